# Optimizing an MI355X kernel written in HIP

```python
import jax
import jax.numpy as jnp
from jax import lax
import numpy as np

D_MODEL = 1024
BATCH = 8
SEQ = 4096
DEPTH = 1

CHUNK = 64
N_META = 16
LN_EPS = 1e-5
RMS_EPS = 1e-6

HG_HEADS = 8
HG_DK = 128
HG_DV = D_MODEL // HG_HEADS
HG_K_WIDTH = HG_HEADS * HG_DK
HG_V_WIDTH = HG_HEADS * HG_DV

LRU_WIDTH = D_MODEL
LRU_BLOCKS = 8
LRU_BLOCK = LRU_WIDTH // LRU_BLOCKS
CONV_W = 4
LRU_C = 8.0

SPLIT_SIZES = (HG_K_WIDTH, HG_K_WIDTH, HG_V_WIDTH, HG_V_WIDTH, LRU_WIDTH, LRU_WIDTH, D_MODEL, D_MODEL)
IN_COLS = 2 * HG_K_WIDTH + 2 * HG_V_WIDTH + 2 * LRU_WIDTH + 2 * D_MODEL

N_EXPERTS = 64
TOP_K = 6
D_EXPERT = 256
D_SHARED = 256
ROUTED_SCALE = 2.5
EXPERT_BLOCK = 128

DEEPNORM_ALPHA = (2.0 * DEPTH) ** 0.25
DEEPNORM_BETA = (8.0 * DEPTH) ** -0.25

kernel_name = 'hybrid_hgrn2_rglru_moe_block'


def layer_norm(x, g, b):
    xf = x.astype(jnp.float32)
    mu = jnp.mean(xf, axis=-1, keepdims=True)
    var = jnp.mean(jnp.square(xf - mu), axis=-1, keepdims=True)
    y = (xf - mu) * lax.rsqrt(var + LN_EPS) * g.astype(jnp.float32) + b.astype(jnp.float32)
    return y.astype(x.dtype)


def hgrn2_mixer(q, f_pre, v, g_out, lb, norm_g):
    B, L, _ = q.shape
    f32 = jnp.float32
    f = lb + (1.0 - lb) * jax.nn.sigmoid(f_pre.astype(f32))
    log_f = jnp.log(f)
    k = 1.0 - f
    qf = jax.nn.silu(q.astype(f32))
    vf = v.astype(f32)
    pad = (-L) % CHUNK
    n_chunks = (L + pad) // CHUNK

    def to_chunks(t, d):
        t = jnp.pad(t, ((0, 0), (pad, 0), (0, 0)))
        return t.reshape(B, n_chunks, CHUNK, HG_HEADS, d).transpose(1, 0, 3, 2, 4)

    causal = jnp.tril(jnp.ones((CHUNK, CHUNK), dtype=bool))[:, :, None]

    def chunk_step(S, inp):
        qc, kc, vc, lfc = inp
        b = jnp.cumsum(lfc, axis=2)
        diff = b[:, :, :, None, :] - b[:, :, None, :, :]
        decay = jnp.exp(jnp.where(causal, diff, -jnp.inf))
        scores = jnp.einsum('bhtk,bhsk,bhtsk->bhts', qc, kc, decay)
        o = (jnp.einsum('bhts,bhsv->bhtv', scores, vc)
             + jnp.einsum('bhtk,bhkv->bhtv', qc * jnp.exp(b), S))
        b_last = b[:, :, -1:, :]
        S = (jnp.exp(b_last[:, :, 0, :])[..., None] * S
             + jnp.einsum('bhsk,bhsv->bhkv', kc * jnp.exp(b_last - b), vc))
        return S, o

    S0 = jnp.zeros((B, HG_HEADS, HG_DK, HG_DV), f32)
    _, o = lax.scan(chunk_step, S0, (to_chunks(qf, HG_DK), to_chunks(k, HG_DK),
                                     to_chunks(vf, HG_DV), to_chunks(log_f, HG_DK)))
    o = o.transpose(1, 0, 3, 2, 4).reshape(B, n_chunks * CHUNK, HG_HEADS, HG_DV)[:, pad:]
    o = o * lax.rsqrt(jnp.mean(jnp.square(o), axis=-1, keepdims=True) + RMS_EPS) * norm_g.astype(f32)
    o = o.reshape(B, L, HG_V_WIDTH) * jax.nn.silu(g_out.astype(f32))
    return o.astype(q.dtype)


def causal_depthwise_conv(x, w, b):
    y = lax.conv_general_dilated(x, w[:, None, :], window_strides=(1,), padding=[(CONV_W - 1, 0)],
                                 dimension_numbers=('NWC', 'WIO', 'NWC'), feature_group_count=x.shape[-1])
    return y + b


def block_diag_linear(x, w, b):
    xb = x.reshape(x.shape[:-1] + (LRU_BLOCKS, LRU_BLOCK))
    return jnp.einsum('blnc,ncd->blnd', xb, w).reshape(x.shape) + b


def rg_lru(x, w_a, b_a, w_x, b_x, lam):
    f32 = jnp.float32
    r = jax.nn.sigmoid(block_diag_linear(x, w_a, b_a).astype(f32))
    i = jax.nn.sigmoid(block_diag_linear(x, w_x, b_x).astype(f32))
    log_a = -LRU_C * r * jax.nn.softplus(-lam.astype(f32))
    a = jnp.exp(log_a)
    u = jnp.sqrt(-jnp.expm1(2.0 * log_a)) * (i * x.astype(f32))

    def combine(c1, c2):
        a1, u1 = c1
        a2, u2 = c2
        return a1 * a2, a2 * u1 + u2

    _, h = lax.associative_scan(combine, (a, u), axis=1)
    return h.astype(x.dtype)


def hybrid_mixer(h, w_in, b_in, lb, hg_norm_g, conv_w, conv_b, lru_wa, lru_ba, lru_wx, lru_bx, lru_lambda, w_out):
    proj = h @ w_in + b_in
    offs = np.cumsum(SPLIT_SIZES)[:-1].tolist()
    q, f_pre, v, g_out, lru_x, lru_g, gate_hg, gate_lru = jnp.split(proj, offs, axis=-1)
    y_hg = hgrn2_mixer(q, f_pre, v, g_out, lb, hg_norm_g)
    y_lru = rg_lru(causal_depthwise_conv(lru_x, conv_w, conv_b), lru_wa, lru_ba, lru_wx, lru_bx,
                   lru_lambda) * jax.nn.gelu(lru_g)
    merged = jax.nn.sigmoid(gate_hg) * y_hg + jax.nn.sigmoid(gate_lru) * y_lru
    return merged @ w_out


def swiglu(x, w_gate, w_up, w_down):
    return (jax.nn.silu(x @ w_gate) * (x @ w_up)) @ w_down


def routed_experts(xt, idx, wts, we_gate, we_up, we_down):
    T, D = xt.shape
    A = T * TOP_K
    n_blocks = -(-A // EXPERT_BLOCK) + N_EXPERTS
    e_flat = idx.reshape(A)
    tok_flat = jnp.arange(A, dtype=jnp.int32) // TOP_K
    order = jnp.argsort(e_flat)
    e_sorted = e_flat[order]
    counts = jnp.bincount(e_flat, length=N_EXPERTS)
    starts = jnp.cumsum(counts) - counts
    padded = (counts + EXPERT_BLOCK - 1) // EXPERT_BLOCK * EXPERT_BLOCK
    pad_ends = jnp.cumsum(padded)
    dest = (pad_ends - padded)[e_sorted] + jnp.arange(A, dtype=counts.dtype) - starts[e_sorted]
    buf_tok = jnp.full((n_blocks * EXPERT_BLOCK,), T, jnp.int32).at[dest].set(tok_flat[order])
    buf_w = jnp.zeros((n_blocks * EXPERT_BLOCK,), wts.dtype).at[dest].set(wts.reshape(A)[order])
    block_start = jnp.arange(n_blocks, dtype=pad_ends.dtype) * EXPERT_BLOCK
    block_expert = jnp.minimum(jnp.searchsorted(pad_ends, block_start, side='right'), N_EXPERTS - 1)
    x_pad = jnp.concatenate([xt, jnp.zeros((1, D), xt.dtype)], axis=0)

    def block_step(acc, inp):
        e, tok_b, w_b = inp
        y_b = swiglu(x_pad[tok_b], we_gate[e], we_up[e], we_down[e])
        return acc.at[tok_b].add(y_b * w_b[:, None]), None

    acc, _ = lax.scan(block_step, jnp.zeros((T + 1, D), xt.dtype),
                      (block_expert, buf_tok.reshape(n_blocks, EXPERT_BLOCK),
                       buf_w.reshape(n_blocks, EXPERT_BLOCK)))
    return acc[:T]


def moe_ffn(h, router_w, router_bias, we_gate, we_up, we_down, ws_gate, ws_up, ws_down):
    B, L, D = h.shape
    xt = h.reshape(B * L, D)
    scores = jax.nn.sigmoid((xt @ router_w).astype(jnp.float32))
    _, idx = lax.top_k(scores + router_bias.astype(jnp.float32), TOP_K)
    s_sel = jnp.take_along_axis(scores, idx, axis=-1)
    wts = s_sel / jnp.sum(s_sel, axis=-1, keepdims=True) * ROUTED_SCALE
    y = routed_experts(xt, idx, wts.astype(xt.dtype), we_gate, we_up, we_down) + swiglu(xt, ws_gate, ws_up, ws_down)
    return y.reshape(B, L, D)


def setup_inputs(seed: int = 0) -> dict:
    key = jax.random.key(seed)
    ks = jax.random.split(key, 28)
    f32 = jnp.float32

    def nrm(k, shape, scale):
        return jax.random.normal(k, shape, f32) * scale

    d_inv = D_MODEL ** -0.5
    u2 = jax.random.uniform(ks[14], (DEPTH, LRU_WIDTH), f32, 0.81, 0.998)
    log_sig = 0.5 * jnp.log(u2) / LRU_C
    lru_lambda = log_sig - jnp.log(-jnp.expm1(log_sig))
    return {
        'x': nrm(ks[0], (BATCH, SEQ, D_MODEL), 1.0),
        'meta_tokens': nrm(ks[1], (N_META, D_MODEL), 1.0),
        'ln_in_g': 1.0 + nrm(ks[2], (D_MODEL,), 0.02),
        'ln_in_b': nrm(ks[3], (D_MODEL,), 0.02),
        'w_in': nrm(ks[4], (DEPTH, D_MODEL, IN_COLS), d_inv),
        'b_in': nrm(ks[5], (DEPTH, IN_COLS), 0.02),
        'hg_lb_logits': nrm(ks[6], (DEPTH + 1, HG_K_WIDTH), 0.5),
        'hg_norm_g': 1.0 + nrm(ks[7], (DEPTH, HG_DV), 0.02),
        'conv_w': nrm(ks[8], (DEPTH, CONV_W, LRU_WIDTH), CONV_W ** -0.5),
        'conv_b': nrm(ks[9], (DEPTH, LRU_WIDTH), 0.02),
        'lru_wa': nrm(ks[10], (DEPTH, LRU_BLOCKS, LRU_BLOCK, LRU_BLOCK), LRU_BLOCK ** -0.5),
        'lru_ba': nrm(ks[11], (DEPTH, LRU_WIDTH), 0.02),
        'lru_wx': nrm(ks[12], (DEPTH, LRU_BLOCKS, LRU_BLOCK, LRU_BLOCK), LRU_BLOCK ** -0.5),
        'lru_bx': nrm(ks[13], (DEPTH, LRU_WIDTH), 0.02),
        'lru_lambda': lru_lambda,
        'w_out': nrm(ks[15], (DEPTH, D_MODEL, D_MODEL), DEEPNORM_BETA * d_inv),
        'ln1_g': 1.0 + nrm(ks[16], (DEPTH, D_MODEL), 0.02),
        'ln1_b': nrm(ks[17], (DEPTH, D_MODEL), 0.02),
        'router_w': nrm(ks[18], (DEPTH, D_MODEL, N_EXPERTS), d_inv),
        'router_bias': nrm(ks[19], (DEPTH, N_EXPERTS), 0.01),
        'we_gate': nrm(ks[20], (DEPTH, N_EXPERTS, D_MODEL, D_EXPERT), d_inv),
        'we_up': nrm(ks[21], (DEPTH, N_EXPERTS, D_MODEL, D_EXPERT), d_inv),
        'we_down': nrm(ks[22], (DEPTH, N_EXPERTS, D_EXPERT, D_MODEL), DEEPNORM_BETA * D_EXPERT ** -0.5),
        'ws_gate': nrm(ks[23], (DEPTH, D_MODEL, D_SHARED), d_inv),
        'ws_up': nrm(ks[24], (DEPTH, D_MODEL, D_SHARED), d_inv),
        'ws_down': nrm(ks[25], (DEPTH, D_SHARED, D_MODEL), DEEPNORM_BETA * D_SHARED ** -0.5),
        'ln2_g': 1.0 + nrm(ks[26], (DEPTH, D_MODEL), 0.02),
        'ln2_b': nrm(ks[27], (DEPTH, D_MODEL), 0.02),
    }


def reference(x, meta_tokens, ln_in_g, ln_in_b, w_in, b_in, hg_lb_logits, hg_norm_g, conv_w, conv_b,
              lru_wa, lru_ba, lru_wx, lru_bx, lru_lambda, w_out, ln1_g, ln1_b, router_w, router_bias,
              we_gate, we_up, we_down, ws_gate, ws_up, ws_down, ln2_g, ln2_b):
    B = x.shape[0]
    meta = jnp.broadcast_to(meta_tokens[None].astype(x.dtype), (B, N_META, D_MODEL))
    h = layer_norm(jnp.concatenate([meta, x], axis=1), ln_in_g, ln_in_b)
    lower_bounds = jnp.cumsum(jax.nn.softmax(hg_lb_logits.astype(jnp.float32), axis=0), axis=0)
    for l in range(DEPTH):
        mix = hybrid_mixer(h, w_in[l], b_in[l], lower_bounds[l], hg_norm_g[l], conv_w[l], conv_b[l],
                           lru_wa[l], lru_ba[l], lru_wx[l], lru_bx[l], lru_lambda[l], w_out[l])
        h = layer_norm(DEEPNORM_ALPHA * h + mix, ln1_g[l], ln1_b[l])
        ffn = moe_ffn(h, router_w[l], router_bias[l], we_gate[l], we_up[l], we_down[l],
                      ws_gate[l], ws_up[l], ws_down[l])
        h = layer_norm(DEEPNORM_ALPHA * h + ffn, ln2_g[l], ln2_b[l])
    return h[:, N_META:]
```

```cpp
#include <hip/hip_runtime.h>
#include <hip/hip_cooperative_groups.h>
#include <stdint.h>
#include <cstdio>
namespace cg = cooperative_groups;

typedef unsigned short bf16_t;
#ifndef REPEAT_PHASE
#define REPEAT_PHASE -1
#endif

constexpr int D = 1024;
constexpr int NB = 8;
constexpr int SEQ = 4096;
constexpr int LP = 4160;
constexpr int PADR = 48;
constexpr int TP = NB * LP;
constexpr int T = NB * SEQ;
constexpr int NCH = LP / 64;
constexpr int NE = 64, TOPK = 6, DE = 256;
constexpr float ALPHA = 1.189207115002721f;
constexpr size_t U = (size_t)TP * D * 2;

__device__ __forceinline__ float bf2f(bf16_t b) { return __uint_as_float(((unsigned)b) << 16); }
__device__ __forceinline__ bf16_t f2bf(float f) { unsigned u = __float_as_uint(f); u += 0x7FFFu + ((u >> 16) & 1u); return (bf16_t)(u >> 16); }
__device__ __forceinline__ float sigmoidf_(float x) { return 1.0f / (1.0f + __expf(-x)); }
__device__ __forceinline__ float siluf_(float x) { return x * sigmoidf_(x); }
__device__ __forceinline__ float gelu_tanh_(float x) { const float c = 0.7978845608028654f; float t = tanhf(c * (x + 0.044715f * x * x * x)); return 0.5f * x * (1.0f + t); }
__device__ __forceinline__ float wave_sum(float v) {
    v += __int_as_float(__builtin_amdgcn_update_dpp(0, __float_as_int(v), 0x111, 0xF, 0xF, false));
    v += __int_as_float(__builtin_amdgcn_update_dpp(0, __float_as_int(v), 0x112, 0xF, 0xF, false));
    v += __int_as_float(__builtin_amdgcn_update_dpp(0, __float_as_int(v), 0x114, 0xF, 0xF, false));
    v += __int_as_float(__builtin_amdgcn_update_dpp(0, __float_as_int(v), 0x118, 0xF, 0xF, false));
    v += __int_as_float(__builtin_amdgcn_update_dpp(0, __float_as_int(v), 0x142, 0xA, 0xF, false));
    v += __int_as_float(__builtin_amdgcn_update_dpp(0, __float_as_int(v), 0x143, 0xC, 0xF, false));
    return __int_as_float(__builtin_amdgcn_readlane(__float_as_int(v), 63));
}

#define LAS __attribute__((address_space(3)))
typedef short bf16x8 __attribute__((ext_vector_type(8)));
typedef float f32x4 __attribute__((ext_vector_type(4)));
typedef unsigned u32x4 __attribute__((ext_vector_type(4)));
typedef unsigned u32x2 __attribute__((ext_vector_type(2)));
constexpr int BM = 256, BK = 64, HALF = 128, HTB = HALF * BK * 2, STAGE_BYTES = 8 * HTB, NXCD = 8, WGM = 16;
constexpr int NTHR = 512;
#ifndef MOE_WGM
#define MOE_WGM 32
#endif
constexpr int LDS_BYTES = 160 * 1024;

struct Params {
    const float *x, *meta, *ln_in_g, *ln_in_b, *w_in, *b_in, *lbl, *hg_ng, *conv_w, *conv_b, *lru_wa, *lru_ba, *lru_wx, *lru_bx, *lru_lam, *w_out, *ln1_g, *ln1_b, *router_w, *router_b,
        *we_gate, *we_up, *we_down, *ws_gate, *ws_up, *ws_down, *ln2_g, *ln2_b;
    float* out;
    bf16_t *h0, *Qh, *Kh, *Vv, *G1, *LX, *G2;
    float* Dk; int* ridx; float* rwts;
    bf16_t* pre1; bf16_t* h1;
    bf16_t *Bt_in, *Bt_out, *Bt_gu, *Bt_d, *Bt_sgu, *Bt_sd, *Bt_wa, *Bt_wx, *Bt_r;
    float* bperm; float* lb;
    int* cnt; int* list_tok; float* list_w;
    bf16_t* act; bf16_t* base; unsigned char* yrows;
    unsigned* bar; unsigned long long* xg;
    int flags; int pad_;
};

__device__ __forceinline__ int lds_byte(int r, int c) { const int st = (r >> 4) * 2 + (c >> 5), rr = r & 15, cc = c & 31, ob = rr * 64 + cc * 2; return st * 1024 + (ob ^ (((ob >> 9) & 1) << 5)); }
__device__ __forceinline__ void stage_rc(int b, int& R, int& C) { const int st = b / 1024, sb = b % 1024, swz = sb ^ (((sb >> 9) & 1) << 5); R = (st >> 1) * 16 + swz / 64; C = (st & 1) * 32 + (swz % 64) / 2; }
__device__ __forceinline__ int perm32(int rho) { const int n = rho >> 4, i = rho & 15; return 8 * (i >> 2) + 4 * n + (i & 3); }
__device__ __forceinline__ unsigned cvt_pk_bf16(float lo, float hi) { unsigned r; asm volatile("v_cvt_pk_bf16_f32 %0, %1, %2" : "=v"(r) : "v"(lo), "v"(hi)); return r; }

__device__ __forceinline__ int tid_opaque() { int t = threadIdx.x; asm volatile("" : "+v"(t)); return t; }
struct Unit { int a0; long long boff; int pm; int pn; int e; int r; };
__device__ __forceinline__ void tile_order(int L, int nM, int nN, int& pm, int& pn, const int wgm = WGM) {
    const int nwg = nM * nN; int wgid = L;
    { const int q = nwg / NXCD, r = nwg % NXCD, xcd = wgid % NXCD, off = wgid / NXCD; wgid = (xcd < r ? xcd * (q + 1) : r * (q + 1) + (xcd - r) * q) + off; }
    const int nig = wgm * nN, gid = wgid / nig, fm = gid * wgm, gsz = (nM - fm) < wgm ? (nM - fm) : wgm;
    pm = fm + ((wgid % nig) % gsz); pn = (wgid % nig) / gsz;
}

#define XB_TMO      128
#define XB_XCNT(j)  (256  + 64 * (j))
#define XB_XSUB(j)  (1280 + 64 * (j))
#define XB_XGEN(j)  (2304 + 64 * (j))
#define XB_TOP      3328
#define XB_TOPGEN   3392
#define XCD_BAR_WORDS 3456
#define XB_SPIN_CAP (1u << 22)
__device__ __forceinline__ unsigned xb_ld(unsigned* p) { return __hip_atomic_load(p, __ATOMIC_RELAXED, __HIP_MEMORY_SCOPE_AGENT); }
__device__ __forceinline__ unsigned xb_add(unsigned* p, unsigned v) { return __hip_atomic_fetch_add(p, v, __ATOMIC_RELAXED, __HIP_MEMORY_SCOPE_AGENT); }
__device__ __forceinline__ unsigned xb_xcc_id() { return (unsigned)__builtin_amdgcn_s_getreg((3 << 11) | 20) & 0xFu; }
#define XB_SPIN(cond, bar) do { unsigned _sp = 0; while (cond) { __builtin_amdgcn_s_sleep(1); \
    if ((++_sp & 255u) == 0u) { if (xb_ld(&(bar)[XB_TMO])) break; if (_sp > XB_SPIN_CAP) { atomicAdd(&(bar)[XB_TMO], 1u); break; } } } } while (0)
struct XcdBarrier { unsigned* bar; unsigned x; volatile LAS unsigned* st; };
__device__ __forceinline__ XcdBarrier xcd_barrier_post(unsigned* bar, volatile LAS unsigned* st) {
    XcdBarrier b; b.bar = bar; b.x = xb_xcc_id(); b.st = st;
    if (threadIdx.x == 0) (void)xb_add(&bar[XB_XCNT(b.x)], 1u);
    return b;
}
__device__ __forceinline__ void xcd_barrier_complete(unsigned* bar, unsigned x, unsigned& nloc, unsigned& nx) {
    const unsigned G = gridDim.x * gridDim.y * gridDim.z;
    unsigned sum, cnt, mine, sp = 0u;
    for (;;) {
        sum = 0u; cnt = 0u; mine = 0u;
#pragma unroll
        for (unsigned j = 0; j < 16; ++j) { const unsigned c = xb_ld(&bar[XB_XCNT(j)]); sum += c; cnt += (c > 0u) ? 1u : 0u; mine = (j == x) ? c : mine; }
        if (sum == G) break;
        __builtin_amdgcn_s_sleep(1);
        if ((++sp & 255u) == 0u) { if (xb_ld(&bar[XB_TMO])) break; if (sp > XB_SPIN_CAP) { atomicAdd(&bar[XB_TMO], 1u); break; } }
    }
    nloc = mine > 0u ? mine : 1u; nx = cnt > 0u ? cnt : 1u;
}
__device__ __forceinline__ void xcd_barrier(const XcdBarrier& b) {
    asm volatile("s_waitcnt vmcnt(0)" ::: "memory");
    __syncthreads();
    if (threadIdx.x == 0) {
        unsigned* bar = b.bar;
        __builtin_amdgcn_s_waitcnt(0);
        unsigned nloc = b.st[0], nx = b.st[1];
        if (nloc == 0u) { xcd_barrier_complete(bar, b.x, nloc, nx); b.st[0] = nloc; b.st[1] = nx; }
        const unsigned old = xb_add(&bar[XB_XSUB(b.x)], 1u);
        const unsigned gen = old / nloc;
        if (old + 1u == (gen + 1u) * nloc) {
            __builtin_amdgcn_fence(__ATOMIC_RELEASE, "agent");
            asm volatile("s_waitcnt vmcnt(0)" ::: "memory");
            const unsigned og = xb_add(&bar[XB_TOP], 1u);
            const unsigned tg = og / nx;
            if (og + 1u == (tg + 1u) * nx) xb_add(&bar[XB_TOPGEN], 1u);
            else XB_SPIN(xb_ld(&bar[XB_TOPGEN]) == tg, bar);
            __builtin_amdgcn_fence(__ATOMIC_ACQUIRE, "agent");
            xb_add(&bar[XB_XGEN(b.x)], 1u);
            asm volatile("s_waitcnt vmcnt(0)" ::: "memory");
        } else {
            XB_SPIN(xb_ld(&bar[XB_XGEN(b.x)]) == gen, bar);
            __builtin_amdgcn_fence(__ATOMIC_ACQUIRE, "agent");
            asm volatile("s_waitcnt vmcnt(0)" ::: "memory");
        }
    }
    __syncthreads();
}

template <class Epi, class Sched>
__device__ __forceinline__ void gemm_phase(LAS unsigned char* lds, const bf16_t* Abase, const bf16_t* Btbase, const int K, const Sched& S, const Epi& E) {
    const int tid = tid_opaque(), wid = __builtin_amdgcn_readfirstlane(tid >> 6), lane = tid & 63, wr = wid >> 2, wc = wid & 3, fr = lane & 15, fq = lane >> 4;
    const int nt = K / BK;
    int Rr[2], Cc[2]; unsigned voffB[2], voffB1[2];
#pragma unroll
    for (int i = 0; i < 2; ++i) { int R, C; stage_rc(tid * 16 + i * 8192, R, C); Rr[i] = R; Cc[i] = C;
        if (Epi::PERM == 2) {
            const int rb = 64 * (R >> 5) + 16 * ((R & 15) >> 2) + 4 * ((R >> 4) & 1) + (R & 3);
            voffB[i] = (unsigned)(rb * K + C) * 2u; voffB1[i] = (unsigned)((rb + 8) * K + C) * 2u;
        } else {
            const int Rb = Epi::PERM ? ((R & ~31) + perm32(R & 31)) : R; voffB[i] = (unsigned)(Rb * K + C) * 2u; voffB1[i] = voffB[i] + (unsigned)(HALF * K * 2);
        } }
    const size_t kstep = (size_t)(BK * 2);
    const unsigned ldsw = (unsigned)wid * 1024u;
    const int aoff = lds_byte(wr * 64 + fr, fq * 8), boff = lds_byte(wc * 32 + fr, fq * 8);
#define G_SA(b, h) (((b) * 2 + (h)) * HTB)
#define G_SB(b, h) ((4 + (b) * 2 + (h)) * HTB)
#define G_STAGE(bufoff, gbase, voff) do { _Pragma("unroll") for (int _i = 0; _i < 2; ++_i) \
        __builtin_amdgcn_global_load_lds((const unsigned*)((const char*)(gbase) + (voff)[_i]), (LAS unsigned*)(lds + (bufoff) + ldsw + _i * 8192), 16, 0, 0); } while (0)
#define G_LDA(dst, b, h) do { _Pragma("unroll") for (int m = 0; m < 4; ++m) _Pragma("unroll") for (int k = 0; k < 2; ++k) dst[m][k] = *(const LAS bf16x8*)(lds + G_SA(b, h) + aoff + m * 2048 + k * 1024); } while (0)
#define G_LDB(dst, b, h) do { _Pragma("unroll") for (int n = 0; n < 2; ++n) _Pragma("unroll") for (int k = 0; k < 2; ++k) dst[n][k] = *(const LAS bf16x8*)(lds + G_SB(b, h) + boff + n * 2048 + k * 1024); } while (0)
#define G_MMA(ai, bj, At, Bt) do { __builtin_amdgcn_s_setprio(1); _Pragma("unroll") for (int m = 0; m < 4; ++m) _Pragma("unroll") for (int n = 0; n < 2; ++n) _Pragma("unroll") for (int k = 0; k < 2; ++k) \
        acc[ai][bj][m][n] = __builtin_amdgcn_mfma_f32_16x16x32_bf16(Bt[n][k], At[m][k], acc[ai][bj][m][n], 0, 0, 0); __builtin_amdgcn_s_setprio(0); } while (0)
#define G_WAIT_V(n) asm volatile("s_waitcnt vmcnt(" #n ")" ::: "memory")
#define G_WAIT_L(n) asm volatile("s_waitcnt lgkmcnt(" #n ")" ::: "memory")
#define G_BAR __builtin_amdgcn_s_barrier()
#define G_SCHED __builtin_amdgcn_sched_barrier(0)
    Unit cur, nxt; int ui = 0;
    if (!S.next(0, cur)) return;
    f32x4 acc[2][2][4][2];
#pragma unroll
    for (int a = 0; a < 2; ++a)
#pragma unroll
        for (int b = 0; b < 2; ++b)
#pragma unroll
            for (int m = 0; m < 4; ++m)
#pragma unroll
                for (int n = 0; n < 2; ++n) acc[a][b][m][n] = (f32x4){0.f, 0.f, 0.f, 0.f};
    bf16x8 At[4][2], B0[2][2], B1[2][2];
    unsigned vA0[2], vA1[2], vN0[2], vN1[2];
    S.a_off(cur, Rr, Cc, K, vA0, vA1);
    const char* const cA = (const char*)Abase;
    const char* cB = (const char*)Btbase + cur.boff;
    G_STAGE(G_SB(0, 0), cB, voffB); G_STAGE(G_SA(0, 0), cA, vA0); G_STAGE(G_SB(0, 1), cB, voffB1); G_STAGE(G_SA(0, 1), cA, vA1);
    if (wr == 1) G_BAR;
    G_WAIT_V(4); G_BAR;
    G_STAGE(G_SB(1, 0), cB + kstep, voffB); G_STAGE(G_SA(1, 0), cA + kstep, vA0); G_STAGE(G_SB(1, 1), cB + kstep, voffB1);
    G_WAIT_V(6); G_BAR;
    for (;;) {
        const bool has_next = S.next(ui + 1, nxt);
        if (has_next) { S.a_off(nxt, Rr, Cc, K, vN0, vN1); asm volatile("" : "+v"(vN0[0]), "+v"(vN0[1]), "+v"(vN1[0]), "+v"(vN1[1])); } else { vN0[0] = vA0[0]; vN0[1] = vA0[1]; vN1[0] = vA1[0]; vN1[1] = vA1[1]; }
        const char* nB = has_next ? (const char*)Btbase + nxt.boff : cB;
#pragma nounroll
        for (int t = 0; t < nt; t += 2) {
            const bool last = (t == nt - 2);
            const char* a1 = cA + (size_t)(t + 1) * kstep;
            const char* a2 = last ? cA : cA + (size_t)(t + 2) * kstep; const char* b2 = last ? nB : cB + (size_t)(t + 2) * kstep;
            const char* a3 = a2 + kstep; const char* b3 = b2 + kstep;
            unsigned w0[2], w1[2];
            w0[0] = last ? vN0[0] : vA0[0]; w0[1] = last ? vN0[1] : vA0[1]; w1[0] = last ? vN1[0] : vA1[0]; w1[1] = last ? vN1[1] : vA1[1];
            G_LDB(B0, 0, 0); G_SCHED; G_LDA(At, 0, 0); G_STAGE(G_SA(1, 1), a1, vA1);
            G_WAIT_L(8); G_BAR; G_WAIT_L(0); G_MMA(0, 0, At, B0); G_BAR; G_SCHED;
            G_LDB(B1, 0, 1); G_STAGE(G_SB(0, 0), b2, voffB);
            G_BAR; G_WAIT_L(0); G_MMA(0, 1, At, B1); G_BAR;
            G_LDA(At, 0, 1); G_STAGE(G_SA(0, 0), a2, w0);
            G_BAR; G_WAIT_L(0); G_MMA(1, 0, At, B0); G_BAR; G_SCHED;
            G_STAGE(G_SB(0, 1), b2, voffB1);
            G_WAIT_V(6); G_BAR; G_MMA(1, 1, At, B1); G_BAR;
            G_LDB(B0, 1, 0); G_SCHED; G_LDA(At, 1, 0); G_STAGE(G_SA(0, 1), a2, w1);
            G_WAIT_L(8); G_BAR; G_WAIT_L(0); G_MMA(0, 0, At, B0); G_BAR; G_SCHED;
            G_LDB(B1, 1, 1); G_STAGE(G_SB(1, 0), b3, voffB);
            G_BAR; G_WAIT_L(0); G_MMA(0, 1, At, B1); G_BAR;
            G_LDA(At, 1, 1); G_STAGE(G_SA(1, 0), a3, w0);
            G_BAR; G_WAIT_L(0); G_MMA(1, 0, At, B0); G_BAR; G_SCHED;
            G_STAGE(G_SB(1, 1), b3, voffB1);
            G_WAIT_V(6); G_BAR; G_MMA(1, 1, At, B1); G_BAR;
        }
        E(acc, cur, wr, wc, fr, fq);
        if (!has_next) break;
#pragma unroll
        for (int a = 0; a < 2; ++a)
#pragma unroll
            for (int b = 0; b < 2; ++b)
#pragma unroll
                for (int m = 0; m < 4; ++m)
#pragma unroll
                    for (int n = 0; n < 2; ++n) acc[a][b][m][n] = (f32x4){0.f, 0.f, 0.f, 0.f};
        cur = nxt; cB = nB; vA0[0] = vN0[0]; vA0[1] = vN0[1]; vA1[0] = vN1[0]; vA1[1] = vN1[1]; ++ui;
    }
    G_WAIT_V(0);
    if (wr == 0) G_BAR;
    G_BAR;
#undef G_SA
#undef G_SB
#undef G_STAGE
#undef G_LDA
#undef G_LDB
#undef G_MMA
#undef G_WAIT_V
#undef G_WAIT_L
#undef G_BAR
#undef G_SCHED
}

template <int NT, class F>
__device__ __forceinline__ void transpose_strip(const float* __restrict__ src, int sld, int k0, int n0, bf16_t* __restrict__ dst, int dld, F drow, LAS float* sm) {
    const int tid = threadIdx.x, kr = tid >> 3, c8 = (tid & 7) * 8;
    f32x4 a[NT], b[NT];
#pragma unroll
    for (int t = 0; t < NT; ++t) { a[t] = *(const f32x4*)(src + (size_t)(k0 + kr) * sld + n0 + t * 64 + c8); b[t] = *(const f32x4*)(src + (size_t)(k0 + kr) * sld + n0 + t * 64 + c8 + 4); }
#pragma unroll
    for (int t = 0; t < NT; ++t) {
        LAS float* w = sm + t * (64 * 65) + kr * 65 + c8;
        w[0] = a[t][0]; w[1] = a[t][1]; w[2] = a[t][2]; w[3] = a[t][3]; w[4] = b[t][0]; w[5] = b[t][1]; w[6] = b[t][2]; w[7] = b[t][3];
    }
    __syncthreads();
    const int nr = tid >> 3, k8 = (tid & 7) * 8;
#pragma unroll
    for (int t = 0; t < NT; ++t) {
        float v[8];
#pragma unroll
        for (int i = 0; i < 8; ++i) v[i] = sm[t * (64 * 65) + (k8 + i) * 65 + nr];
        u32x4 o; o.x = cvt_pk_bf16(v[0], v[1]); o.y = cvt_pk_bf16(v[2], v[3]); o.z = cvt_pk_bf16(v[4], v[5]); o.w = cvt_pk_bf16(v[6], v[7]);
        *(u32x4*)(dst + (size_t)drow(n0 + t * 64 + nr) * dld + k0 + k8) = o;
    }
    __syncthreads();
}
__device__ __forceinline__ int drow_in(int s) {
    const int sec = s >> 10, i = s & 1023, h = i >> 7, j = i & 127;
    switch (sec) {
        case 0: return h * 256 + j;
        case 1: return h * 256 + 128 + j;
        case 2: return (8 + (i >> 8)) * 256 + (i & 255);
        case 3: return (12 + h) * 256 + j;
        case 4: return (20 + (i >> 8)) * 256 + (i & 255);
        case 5: return (24 + h) * 256 + j;
        case 6: return (12 + h) * 256 + 128 + j;
        default: return (24 + h) * 256 + 128 + j;
    }
}
__device__ __forceinline__ void phase_prep(const Params& p, LAS unsigned char* lds) {
    LAS float* sm = (LAS float*)lds;
    const int nwg = gridDim.x, wg = blockIdx.x;
    constexpr int NT_TOTAL = 512 + 64 + 1024 * 3 + 16 * 3 + 16 * 2 + 16;
    const bool experts_here = gridDim.x != 256;
    for (int it = wg; it < NT_TOTAL; it += nwg) {
        int t = it;
        if (!experts_here && t >= 576 && t < 576 + 3072) continue;
        if (t < 512) { const int kt = t >> 5, ns = t & 31; transpose_strip<4>(p.w_in, 8192, kt * 64, ns * 256, p.Bt_in, 1024, [](int n) { return drow_in(n); }, sm); continue; }
        t -= 512;
        if (t < 64) { const int kt = t >> 2, ns = t & 3; transpose_strip<4>(p.w_out, 1024, kt * 64, ns * 256, p.Bt_out, 1024, [](int n) { return n; }, sm); continue; }
        t -= 64;
        if (t < 1024) { const int e = t >> 4, kt = t & 15; transpose_strip<4>(p.we_gate + (size_t)e * D * DE, DE, kt * 64, 0, p.Bt_gu + (size_t)e * 512 * D, D, [](int n) { return (n >> 7) * 256 + (n & 127); }, sm); continue; }
        t -= 1024;
        if (t < 1024) { const int e = t >> 4, kt = t & 15; transpose_strip<4>(p.we_up + (size_t)e * D * DE, DE, kt * 64, 0, p.Bt_gu + (size_t)e * 512 * D, D, [](int n) { return (n >> 7) * 256 + 128 + (n & 127); }, sm); continue; }
        t -= 1024;
        if (t < 1024) { const int e = t >> 4, r = t & 15, kt = r >> 2, ns = r & 3; transpose_strip<4>(p.we_down + (size_t)e * DE * D, D, kt * 64, ns * 256, p.Bt_d + (size_t)e * D * DE, DE, [](int n) { return n; }, sm); continue; }
        t -= 1024;
        if (t < 16) { transpose_strip<4>(p.ws_gate, DE, t * 64, 0, p.Bt_sgu, D, [](int n) { return (n >> 7) * 256 + (n & 127); }, sm); continue; }
        t -= 16;
        if (t < 16) { transpose_strip<4>(p.ws_up, DE, t * 64, 0, p.Bt_sgu, D, [](int n) { return (n >> 7) * 256 + 128 + (n & 127); }, sm); continue; }
        t -= 16;
        if (t < 16) { const int kt = t >> 2, ns = t & 3; transpose_strip<4>(p.ws_down, D, kt * 64, ns * 256, p.Bt_sd, DE, [](int n) { return n; }, sm); continue; }
        t -= 16;
        if (t < 16) { const int e = t >> 1, kt = t & 1; transpose_strip<2>(p.lru_wa + (size_t)e * 16384, 128, kt * 64, 0, p.Bt_wa + (size_t)e * 16384, 128, [](int n) { return n; }, sm); continue; }
        t -= 16;
        if (t < 16) { const int e = t >> 1, kt = t & 1; transpose_strip<2>(p.lru_wx + (size_t)e * 16384, 128, kt * 64, 0, p.Bt_wx + (size_t)e * 16384, 128, [](int n) { return n; }, sm); continue; }
        t -= 16;
        { transpose_strip<1>(p.router_w, NE, t * 64, 0, p.Bt_r, D, [](int n) { return n; }, sm); }
    }
    {
        const int wv = threadIdx.x >> 6, lane = threadIdx.x & 63;
        f32x4 g0v[4], b0v[4];
#pragma unroll
        for (int j = 0; j < 4; ++j) { g0v[j] = *(const f32x4*)(p.ln_in_g + j * 256 + lane * 4); b0v[j] = *(const f32x4*)(p.ln_in_b + j * 256 + lane * 4); }
        for (int it = wg; it < TP / 8; it += nwg) {
            const int row = it * 8 + wv;
            const int bb = row / LP, pos = row % LP;
            bf16_t* dst = p.h0 + (size_t)row * D;
            if (pos < PADR) {
#pragma unroll
                for (int j = 0; j < 4; ++j) *(u32x2*)(dst + j * 256 + lane * 4) = (u32x2){0u, 0u};
                continue;
            }
            const float* src = pos < 64 ? p.meta + (size_t)(pos - PADR) * D : p.x + ((size_t)bb * SEQ + (pos - 64)) * D;
            f32x4 v[4]; float s = 0.f;
#pragma unroll
            for (int j = 0; j < 4; ++j) { v[j] = *(const f32x4*)(src + j * 256 + lane * 4); s += (v[j][0] + v[j][1]) + (v[j][2] + v[j][3]); }
            const float mean = wave_sum(s) * (1.0f / D);
            float q = 0.f;
#pragma unroll
            for (int j = 0; j < 4; ++j) { const f32x4 d = v[j] - mean; q += (d[0] * d[0] + d[1] * d[1]) + (d[2] * d[2] + d[3] * d[3]); }
            const float rstd = rsqrtf(wave_sum(q) * (1.0f / D) + 1e-5f);
#pragma unroll
            for (int j = 0; j < 4; ++j) {
                const int c0 = j * 256 + lane * 4;
                const f32x4 o = (v[j] - mean) * rstd * g0v[j] + b0v[j];
                *(u32x2*)(dst + c0) = (u32x2){cvt_pk_bf16(o[0], o[1]), cvt_pk_bf16(o[2], o[3])};
            }
        }
    }
    { const int t0 = tid_opaque(); if (wg == 0 && t0 < 64) p.cnt[t0 * 64] = 0; }
    for (int i = wg * NTHR + threadIdx.x; i < 64 * 4 * 4 * 64; i += nwg * NTHR) p.xg[i] = 0ull;
    for (int s = wg * NTHR + threadIdx.x; s < 1024; s += nwg * NTHR) p.lb[s] = 1.0f / (1.0f + expf(p.lbl[D + s] - p.lbl[s]));
    for (int s = wg * NTHR + threadIdx.x; s < 8192; s += nwg * NTHR) p.bperm[drow_in(s)] = p.b_in[s];
}

struct Sched3 {
    int G, c;
    __device__ __forceinline__ bool next(int i, Unit& u) const {
        const int L = i * G + c; if (L >= 128 * 4) return false;
        int pm, pn; tile_order(L, 128, 4, pm, pn);
        u.pm = pm; u.pn = pn; u.a0 = (pm >> 4) * LP + 64 + (pm & 15) * 256; u.boff = (long long)pn * 256 * D * 2; u.e = 0; u.r = 0; return true;
    }
    __device__ __forceinline__ void a_off(const Unit& u, const int (&R)[2], const int (&C)[2], int K, unsigned (&v0)[2], unsigned (&v1)[2]) const {
#pragma unroll
        for (int i = 0; i < 2; ++i) { v0[i] = (unsigned)((u.a0 + R[i]) * K + C[i]) * 2u; v1[i] = (unsigned)((u.a0 + HALF + R[i]) * K + C[i]) * 2u; }
    }
};
struct Epi3 {
    static constexpr int PERM = 1;
    const bf16_t* __restrict__ h0; bf16_t* __restrict__ pre1;
    __device__ __forceinline__ void operator()(const f32x4 (&acc)[2][2][4][2], const Unit& u, int wr, int wc, int fr, int fq) const {
        int c0 = u.pn * 256 + wc * 32 + 8 * fq, rit = wr * 64 + fr;
        asm volatile("" : "+v"(c0), "+v"(rit));
        const bf16_t* hb = h0 + ((size_t)u.a0 + rit) * D + c0;
        bf16_t* pb = pre1 + ((size_t)u.pm * 256 + rit) * D + c0;
#pragma unroll
        for (int ai = 0; ai < 2; ++ai) {
            u32x4 hv[4][2];
#pragma unroll
            for (int m = 0; m < 4; ++m)
#pragma unroll
                for (int bj = 0; bj < 2; ++bj) hv[m][bj] = *(const u32x4*)(hb + (size_t)(ai * HALF + m * 16) * D + bj * HALF);
#pragma unroll
            for (int m = 0; m < 4; ++m)
#pragma unroll
                for (int bj = 0; bj < 2; ++bj) {
                    const u32x4 h = hv[m][bj]; const f32x4 v0 = acc[ai][bj][m][0], v1 = acc[ai][bj][m][1];
                    u32x4 w;
                    w.x = cvt_pk_bf16(v0[0] + ALPHA * __uint_as_float(h.x << 16), v0[1] + ALPHA * __uint_as_float(h.x & 0xffff0000u));
                    w.y = cvt_pk_bf16(v0[2] + ALPHA * __uint_as_float(h.y << 16), v0[3] + ALPHA * __uint_as_float(h.y & 0xffff0000u));
                    w.z = cvt_pk_bf16(v1[0] + ALPHA * __uint_as_float(h.z << 16), v1[1] + ALPHA * __uint_as_float(h.z & 0xffff0000u));
                    w.w = cvt_pk_bf16(v1[2] + ALPHA * __uint_as_float(h.w << 16), v1[3] + ALPHA * __uint_as_float(h.w & 0xffff0000u));
                    *(u32x4*)(pb + (size_t)(ai * HALF + m * 16) * D + bj * HALF) = w;
                }
            asm volatile("" ::: "memory");
        }
    }
};
__device__ __forceinline__ void phase3(const Params& p, LAS unsigned char* lds) {
    Sched3 S{(int)gridDim.x, (int)blockIdx.x}; Epi3 E{p.h0, p.pre1};
    gemm_phase(lds, p.G1, p.Bt_out, D, S, E);
}

__device__ __forceinline__ float fast_sigmoid(float z) { return __builtin_amdgcn_rcpf(1.0f + __builtin_amdgcn_exp2f(-1.4426950408889634f * z)); }
template <int N> __device__ __forceinline__ float dpp_row_shr(float v) { return __int_as_float(__builtin_amdgcn_update_dpp(0, __float_as_int(v), 0x110 + N, 0xF, 0xF, false)); }
__device__ __forceinline__ float row16_incl_scan(float v) { v += dpp_row_shr<1>(v); v += dpp_row_shr<2>(v); v += dpp_row_shr<4>(v); v += dpp_row_shr<8>(v); return v; }
struct Sched1 {
    int G, c;
    __device__ __forceinline__ bool next(int i, Unit& u) const {
        const int L = i * G + c; if (L >= 130 * 32) return false;
        int pm, pn; tile_order(L, 130, 32, pm, pn);
        u.pm = pm; u.pn = pn; u.a0 = pm * 256; u.boff = (long long)pn * 256 * D * 2; u.e = 0; u.r = 0; return true;
    }
    __device__ __forceinline__ void a_off(const Unit& u, const int (&R)[2], const int (&C)[2], int K, unsigned (&v0)[2], unsigned (&v1)[2]) const {
#pragma unroll
        for (int i = 0; i < 2; ++i) { v0[i] = (unsigned)((u.a0 + R[i]) * K + C[i]) * 2u; v1[i] = (unsigned)((u.a0 + HALF + R[i]) * K + C[i]) * 2u; }
    }
};
struct Epi1 {
    static constexpr int PERM = 1;
    const LAS bf16_t* sbias; const LAS float* slb;
    bf16_t* __restrict__ Qh; bf16_t* __restrict__ Kh; bf16_t* __restrict__ Vv; bf16_t* __restrict__ G1; bf16_t* __restrict__ LX; bf16_t* __restrict__ G2; float* __restrict__ Dk;
    __device__ __forceinline__ void ld8(const LAS bf16_t* p, f32x4& lo, f32x4& hi) const {
        const u32x4 v = *(const LAS u32x4*)p;
        lo = (f32x4){__uint_as_float(v.x << 16), __uint_as_float(v.x & 0xffff0000u), __uint_as_float(v.y << 16), __uint_as_float(v.y & 0xffff0000u)};
        hi = (f32x4){__uint_as_float(v.z << 16), __uint_as_float(v.z & 0xffff0000u), __uint_as_float(v.w << 16), __uint_as_float(v.w & 0xffff0000u)};
    }
    __device__ __forceinline__ void operator()(const f32x4 (&acc)[2][2][4][2], const Unit& u, int wr, int wc, int fr, int fq) const {
        const int pn = u.pn, col8 = wc * 32 + fq * 8;
        const size_t row0 = (size_t)u.pm * 256 + wr * 64 + fr;
        if (pn < 8) {
            f32x4 bq0, bq1, bf0, bf1; ld8(sbias + pn * 256 + col8, bq0, bq1); ld8(sbias + pn * 256 + 128 + col8, bf0, bf1);
            const f32x4 lb0 = *(const LAS f32x4*)(slb + pn * 128 + col8), lb1 = *(const LAS f32x4*)(slb + pn * 128 + col8 + 4);
            const int lane16 = (int)(threadIdx.x & 48) | 15;
#pragma unroll
            for (int ai = 0; ai < 2; ++ai) {
                const int chunk = u.pm * 4 + ai * 2 + wr;
                const bool first = (chunk % NCH) == 0;
                float carry[2][4];
#pragma unroll
                for (int n = 0; n < 2; ++n)
#pragma unroll
                    for (int j = 0; j < 4; ++j) carry[n][j] = 0.f;
#pragma unroll
                for (int m = 0; m < 4; ++m) {
                    const bool pad = first && (m * 16 + fr < PADR);
                    float qo[2][4], ko[2][4];
#pragma unroll
                    for (int n = 0; n < 2; ++n)
#pragma unroll
                        for (int j = 0; j < 4; ++j) {
                            const float qv = acc[ai][0][m][n][j] + (n ? bq1[j] : bq0[j]);
                            const float z = acc[ai][1][m][n][j] + (n ? bf1[j] : bf0[j]);
                            const float lbv = n ? lb1[j] : lb0[j];
                            const float f = lbv + (1.0f - lbv) * fast_sigmoid(z);
                            const float l2 = pad ? 0.f : __builtin_amdgcn_logf(f);
                            const float s = row16_incl_scan(l2) + carry[n][j];
                            carry[n][j] = __shfl(s, lane16);
                            qo[n][j] = qv * fast_sigmoid(qv) * __builtin_amdgcn_exp2f(s);
                            ko[n][j] = pad ? 0.f : (1.0f - f) * __builtin_amdgcn_exp2f(fminf(-s, 120.0f));
                        }
                    const size_t o = (row0 + ai * HALF + m * 16) * D + pn * 128 + col8;
                    u32x4 wq, wk;
                    wq.x = cvt_pk_bf16(qo[0][0], qo[0][1]); wq.y = cvt_pk_bf16(qo[0][2], qo[0][3]); wq.z = cvt_pk_bf16(qo[1][0], qo[1][1]); wq.w = cvt_pk_bf16(qo[1][2], qo[1][3]);
                    wk.x = cvt_pk_bf16(ko[0][0], ko[0][1]); wk.y = cvt_pk_bf16(ko[0][2], ko[0][3]); wk.z = cvt_pk_bf16(ko[1][0], ko[1][1]); wk.w = cvt_pk_bf16(ko[1][2], ko[1][3]);
                    *(u32x4*)(Qh + o) = wq; *(u32x4*)(Kh + o) = wk;
                }
                if (fr == 0) {
                    float* dp = Dk + (size_t)chunk * D + pn * 128 + col8;
                    *(f32x4*)dp = (f32x4){__builtin_amdgcn_exp2f(carry[0][0]), __builtin_amdgcn_exp2f(carry[0][1]), __builtin_amdgcn_exp2f(carry[0][2]), __builtin_amdgcn_exp2f(carry[0][3])};
                    *(f32x4*)(dp + 4) = (f32x4){__builtin_amdgcn_exp2f(carry[1][0]), __builtin_amdgcn_exp2f(carry[1][1]), __builtin_amdgcn_exp2f(carry[1][2]), __builtin_amdgcn_exp2f(carry[1][3])};
                }
            }
        } else if ((pn >= 8 && pn < 12) || (pn >= 20 && pn < 24)) {
            bf16_t* dst = pn < 12 ? Vv : LX; const int cb = (pn - (pn < 12 ? 8 : 20)) * 256;
#pragma unroll
            for (int bj = 0; bj < 2; ++bj) {
                f32x4 b0, b1; ld8(sbias + pn * 256 + bj * HALF + col8, b0, b1);
#pragma unroll
                for (int ai = 0; ai < 2; ++ai)
#pragma unroll
                    for (int m = 0; m < 4; ++m) {
                        const f32x4 v0 = acc[ai][bj][m][0] + b0, v1 = acc[ai][bj][m][1] + b1;
                        u32x4 w; w.x = cvt_pk_bf16(v0[0], v0[1]); w.y = cvt_pk_bf16(v0[2], v0[3]); w.z = cvt_pk_bf16(v1[0], v1[1]); w.w = cvt_pk_bf16(v1[2], v1[3]);
                        *(u32x4*)(dst + (row0 + ai * HALF + m * 16) * D + cb + bj * HALF + col8) = w;
                    }
            }
        } else {
            const bool is1 = pn < 20; bf16_t* dst = is1 ? G1 : G2; const int cb = (pn - (is1 ? 12 : 24)) * 128;
            f32x4 ba0, ba1, bg0, bg1; ld8(sbias + pn * 256 + col8, ba0, ba1); ld8(sbias + pn * 256 + 128 + col8, bg0, bg1);
#pragma unroll
            for (int ai = 0; ai < 2; ++ai)
#pragma unroll
                for (int m = 0; m < 4; ++m) {
                    float o[2][4];
#pragma unroll
                    for (int n = 0; n < 2; ++n)
#pragma unroll
                        for (int j = 0; j < 4; ++j) {
                            const float a = acc[ai][0][m][n][j] + (n ? ba1[j] : ba0[j]);
                            const float g = acc[ai][1][m][n][j] + (n ? bg1[j] : bg0[j]);
                            const float arg = is1 ? a : 1.5957691216057308f * (a + 0.044715f * a * a * a);
                            o[n][j] = a * fast_sigmoid(arg) * fast_sigmoid(g);
                        }
                    u32x4 w; w.x = cvt_pk_bf16(o[0][0], o[0][1]); w.y = cvt_pk_bf16(o[0][2], o[0][3]); w.z = cvt_pk_bf16(o[1][0], o[1][1]); w.w = cvt_pk_bf16(o[1][2], o[1][3]);
                    *(u32x4*)(dst + (row0 + ai * HALF + m * 16) * D + cb + col8) = w;
                }
        }
    }
};
__device__ __forceinline__ void phase1(const Params& p, LAS unsigned char* lds) {
    LAS bf16_t* sbias = (LAS bf16_t*)(lds + STAGE_BYTES); LAS float* slb = (LAS float*)(lds + STAGE_BYTES + 16384);
    for (int i = threadIdx.x; i < 8192; i += NTHR) sbias[i] = f2bf(p.bperm[i]);
    for (int i = threadIdx.x; i < 1024; i += NTHR) slb[i] = p.lb[i];
    __syncthreads();
    Sched1 S{(int)gridDim.x, (int)blockIdx.x}; Epi1 E{sbias, slb, p.Qh, p.Kh, p.Vv, p.G1, p.LX, p.G2, p.Dk};
    gemm_phase(lds, p.h0, p.Bt_in, D, S, E);
}

__device__ __forceinline__ void phase4(const Params& p, LAS unsigned char* lds) {
    constexpr int ASTR = 2064;
    LAS unsigned char* Aimg = lds;
    LAS float* sc = (LAS float*)(lds + 64 * ASTR);
    LAS int* asg_e = (LAS int*)(lds + 64 * ASTR + 16384);
    LAS float* asg_w = (LAS float*)(asg_e + 384);
    LAS int* asg_r = (LAS int*)(asg_w + 384);
    LAS int* cntL = asg_r + 384;
    LAS int* baseL = cntL + 64;
    const int tid = tid_opaque(), wv = tid >> 6, lane = tid & 63;
    bf16x8 rwf[16];
#pragma unroll
    for (int ks = 0; ks < 16; ++ks) rwf[ks] = *(const bf16x8*)(p.Bt_r + (size_t)((wv & 3) * 16 + (lane & 15)) * D + 512 * (wv >> 2) + 32 * ks + 8 * (lane >> 4));
    f32x4 g1v[4], b1v[4];
#pragma unroll
    for (int j = 0; j < 4; ++j) { g1v[j] = *(const f32x4*)(p.ln1_g + j * 256 + lane * 4); b1v[j] = *(const f32x4*)(p.ln1_b + j * 256 + lane * 4); }
    for (int tile = blockIdx.x; tile < T / 64; tile += gridDim.x) {
        if (tid < 64) cntL[tid] = 0;
        *(LAS f32x4*)(sc + tid * 8) = (f32x4){0.f, 0.f, 0.f, 0.f}; *(LAS f32x4*)(sc + tid * 8 + 4) = (f32x4){0.f, 0.f, 0.f, 0.f};
        u32x2 vn[4];
#pragma unroll
        for (int j = 0; j < 4; ++j) vn[j] = *(const u32x2*)(p.pre1 + ((size_t)tile * 64 + wv * 8) * D + j * 256 + lane * 4);
        for (int i = 0; i < 8; ++i) {
            const int tl = wv * 8 + i; const size_t tok = (size_t)tile * 64 + tl;
            f32x4 v[4]; float s = 0.f;
#pragma unroll
            for (int j = 0; j < 4; ++j) { v[j] = (f32x4){__uint_as_float(vn[j].x << 16), __uint_as_float(vn[j].x & 0xffff0000u), __uint_as_float(vn[j].y << 16), __uint_as_float(vn[j].y & 0xffff0000u)}; s += (v[j][0] + v[j][1]) + (v[j][2] + v[j][3]); }
            { const size_t tokn = tok + (i < 7 ? 1 : 0);
#pragma unroll
              for (int j = 0; j < 4; ++j) vn[j] = *(const u32x2*)(p.pre1 + tokn * D + j * 256 + lane * 4); }
            const float mean = wave_sum(s) * (1.0f / D);
            float q = 0.f;
#pragma unroll
            for (int j = 0; j < 4; ++j) { const f32x4 d = v[j] - mean; q += (d[0] * d[0] + d[1] * d[1]) + (d[2] * d[2] + d[3] * d[3]); }
            const float rstd = rsqrtf(wave_sum(q) * (1.0f / D) + 1e-5f);
#pragma unroll
            for (int j = 0; j < 4; ++j) {
                const int c0 = j * 256 + lane * 4;
                const f32x4 o = (v[j] - mean) * rstd * g1v[j] + b1v[j];
                const u32x2 w = (u32x2){cvt_pk_bf16(o[0], o[1]), cvt_pk_bf16(o[2], o[3])};
                *(u32x2*)(p.h1 + tok * D + c0) = w;
                *(LAS u32x2*)(Aimg + tl * ASTR + c0 * 2) = w;
            }
        }
        __syncthreads();
        {
            const int fr = lane & 15, fq = lane >> 4, nt = wv & 3, kh = wv >> 2;
            f32x4 ac[4];
#pragma unroll
            for (int mt = 0; mt < 4; ++mt) ac[mt] = (f32x4){0.f, 0.f, 0.f, 0.f};
#pragma unroll
            for (int ks = 0; ks < 16; ++ks)
#pragma unroll
                for (int mt = 0; mt < 4; ++mt) {
                    const bf16x8 a = *(const LAS bf16x8*)(Aimg + (mt * 16 + fr) * ASTR + (512 * kh + 32 * ks + 8 * fq) * 2);
                    ac[mt] = __builtin_amdgcn_mfma_f32_16x16x32_bf16(a, rwf[ks], ac[mt], 0, 0, 0);
                }
#pragma unroll
            for (int mt = 0; mt < 4; ++mt)
#pragma unroll
                for (int r = 0; r < 4; ++r) __hip_atomic_fetch_add(sc + (mt * 16 + fq * 4 + r) * 64 + nt * 16 + fr, ac[mt][r], __ATOMIC_RELAXED, __HIP_MEMORY_SCOPE_WORKGROUP);
        }
        __syncthreads();
        const float rb = p.router_b[lane];
        for (int i = 0; i < 8; ++i) {
            const int tl = wv * 8 + i; const size_t tok = (size_t)tile * 64 + tl;
            const float sg = fast_sigmoid(sc[tl * 64 + lane]);
            float sel = sg + rb; float ssum = 0.f; int my_e = 0; float my_s = 0.f;
#pragma unroll
            for (int kk = 0; kk < TOPK; ++kk) {
                const int NEG = (int)0xff800000u;
                float v = sel;
                v = fmaxf(v, __int_as_float(__builtin_amdgcn_update_dpp(NEG, __float_as_int(v), 0x111, 0xF, 0xF, false)));
                v = fmaxf(v, __int_as_float(__builtin_amdgcn_update_dpp(NEG, __float_as_int(v), 0x112, 0xF, 0xF, false)));
                v = fmaxf(v, __int_as_float(__builtin_amdgcn_update_dpp(NEG, __float_as_int(v), 0x114, 0xF, 0xF, false)));
                v = fmaxf(v, __int_as_float(__builtin_amdgcn_update_dpp(NEG, __float_as_int(v), 0x118, 0xF, 0xF, false)));
                v = fmaxf(v, __int_as_float(__builtin_amdgcn_update_dpp(NEG, __float_as_int(v), 0x142, 0xA, 0xF, false)));
                v = fmaxf(v, __int_as_float(__builtin_amdgcn_update_dpp(NEG, __float_as_int(v), 0x143, 0xC, 0xF, false)));
                const float mx = __int_as_float(__builtin_amdgcn_readlane(__float_as_int(v), 63));
                const unsigned long long mk = __ballot(sel == mx);
                const int bi = __builtin_amdgcn_readfirstlane((int)__builtin_ctzll(mk));
                const float ws = __int_as_float(__builtin_amdgcn_readlane(__float_as_int(sg), bi)); ssum += ws;
                if (lane == kk) { my_e = bi; my_s = ws; }
                if (lane == bi) sel = -3.0e38f;
            }
            if (lane < TOPK) {
                const float w = my_s / ssum * 2.5f;
                asg_e[tl * TOPK + lane] = my_e; asg_w[tl * TOPK + lane] = w;
                p.ridx[tok * TOPK + lane] = my_e; p.rwts[tok * TOPK + lane] = w;
            }
        }
        __syncthreads();
        if (tid < 384) asg_r[tid] = __hip_atomic_fetch_add(cntL + asg_e[tid], 1, __ATOMIC_RELAXED, __HIP_MEMORY_SCOPE_WORKGROUP);
        __syncthreads();
        if (tid < 64) { const int c = cntL[tid]; baseL[tid] = c ? __hip_atomic_fetch_add(p.cnt + tid * 64, c, __ATOMIC_RELAXED, __HIP_MEMORY_SCOPE_AGENT) : 0; }
        __syncthreads();
        if (tid < 384) { const int e = asg_e[tid]; const int slot = baseL[e] + asg_r[tid]; p.list_tok[(size_t)e * T + slot] = tile * 384 + tid; p.list_w[(size_t)e * T + slot] = asg_w[tid]; }
        __syncthreads();
    }
}

constexpr int ACT_S_ROW0 = 832 * 256;
__device__ __forceinline__ void moe_table(const Params& p, LAS unsigned char* lds) {
    LAS int* tb = (LAS int*)(lds + STAGE_BYTES); LAS int* ce = tb + 80;
    const int tm = tid_opaque();
    if (tm < 64) {
        const int lane = tm; const int c = p.cnt[lane * 64]; const int tl = (c + 255) >> 8;
        int s = tl;
#pragma unroll
        for (int o = 1; o < 64; o <<= 1) { const int t = __shfl_up(s, o); if (lane >= o) s += t; }
        tb[lane] = s - tl; ce[lane] = c; if (lane == 63) tb[64] = s;
    }
    __syncthreads();
}
template <int NCU  >
struct SchedMoe {
    int G, c; const LAS int* tb; const LAS int* ce; const int* list_tok; long long sh_boff; long long e_stride; int K;
    __device__ __forceinline__ bool next(int i, Unit& u) const {
        const int NT = __builtin_amdgcn_readfirstlane(tb[64]); const int L = i * G + c;
        if (L >= NCU * NT + NCU * 128) return false;
        if (L < NCU * NT) {
            int t, j; tile_order(L, NT, NCU, t, j, MOE_WGM);
            int lane = threadIdx.x & 63; asm volatile("" : "+v"(lane));
            const unsigned long long mk = __ballot(tb[lane] <= t);
            const int e = __builtin_amdgcn_readfirstlane((int)__popcll(mk) - 1);
            const int tbe = __builtin_amdgcn_readfirstlane(tb[e]);
            u.e = e; u.r = t - tbe; u.pm = t; u.pn = j; u.a0 = t * 256; u.boff = (long long)e * e_stride + (long long)j * 256 * K * 2;
        } else {
            int pm, j; tile_order(L - NCU * NT, 128, NCU, pm, j, MOE_WGM);
            u.e = -1; u.r = 0; u.pm = pm; u.pn = j; u.a0 = ACT_S_ROW0 + pm * 256; u.boff = sh_boff + (long long)j * 256 * K * 2;
        }
        return true;
    }
    __device__ __forceinline__ void a_off(const Unit& u, const int (&R)[2], const int (&C)[2], int K_, unsigned (&v0)[2], unsigned (&v1)[2]) const {
        if (NCU == 4) {
#pragma unroll
            for (int i = 0; i < 2; ++i) { v0[i] = (unsigned)((u.a0 + R[i]) * K_ + C[i]) * 2u; v1[i] = (unsigned)((u.a0 + HALF + R[i]) * K_ + C[i]) * 2u; }
        } else if (u.e < 0) {
#pragma unroll
            for (int i = 0; i < 2; ++i) { v0[i] = (unsigned)((u.pm * 256 + R[i]) * K_ + C[i]) * 2u; v1[i] = (unsigned)((u.pm * 256 + HALF + R[i]) * K_ + C[i]) * 2u; }
        } else {
            const int n = __builtin_amdgcn_readfirstlane(ce[u.e]); const int* lt = list_tok + (size_t)u.e * T;
#pragma unroll
            for (int i = 0; i < 2; ++i) {
                const int s0 = u.r * 256 + R[i], s1 = s0 + HALF;
                const int t0 = s0 < n ? lt[s0] / TOPK : 0, t1 = s1 < n ? lt[s1] / TOPK : 0;
                v0[i] = (unsigned)(t0 * K_ + C[i]) * 2u; v1[i] = (unsigned)(t1 * K_ + C[i]) * 2u;
            }
        }
    }
};
struct Epi5 {
    static constexpr int PERM = 1;
    const LAS int* ce; const float* __restrict__ list_w; bf16_t* __restrict__ act;
    __device__ __forceinline__ void operator()(const f32x4 (&acc)[2][2][4][2], const Unit& u, int wr, int wc, int fr, int fq) const {
        int col8 = wc * 32 + fq * 8, rit = wr * 64 + fr;
        asm volatile("" : "+v"(col8), "+v"(rit));
        float w[2][4];
        if (u.e >= 0) {
            const int n = __builtin_amdgcn_readfirstlane(ce[u.e]); const float* lw = list_w + (size_t)u.e * T + u.r * 256;
#pragma unroll
            for (int ai = 0; ai < 2; ++ai)
#pragma unroll
                for (int m = 0; m < 4; ++m) { const int s = ai * HALF + m * 16 + rit; w[ai][m] = (u.r * 256 + s < n) ? lw[s] : 0.f; }
        } else {
#pragma unroll
            for (int ai = 0; ai < 2; ++ai)
#pragma unroll
                for (int m = 0; m < 4; ++m) w[ai][m] = 1.0f;
        }
        bf16_t* ob = act + ((size_t)u.a0 + rit) * DE + u.pn * 128 + col8;
#pragma unroll
        for (int ai = 0; ai < 2; ++ai)
#pragma unroll
            for (int m = 0; m < 4; ++m) {
                float o[2][4];
#pragma unroll
                for (int n = 0; n < 2; ++n)
#pragma unroll
                    for (int j = 0; j < 4; ++j) { const float g = acc[ai][0][m][n][j], uu = acc[ai][1][m][n][j]; o[n][j] = g * fast_sigmoid(g) * uu * w[ai][m]; }
                u32x4 wv; wv.x = cvt_pk_bf16(o[0][0], o[0][1]); wv.y = cvt_pk_bf16(o[0][2], o[0][3]); wv.z = cvt_pk_bf16(o[1][0], o[1][1]); wv.w = cvt_pk_bf16(o[1][2], o[1][3]);
                *(u32x4*)(ob + (size_t)(ai * HALF + m * 16) * DE) = wv;
            }
    }
};
constexpr float YSCALE = 16.0f;
struct Epi6 {
    static constexpr int PERM = 2;
    const LAS int* ce; const int* __restrict__ list_tok; unsigned char* __restrict__ yrows; const bf16_t* __restrict__ h1; bf16_t* __restrict__ base;
    __device__ __forceinline__ void operator()(const f32x4 (&acc)[2][2][4][2], const Unit& u, int wr, int wc, int fr, int fq) const {
        int col16 = wc * 64 + fq * 16, rit = wr * 64 + fr;
        asm volatile("" : "+v"(col16), "+v"(rit));
        if (u.e >= 0) {
            const int n = __builtin_amdgcn_readfirstlane(ce[u.e]); const int* lt = list_tok + (size_t)u.e * T + u.r * 256;
            int aid[2][4];
#pragma unroll
            for (int ai = 0; ai < 2; ++ai)
#pragma unroll
                for (int m = 0; m < 4; ++m) { const int s = ai * HALF + m * 16 + rit; aid[ai][m] = (u.r * 256 + s < n) ? lt[s] : -1; }
#pragma unroll
            for (int ai = 0; ai < 2; ++ai)
#pragma unroll
                for (int m = 0; m < 4; ++m) {
                    if (aid[ai][m] < 0) continue;
                    int wd[4];
#pragma unroll
                    for (int bj = 0; bj < 2; ++bj) {
                        const f32x4 v0 = acc[ai][bj][m][0] * YSCALE, v1 = acc[ai][bj][m][1] * YSCALE;
                        int w0 = 0, w1 = 0;
                        w0 = __builtin_amdgcn_cvt_pk_fp8_f32(v0[0], v0[1], w0, false); w0 = __builtin_amdgcn_cvt_pk_fp8_f32(v0[2], v0[3], w0, true);
                        w1 = __builtin_amdgcn_cvt_pk_fp8_f32(v1[0], v1[1], w1, false); w1 = __builtin_amdgcn_cvt_pk_fp8_f32(v1[2], v1[3], w1, true);
                        wd[2 * bj] = w0; wd[2 * bj + 1] = w1;
                    }
                    *(u32x4*)(yrows + (size_t)aid[ai][m] * D + u.pn * 256 + col16) = (u32x4){(unsigned)wd[0], (unsigned)wd[1], (unsigned)wd[2], (unsigned)wd[3]};
                }
        } else {
            const size_t tok0 = (size_t)u.pm * 256 + rit;
            const int c0 = u.pn * 256 + col16;
#pragma unroll
            for (int ai = 0; ai < 2; ++ai) {
                u32x4 hv[4][2];
#pragma unroll
                for (int m = 0; m < 4; ++m)
#pragma unroll
                    for (int bj = 0; bj < 2; ++bj) hv[m][bj] = *(const u32x4*)(h1 + (tok0 + ai * HALF + m * 16) * D + c0 + bj * 8);
#pragma unroll
                for (int m = 0; m < 4; ++m)
#pragma unroll
                    for (int bj = 0; bj < 2; ++bj) {
                        const u32x4 h = hv[m][bj]; const f32x4 v0 = acc[ai][bj][m][0], v1 = acc[ai][bj][m][1];
                        u32x4 w;
                        w.x = cvt_pk_bf16(v0[0] + ALPHA * __uint_as_float(h.x << 16), v0[1] + ALPHA * __uint_as_float(h.x & 0xffff0000u));
                        w.y = cvt_pk_bf16(v0[2] + ALPHA * __uint_as_float(h.y << 16), v0[3] + ALPHA * __uint_as_float(h.y & 0xffff0000u));
                        w.z = cvt_pk_bf16(v1[0] + ALPHA * __uint_as_float(h.z << 16), v1[1] + ALPHA * __uint_as_float(h.z & 0xffff0000u));
                        w.w = cvt_pk_bf16(v1[2] + ALPHA * __uint_as_float(h.w << 16), v1[3] + ALPHA * __uint_as_float(h.w & 0xffff0000u));
                        *(u32x4*)(base + (tok0 + ai * HALF + m * 16) * D + c0 + bj * 8) = w;
                    }
                asm volatile("" ::: "memory");
            }
        }
    }
};
__device__ __forceinline__ void phase5(const Params& p, LAS unsigned char* lds) {
    moe_table(p, lds);
    const LAS int* tb = (const LAS int*)(lds + STAGE_BYTES); const LAS int* ce = tb + 80;
    SchedMoe<2> S{(int)gridDim.x, (int)blockIdx.x, tb, ce, p.list_tok, (long long)((const char*)p.Bt_sgu - (const char*)p.Bt_gu), (long long)512 * D * 2, D};
    Epi5 E{ce, p.list_w, p.act};
    gemm_phase(lds, p.h1, p.Bt_gu, D, S, E);
}
__device__ __forceinline__ void phase6(const Params& p, LAS unsigned char* lds) {
    moe_table(p, lds);
    const LAS int* tb = (const LAS int*)(lds + STAGE_BYTES); const LAS int* ce = tb + 80;
    SchedMoe<4> S{(int)gridDim.x, (int)blockIdx.x, tb, ce, p.list_tok, (long long)((const char*)p.Bt_sd - (const char*)p.Bt_d), (long long)D * DE * 2, DE};
    Epi6 E{ce, p.list_tok, p.yrows, p.h1, p.base};
    gemm_phase(lds, p.act, p.Bt_d, DE, S, E);
}
__device__ __forceinline__ void phase7(const Params& p) {
    const int tid7 = tid_opaque(); const int wv = tid7 >> 6, lane = tid7 & 63;
    const int c0 = lane * 16;
    f32x4 g[4], b[4];
#pragma unroll
    for (int q = 0; q < 4; ++q) { g[q] = *(const f32x4*)(p.ln2_g + c0 + q * 4); b[q] = *(const f32x4*)(p.ln2_b + c0 + q * 4); }
    u32x4 nb0, nb1, ny[TOPK];
    {
        const int tok = blockIdx.x * 8 + wv;
        nb0 = *(const u32x4*)(p.base + (size_t)tok * D + c0); nb1 = *(const u32x4*)(p.base + (size_t)tok * D + c0 + 8);
#pragma unroll
        for (int k = 0; k < TOPK; ++k) ny[k] = *(const u32x4*)(p.yrows + ((size_t)tok * TOPK + k) * D + c0);
    }
    for (int tok = blockIdx.x * 8 + wv; tok < T; tok += gridDim.x * 8) {
        const u32x4 b0 = nb0, b1 = nb1;
        u32x4 y[TOPK];
#pragma unroll
        for (int k = 0; k < TOPK; ++k) y[k] = ny[k];
        {
            const int tn = tok + (int)gridDim.x * 8 < T ? tok + (int)gridDim.x * 8 : tok;
            nb0 = *(const u32x4*)(p.base + (size_t)tn * D + c0); nb1 = *(const u32x4*)(p.base + (size_t)tn * D + c0 + 8);
#pragma unroll
            for (int k = 0; k < TOPK; ++k) ny[k] = *(const u32x4*)(p.yrows + ((size_t)tn * TOPK + k) * D + c0);
        }
        float r[16];
#pragma unroll
        for (int q = 0; q < 16; ++q) r[q] = 0.f;
#pragma unroll
        for (int k = 0; k < TOPK; ++k)
#pragma unroll
            for (int q = 0; q < 4; ++q) {
                const int wd = (int)y[k][q];
                const auto lo = __builtin_amdgcn_cvt_pk_f32_fp8(wd, false); const auto hi = __builtin_amdgcn_cvt_pk_f32_fp8(wd, true);
                r[q * 4 + 0] += lo[0]; r[q * 4 + 1] += lo[1]; r[q * 4 + 2] += hi[0]; r[q * 4 + 3] += hi[1];
            }
        float v[16];
#pragma unroll
        for (int q = 0; q < 4; ++q) {
            const unsigned w0 = q < 2 ? b0[q * 2] : b1[(q - 2) * 2], w1 = q < 2 ? b0[q * 2 + 1] : b1[(q - 2) * 2 + 1];
            v[q * 4 + 0] = __uint_as_float(w0 << 16) + r[q * 4 + 0] * (1.0f / YSCALE); v[q * 4 + 1] = __uint_as_float(w0 & 0xffff0000u) + r[q * 4 + 1] * (1.0f / YSCALE);
            v[q * 4 + 2] = __uint_as_float(w1 << 16) + r[q * 4 + 2] * (1.0f / YSCALE); v[q * 4 + 3] = __uint_as_float(w1 & 0xffff0000u) + r[q * 4 + 3] * (1.0f / YSCALE);
        }
        float s = 0.f;
#pragma unroll
        for (int q = 0; q < 16; ++q) s += v[q];
        const float mean = wave_sum(s) * (1.0f / D);
        float qq = 0.f;
#pragma unroll
        for (int q = 0; q < 16; ++q) { const float d = v[q] - mean; qq += d * d; }
        const float rstd = rsqrtf(wave_sum(qq) * (1.0f / D) + 1e-5f);
#pragma unroll
        for (int q = 0; q < 4; ++q) {
            f32x4 o;
#pragma unroll
            for (int j = 0; j < 4; ++j) o[j] = (v[q * 4 + j] - mean) * rstd * g[q][j] + b[q][j];
            *(f32x4*)(p.out + (size_t)tok * D + c0 + q * 4) = o;
        }
    }
}

typedef float f32x16 __attribute__((ext_vector_type(16)));
#define CROW(i, h) (((i) & 3) + 8 * ((i) >> 2) + 4 * (h))
__device__ __forceinline__ f32x16 mfma32(bf16x8 a, bf16x8 b, f32x16 c) { return __builtin_amdgcn_mfma_f32_32x32x16_bf16(a, b, c, 0, 0, 0); }
__device__ __forceinline__ bf16_t f2bf_fast(float f) { return (bf16_t)(cvt_pk_bf16(f, f) & 0xffffu); }
__device__ __forceinline__ void unpack8(const u32x4 v, float (&o)[8]) {
    o[0] = __uint_as_float(v.x << 16); o[1] = __uint_as_float(v.x & 0xffff0000u); o[2] = __uint_as_float(v.y << 16); o[3] = __uint_as_float(v.y & 0xffff0000u);
    o[4] = __uint_as_float(v.z << 16); o[5] = __uint_as_float(v.z & 0xffff0000u); o[6] = __uint_as_float(v.w << 16); o[7] = __uint_as_float(v.w & 0xffff0000u);
}
__device__ __forceinline__ void lru_chain(const Params& p, LAS unsigned char* lds, const int b, const int n, const bool dry = false) {
    constexpr int WSTR = 272, XSTR = 272;
    LAS unsigned char* WA = lds;
    LAS unsigned char* WX = lds + 128 * WSTR;
    LAS unsigned char* XC = lds + 2 * 128 * WSTR;
    LAS unsigned char* O2 = XC + 64 * XSTR;
    LAS float* CW = (LAS float*)(O2 + 64 * 256);
    LAS float* LSA = CW + 640;
    LAS float* LSU = LSA + 256;
    LAS float* CAR = LSU + 256;
    const int tid = threadIdx.x, w = __builtin_amdgcn_readfirstlane(tid >> 6), lane = tid & 63, r = lane & 31, h = lane >> 5, tau = w & 1, q4 = w >> 1;
    const int CB = n * 128;
    for (int i = tid; i < 128 * 16; i += NTHR) {
        const int row = i >> 4, pc = i & 15;
        *(LAS u32x4*)(WA + row * WSTR + pc * 16) = *(const u32x4*)(p.Bt_wa + ((size_t)n * 128 + row) * 128 + pc * 8);
        *(LAS u32x4*)(WX + row * WSTR + pc * 16) = *(const u32x4*)(p.Bt_wx + ((size_t)n * 128 + row) * 128 + pc * 8);
    }
    for (int i = tid; i < 640; i += NTHR) { const int j = i >> 7, c = i & 127; CW[i] = j < 4 ? p.conv_w[j * D + CB + c] : p.conv_b[CB + c]; }
    if (tid < 256) CAR[tid] = 0.f;
    const int dcol = CB + q4 * 32 + r;
    const float bav = p.lru_ba[dcol], bxv = p.lru_bx[dcol];
    const float c2 = -8.0f * log1pf(expf(-p.lru_lam[dcol])) * 1.4426950408889634f;
    const int cg = tid & 15, tg = tid >> 4, crow = tid >> 3, cseg = (tid & 7) * 16;
    u32x4 lx[5]; u32x4 g2[2];
    auto prefetch_lx = [&](int c) {
#pragma unroll
        for (int j = 0; j < 5; ++j) { int pos = c * 64 + 2 * tg - 3 + j; pos = pos < 0 ? 0 : pos; lx[j] = *(const u32x4*)(p.LX + ((size_t)b * LP + pos) * D + CB + cg * 8); }
    };
    auto prefetch_g2 = [&](int c) {
        const size_t R0 = (size_t)b * LP + c * 64;
        g2[0] = *(const u32x4*)(p.G2 + (R0 + crow) * D + CB + cseg); g2[1] = *(const u32x4*)(p.G2 + (R0 + crow) * D + CB + cseg + 8);
    };
    prefetch_lx(0); prefetch_g2(0);
    __syncthreads();
    for (int c = 0; c < NCH; ++c) {
        const size_t R0 = (size_t)b * LP + c * 64; const int par = c & 1;
        {
            float x[5][8];
#pragma unroll
            for (int j = 0; j < 5; ++j) { unpack8(lx[j], x[j]);
                if (c == 0 && 2 * tg - 3 + j < PADR) {
#pragma unroll
                    for (int e = 0; e < 8; ++e) x[j][e] = 0.f; } }
            float cw[5][8];
#pragma unroll
            for (int j = 0; j < 5; ++j) { const f32x4 a = *(const LAS f32x4*)(CW + j * 128 + cg * 8), bq = *(const LAS f32x4*)(CW + j * 128 + cg * 8 + 4);
                cw[j][0] = a[0]; cw[j][1] = a[1]; cw[j][2] = a[2]; cw[j][3] = a[3]; cw[j][4] = bq[0]; cw[j][5] = bq[1]; cw[j][6] = bq[2]; cw[j][7] = bq[3]; }
#pragma unroll
            for (int rr = 0; rr < 2; ++rr) {
                float y[8];
#pragma unroll
                for (int e = 0; e < 8; ++e) y[e] = __builtin_fmaf(cw[3][e], x[rr + 3][e], __builtin_fmaf(cw[2][e], x[rr + 2][e], __builtin_fmaf(cw[1][e], x[rr + 1][e], __builtin_fmaf(cw[0][e], x[rr][e], cw[4][e]))));
                u32x4 o; o.x = cvt_pk_bf16(y[0], y[1]); o.y = cvt_pk_bf16(y[2], y[3]); o.z = cvt_pk_bf16(y[4], y[5]); o.w = cvt_pk_bf16(y[6], y[7]);
                *(LAS u32x4*)(XC + (2 * tg + rr) * XSTR + cg * 16) = o;
            }
        }
        __syncthreads();
        prefetch_lx(c + 1 < NCH ? c + 1 : c);
        f32x16 Rg, Ig;
#pragma unroll
        for (int i = 0; i < 16; ++i) { Rg[i] = 0.f; Ig[i] = 0.f; }
#pragma unroll
        for (int ks = 0; ks < 8; ++ks) {
            const bf16x8 a = *(const LAS bf16x8*)(XC + (32 * tau + r) * XSTR + (16 * ks + 8 * h) * 2);
            const bf16x8 ba = *(const LAS bf16x8*)(WA + (32 * q4 + r) * WSTR + (16 * ks + 8 * h) * 2);
            const bf16x8 bx = *(const LAS bf16x8*)(WX + (32 * q4 + r) * WSTR + (16 * ks + 8 * h) * 2);
            Rg = mfma32(a, ba, Rg); Ig = mfma32(a, bx, Ig);
        }
        float av[16], uv[16];
#pragma unroll
        for (int i = 0; i < 16; ++i) {
            const int tl = 32 * tau + CROW(i, h);
            const float xcv = bf2f(*(const LAS bf16_t*)(XC + tl * XSTR + (32 * q4 + r) * 2));
            const float rr = fast_sigmoid(Rg[i] + bav), ii = fast_sigmoid(Ig[i] + bxv);
            float a = __builtin_amdgcn_exp2f(rr * c2);
            float u = __builtin_amdgcn_sqrtf(fmaxf(1.0f - a * a, 0.f)) * ii * xcv;
            if (c == 0 && tl < PADR) { a = 1.0f; u = 0.f; }
            av[i] = a; uv[i] = u;
        }
        float gA[4], gU[4];
#pragma unroll
        for (int g = 0; g < 4; ++g) {
            float cA = 1.0f, hl = 0.f;
#pragma unroll
            for (int j = 0; j < 4; ++j) { hl = av[4 * g + j] * hl + uv[4 * g + j]; cA *= av[4 * g + j]; av[4 * g + j] = cA; uv[4 * g + j] = hl; }
            gA[g] = cA; gU[g] = hl;
        }
        float rA = 1.0f, rU = 0.f;
#pragma unroll
        for (int g = 0; g < 4; ++g) {
            const float pA = __shfl_xor(gA[g], 32), pU = __shfl_xor(gU[g], 32);
            const float fA = h ? pA : gA[g], fU = h ? pU : gU[g];
            const float sA = h ? gA[g] : pA, sU = h ? gU[g] : pU;
            const float r1U = fA * rU + fU, r1A = fA * rA;
            const float stA = h ? r1A : rA, stU = h ? r1U : rU;
            rU = sA * r1U + sU; rA = sA * r1A;
#pragma unroll
            for (int j = 0; j < 4; ++j) { const float ca = av[4 * g + j]; uv[4 * g + j] = ca * stU + uv[4 * g + j]; av[4 * g + j] = ca * stA; }
        }
        if (tau == 0 && h == 0) { LSA[par * 128 + 32 * q4 + r] = rA; LSU[par * 128 + 32 * q4 + r] = rU; }
        __syncthreads();
        {
            const float cin = CAR[par * 128 + 32 * q4 + r];
            float hin = cin;
            if (tau == 1) { hin = LSA[par * 128 + 32 * q4 + r] * cin + LSU[par * 128 + 32 * q4 + r]; if (h == 0) CAR[(par ^ 1) * 128 + 32 * q4 + r] = rA * hin + rU; }
#pragma unroll
            for (int i = 0; i < 16; ++i) {
                const int tl = 32 * tau + CROW(i, h);
                *(LAS bf16_t*)(O2 + tl * 256 + (32 * q4 + r) * 2) = f2bf_fast(av[i] * hin + uv[i]);
            }
        }
        __syncthreads();
        {
            const u32x4 h0 = *(const LAS u32x4*)(O2 + crow * 256 + cseg * 2), h1 = *(const LAS u32x4*)(O2 + crow * 256 + cseg * 2 + 16);
            float hh[8], gg[8]; u32x4 o0, o1;
            unpack8(h0, hh); unpack8(g2[0], gg);
            o0.x = cvt_pk_bf16(hh[0] * gg[0], hh[1] * gg[1]); o0.y = cvt_pk_bf16(hh[2] * gg[2], hh[3] * gg[3]); o0.z = cvt_pk_bf16(hh[4] * gg[4], hh[5] * gg[5]); o0.w = cvt_pk_bf16(hh[6] * gg[6], hh[7] * gg[7]);
            unpack8(h1, hh); unpack8(g2[1], gg);
            o1.x = cvt_pk_bf16(hh[0] * gg[0], hh[1] * gg[1]); o1.y = cvt_pk_bf16(hh[2] * gg[2], hh[3] * gg[3]); o1.z = cvt_pk_bf16(hh[4] * gg[4], hh[5] * gg[5]); o1.w = cvt_pk_bf16(hh[6] * gg[6], hh[7] * gg[7]);
            if (!dry) { *(u32x4*)(p.G2 + (R0 + crow) * D + CB + cseg) = o0; *(u32x4*)(p.G2 + (R0 + crow) * D + CB + cseg + 8) = o1; }
            prefetch_g2(c + 1 < NCH ? c + 1 : 0);
        }
    }
    __syncthreads();
}
__device__ __forceinline__ void hgrn_chain(const Params& p, LAS unsigned char* lds, const int b, const int hd, const bool dry = false) {
    constexpr int QSTR = 272, TSTR = 144;
    LAS unsigned char* Qi = lds;
    LAS unsigned char* Ki = Qi + 64 * QSTR;
    LAS unsigned char* Kt = Ki + 64 * QSTR;
    LAS unsigned char* Vt = Kt + 128 * TSTR;
    LAS unsigned char* St = Vt + 128 * TSTR;
    LAS unsigned char* Pi = St + 128 * QSTR;
    LAS unsigned char* O1 = Pi + 64 * TSTR;
    LAS float* Df = (LAS float*)(O1 + 64 * 256);
    LAS float* ssL = Df + 128;
    const int tid = threadIdx.x, w = __builtin_amdgcn_readfirstlane(tid >> 6), lane = tid & 63, r = lane & 31, h = lane >> 5, tau = w & 1, q4 = w >> 1;
    const int CB = hd * 128;
    for (int i = tid; i < 128 * QSTR / 16; i += NTHR) *(LAS u32x4*)(St + i * 16) = (u32x4){0u, 0u, 0u, 0u};
    if (tid < 64) ssL[tid] = 0.f;
    f32x16 Sacc[2];
#pragma unroll
    for (int i2 = 0; i2 < 2; ++i2)
#pragma unroll
        for (int i = 0; i < 16; ++i) Sacc[i2][i] = 0.f;
    const float ngv = p.hg_ng[q4 * 32 + r];
    const int crow = tid >> 3, cseg = (tid & 7) * 16;
    const int trow = lane, tseg = w * 16;
    u32x4 pq[2], pk[2], pv[2], pg[2], pz[2]; float pd = 0.f;
    auto prefetch = [&](int c) {
        const size_t R0 = (size_t)b * LP + c * 64;
        pq[0] = *(const u32x4*)(p.Qh + (R0 + crow) * D + CB + cseg); pq[1] = *(const u32x4*)(p.Qh + (R0 + crow) * D + CB + cseg + 8);
        pk[0] = *(const u32x4*)(p.Kh + (R0 + trow) * D + CB + tseg); pk[1] = *(const u32x4*)(p.Kh + (R0 + trow) * D + CB + tseg + 8);
        pv[0] = *(const u32x4*)(p.Vv + (R0 + trow) * D + CB + tseg); pv[1] = *(const u32x4*)(p.Vv + (R0 + trow) * D + CB + tseg + 8);
        pd = p.Dk[((size_t)b * NCH + c) * D + CB + (tid & 127)];
    };
    auto prefetch_g = [&](int c) {
        const size_t R0 = (size_t)b * LP + c * 64;
        pg[0] = *(const u32x4*)(p.G1 + (R0 + crow) * D + CB + cseg); pg[1] = *(const u32x4*)(p.G1 + (R0 + crow) * D + CB + cseg + 8);
        pz[0] = *(const u32x4*)(p.G2 + (R0 + crow) * D + CB + cseg); pz[1] = *(const u32x4*)(p.G2 + (R0 + crow) * D + CB + cseg + 8);
    };
    prefetch(0); prefetch_g(0);
    __syncthreads();
    for (int c = 0; c < NCH; ++c) {
        const size_t R0 = (size_t)b * LP + c * 64;
        *(LAS u32x4*)(Qi + crow * QSTR + cseg * 2) = pq[0]; *(LAS u32x4*)(Qi + crow * QSTR + cseg * 2 + 16) = pq[1];
        *(LAS u32x4*)(Ki + trow * QSTR + tseg * 2) = pk[0]; *(LAS u32x4*)(Ki + trow * QSTR + tseg * 2 + 16) = pk[1];
        {
            const unsigned kw[8] = {pk[0].x, pk[0].y, pk[0].z, pk[0].w, pk[1].x, pk[1].y, pk[1].z, pk[1].w};
            const unsigned vw[8] = {pv[0].x, pv[0].y, pv[0].z, pv[0].w, pv[1].x, pv[1].y, pv[1].z, pv[1].w};
#pragma unroll
            for (int e = 0; e < 8; ++e) {
                *(LAS bf16_t*)(Kt + (tseg + 2 * e) * TSTR + trow * 2) = (bf16_t)(kw[e] & 0xffffu); *(LAS bf16_t*)(Kt + (tseg + 2 * e + 1) * TSTR + trow * 2) = (bf16_t)(kw[e] >> 16);
                *(LAS bf16_t*)(Vt + (tseg + 2 * e) * TSTR + trow * 2) = (bf16_t)(vw[e] & 0xffffu); *(LAS bf16_t*)(Vt + (tseg + 2 * e + 1) * TSTR + trow * 2) = (bf16_t)(vw[e] >> 16);
            }
        }
        if (tid < 128) Df[tid] = pd;
        __syncthreads();
        prefetch(c + 1 < NCH ? c + 1 : c);
        if (w < 3) {
            const int tx = w ? 1 : 0, sx = w == 2 ? 1 : 0;
            f32x16 X;
#pragma unroll
            for (int i = 0; i < 16; ++i) X[i] = 0.f;
#pragma unroll
            for (int ks = 0; ks < 8; ++ks) {
                const bf16x8 a = *(const LAS bf16x8*)(Qi + (32 * tx + r) * QSTR + (16 * ks + 8 * h) * 2);
                const bf16x8 bb = *(const LAS bf16x8*)(Ki + (32 * sx + r) * QSTR + (16 * ks + 8 * h) * 2);
                X = mfma32(a, bb, X);
            }
#pragma unroll
            for (int i = 0; i < 16; ++i) {
                const int tl = CROW(i, h);
                const float v = (tx == sx && r > tl) ? 0.f : X[i];
                *(LAS bf16_t*)(Pi + (32 * tx + tl) * TSTR + (32 * sx + r) * 2) = f2bf_fast(v);
            }
        }
        __syncthreads();
        f32x16 O;
#pragma unroll
        for (int i = 0; i < 16; ++i) O[i] = 0.f;
        for (int ks = 0; ks < 2 * (tau + 1); ++ks) {
            const bf16x8 a = *(const LAS bf16x8*)(Pi + (32 * tau + r) * TSTR + (16 * ks + 8 * h) * 2);
            const bf16x8 bb = *(const LAS bf16x8*)(Vt + (32 * q4 + r) * TSTR + (16 * ks + 8 * h) * 2);
            O = mfma32(a, bb, O);
        }
#pragma unroll
        for (int ks = 0; ks < 8; ++ks) {
            const bf16x8 a = *(const LAS bf16x8*)(Qi + (32 * tau + r) * QSTR + (16 * ks + 8 * h) * 2);
            const bf16x8 bb = *(const LAS bf16x8*)(St + (32 * q4 + r) * QSTR + (16 * ks + 8 * h) * 2);
            O = mfma32(a, bb, O);
        }
        {
            float x[16];
#pragma unroll
            for (int i = 0; i < 16; ++i) x[i] = O[i] * O[i];
#pragma unroll
            for (int i = 0; i < 8; ++i) { const float snd = (lane & 16) ? x[i] : x[i + 8]; const float rcv = __shfl_xor(snd, 16); x[i] = ((lane & 16) ? x[i + 8] : x[i]) + rcv; }
#pragma unroll
            for (int i = 0; i < 4; ++i) { const float snd = (lane & 8) ? x[i] : x[i + 4]; const float rcv = __shfl_xor(snd, 8); x[i] = ((lane & 8) ? x[i + 4] : x[i]) + rcv; }
#pragma unroll
            for (int i = 0; i < 2; ++i) { const float snd = (lane & 4) ? x[i] : x[i + 2]; const float rcv = __shfl_xor(snd, 4); x[i] = ((lane & 4) ? x[i + 2] : x[i]) + rcv; }
            { const float snd = (lane & 2) ? x[0] : x[1]; const float rcv = __shfl_xor(snd, 2); x[0] = ((lane & 2) ? x[1] : x[0]) + rcv; }
            x[0] += __shfl_xor(x[0], 1);
            const int idx = ((lane >> 4) & 1) * 8 + ((lane >> 3) & 1) * 4 + ((lane >> 2) & 1) * 2 + ((lane >> 1) & 1);
            if ((lane & 1) == 0) __hip_atomic_fetch_add(ssL + 32 * tau + CROW(idx, h), x[0], __ATOMIC_RELAXED, __HIP_MEMORY_SCOPE_WORKGROUP);
        }
        __syncthreads();
#pragma unroll
        for (int g = 0; g < 4; ++g) {
            const f32x4 s4 = *(const LAS f32x4*)(ssL + 32 * tau + 8 * g + 4 * h);
#pragma unroll
            for (int j = 0; j < 4; ++j) {
                const float rt = rsqrtf(s4[j] * (1.0f / 128.0f) + 1e-6f);
                *(LAS bf16_t*)(O1 + (32 * tau + 8 * g + 4 * h + j) * 256 + (32 * q4 + r) * 2) = f2bf_fast(O[4 * g + j] * rt * ngv);
            }
        }
#pragma unroll
        for (int i2 = 0; i2 < 2; ++i2) {
            const int kap = 2 * tau + i2;
#pragma unroll
            for (int ks = 0; ks < 4; ++ks) {
                const bf16x8 a = *(const LAS bf16x8*)(Kt + (32 * kap + r) * TSTR + (16 * ks + 8 * h) * 2);
                const bf16x8 bb = *(const LAS bf16x8*)(Vt + (32 * q4 + r) * TSTR + (16 * ks + 8 * h) * 2);
                Sacc[i2] = mfma32(a, bb, Sacc[i2]);
            }
#pragma unroll
            for (int g = 0; g < 4; ++g) {
                const f32x4 d4 = *(const LAS f32x4*)(Df + 32 * kap + 8 * g + 4 * h);
#pragma unroll
                for (int j = 0; j < 4; ++j) Sacc[i2][4 * g + j] *= d4[j];
                *(LAS u32x2*)(St + (32 * q4 + r) * QSTR + (32 * kap + 8 * g + 4 * h) * 2) =
                    (u32x2){cvt_pk_bf16(Sacc[i2][4 * g], Sacc[i2][4 * g + 1]), cvt_pk_bf16(Sacc[i2][4 * g + 2], Sacc[i2][4 * g + 3])};
            }
        }
        __syncthreads();
        {
            if (tid < 64) ssL[tid] = 0.f;
            const u32x4 z0 = *(const LAS u32x4*)(O1 + crow * 256 + cseg * 2), z1 = *(const LAS u32x4*)(O1 + crow * 256 + cseg * 2 + 16);
            float oo[8], gg[8], zz[8]; u32x4 o0, o1;
            unpack8(z0, oo); unpack8(pg[0], gg); unpack8(pz[0], zz);
            o0.x = cvt_pk_bf16(oo[0] * gg[0] + zz[0], oo[1] * gg[1] + zz[1]); o0.y = cvt_pk_bf16(oo[2] * gg[2] + zz[2], oo[3] * gg[3] + zz[3]);
            o0.z = cvt_pk_bf16(oo[4] * gg[4] + zz[4], oo[5] * gg[5] + zz[5]); o0.w = cvt_pk_bf16(oo[6] * gg[6] + zz[6], oo[7] * gg[7] + zz[7]);
            unpack8(z1, oo); unpack8(pg[1], gg); unpack8(pz[1], zz);
            o1.x = cvt_pk_bf16(oo[0] * gg[0] + zz[0], oo[1] * gg[1] + zz[1]); o1.y = cvt_pk_bf16(oo[2] * gg[2] + zz[2], oo[3] * gg[3] + zz[3]);
            o1.z = cvt_pk_bf16(oo[4] * gg[4] + zz[4], oo[5] * gg[5] + zz[5]); o1.w = cvt_pk_bf16(oo[6] * gg[6] + zz[6], oo[7] * gg[7] + zz[7]);
            if (!dry) { *(u32x4*)(p.G1 + (R0 + crow) * D + CB + cseg) = o0; *(u32x4*)(p.G1 + (R0 + crow) * D + CB + cseg + 8) = o1; }
            prefetch_g(c + 1 < NCH ? c + 1 : 0);
        }
    }
    __syncthreads();
}
__device__ __forceinline__ f32x4 mfma16(bf16x8 a, bf16x8 b, f32x4 c) { return __builtin_amdgcn_mfma_f32_16x16x32_bf16(a, b, c, 0, 0, 0); }
__device__ __forceinline__ void unpack4(const u32x2 v, float (&o)[4]) {
    o[0] = __uint_as_float(v.x << 16); o[1] = __uint_as_float(v.x & 0xffff0000u); o[2] = __uint_as_float(v.y << 16); o[3] = __uint_as_float(v.y & 0xffff0000u);
}
typedef short v4i16 __attribute__((ext_vector_type(4)));
struct XStrip { const float* src; bf16_t* dst; int sld, dld, k0, n0, mode; };
__device__ __forceinline__ XStrip xstrip_decode(const Params& p, int sid) {
    XStrip s; const int j = sid >> 10, t = sid & 1023, e = t >> 4;
    if (j < 2) { s.src = (j ? p.we_up : p.we_gate) + (size_t)e * D * DE; s.sld = DE; s.k0 = (t & 15) * 64; s.n0 = 0; s.dst = p.Bt_gu + (size_t)e * 512 * D; s.dld = D; s.mode = j; }
    else { const int r = t & 15; s.src = p.we_down + (size_t)e * DE * D; s.sld = D; s.k0 = (r >> 2) * 64; s.n0 = (r & 3) * 256; s.dst = p.Bt_d + (size_t)e * D * DE; s.dld = DE; s.mode = 2; }
    return s;
}
__device__ __forceinline__ int xstrip_drow(int mode, int n) { return mode == 2 ? n : (n >> 7) * 256 + mode * 128 + (n & 127); }
__device__ __forceinline__ void bcast_rows(float x, float (&v)[4]) {
    const auto r = __builtin_amdgcn_permlane32_swap(__float_as_uint(x), __float_as_uint(x), false, false);
    const auto a = __builtin_amdgcn_permlane16_swap(r[0], r[0], false, false);
    const auto b = __builtin_amdgcn_permlane16_swap(r[1], r[1], false, false);
    v[0] = __uint_as_float(a[0]); v[1] = __uint_as_float(a[1]); v[2] = __uint_as_float(b[0]); v[3] = __uint_as_float(b[1]);
}
__device__ __forceinline__ void lru_chain_q(const Params& p, LAS unsigned char* lds, const int b, const int n, const int q, const bool dry = false, const bool do_strips = false) {
    constexpr int XSTR = 272;
    LAS unsigned char* XC = lds;
    LAS unsigned char* O2 = XC + 64 * XSTR;
    LAS float* CW = (LAS float*)(O2 + 64 * 64);
    LAS float* LSA = CW + 640;
    LAS float* LSU = LSA + 256;
    LAS float* CAR = LSU + 256;
    const int tid = tid_opaque(), w = __builtin_amdgcn_readfirstlane(tid >> 6), lane = tid & 63, c16 = lane & 15, qd = lane >> 4, tt = w >> 1, dh = w & 1;
    const int CB = n * 128;
    const int dl = 16 * dh + c16;
    const int dcol = CB + 32 * q + dl;
    for (int i = tid; i < 640; i += NTHR) { const int j = i >> 7, c = i & 127; CW[i] = j < 4 ? p.conv_w[j * D + CB + c] : p.conv_b[CB + c]; }
    if (tid < 64) CAR[tid] = 0.f;
    bf16x8 waf[4], wxf[4];
#pragma unroll
    for (int ks = 0; ks < 4; ++ks) {
        waf[ks] = *(const bf16x8*)(p.Bt_wa + ((size_t)n * 128 + 32 * q + dl) * 128 + 32 * ks + 8 * qd);
        wxf[ks] = *(const bf16x8*)(p.Bt_wx + ((size_t)n * 128 + 32 * q + dl) * 128 + 32 * ks + 8 * qd);
    }
    const float bav = p.lru_ba[dcol], bxv = p.lru_bx[dcol];
    const float c2 = -8.0f * log1pf(expf(-p.lru_lam[dcol])) * 1.4426950408889634f;
    const int cg = tid & 15, tg = tid >> 4, crow = tid >> 3, c4 = (tid & 7) * 4;
    u32x4 lx[5]; u32x2 g2;
    LAS float* TR = (LAS float*)(lds + 32768);
    f32x4 xa[4], xb[4];
#pragma unroll
    for (int t = 0; t < 4; ++t) { xa[t] = (f32x4){0.f, 0.f, 0.f, 0.f}; xb[t] = xa[t]; }
    auto prefetch_lx = [&](int c) {
#pragma unroll
        for (int j = 0; j < 5; ++j) { int pos = c * 64 + 2 * tg - 3 + j; pos = pos < 0 ? 0 : pos; lx[j] = *(const u32x4*)(p.LX + ((size_t)b * LP + pos) * D + CB + cg * 8); }
    };
    auto prefetch_g2 = [&](int c) { g2 = *(const u32x2*)(p.G2 + ((size_t)b * LP + c * 64 + crow) * D + CB + 32 * q + c4); };
    prefetch_lx(0); prefetch_g2(0);
    __syncthreads();
    float cw[5][8];
#pragma unroll
    for (int j = 0; j < 5; ++j) { const f32x4 a = *(const LAS f32x4*)(CW + j * 128 + cg * 8), bq = *(const LAS f32x4*)(CW + j * 128 + cg * 8 + 4);
        cw[j][0] = a[0]; cw[j][1] = a[1]; cw[j][2] = a[2]; cw[j][3] = a[3]; cw[j][4] = bq[0]; cw[j][5] = bq[1]; cw[j][6] = bq[2]; cw[j][7] = bq[3]; }
    for (int c = 0; c < NCH; ++c) {
        const size_t R0 = (size_t)b * LP + c * 64; const int par = c & 1;
        {
            float x[5][8];
#pragma unroll
            for (int j = 0; j < 5; ++j) { unpack8(lx[j], x[j]);
                if (c == 0 && 2 * tg - 3 + j < PADR) {
#pragma unroll
                    for (int e = 0; e < 8; ++e) x[j][e] = 0.f; } }
#pragma unroll
            for (int rr = 0; rr < 2; ++rr) {
                float y[8];
#pragma unroll
                for (int e = 0; e < 8; ++e) y[e] = __builtin_fmaf(cw[3][e], x[rr + 3][e], __builtin_fmaf(cw[2][e], x[rr + 2][e], __builtin_fmaf(cw[1][e], x[rr + 1][e], __builtin_fmaf(cw[0][e], x[rr][e], cw[4][e]))));
                u32x4 o; o.x = cvt_pk_bf16(y[0], y[1]); o.y = cvt_pk_bf16(y[2], y[3]); o.z = cvt_pk_bf16(y[4], y[5]); o.w = cvt_pk_bf16(y[6], y[7]);
                *(LAS u32x4*)(XC + (2 * tg + rr) * XSTR + cg * 16) = o;
            }
        }
        __syncthreads();
        prefetch_lx(c + 1 < NCH ? c + 1 : c);
        if (do_strips && c < 60) {
            const int ph = c % 5; const int sid = (int)blockIdx.x + 256 * (c / 5);
            if (ph == 0) {
                const XStrip s = xstrip_decode(p, sid); const int kr = tid >> 3, c8 = (tid & 7) * 8;
#pragma unroll
                for (int t = 0; t < 4; ++t) { const float* sp = s.src + (size_t)(s.k0 + kr) * s.sld + s.n0 + t * 64 + c8; xa[t] = *(const f32x4*)sp; xb[t] = *(const f32x4*)(sp + 4); }
            } else if (ph == 1) {
                const int kr = tid >> 3, c8 = (tid & 7) * 8;
#pragma unroll
                for (int t = 0; t < 4; ++t) { LAS float* wp = TR + t * (64 * 65) + kr * 65 + c8;
                    wp[0] = xa[t][0]; wp[1] = xa[t][1]; wp[2] = xa[t][2]; wp[3] = xa[t][3]; wp[4] = xb[t][0]; wp[5] = xb[t][1]; wp[6] = xb[t][2]; wp[7] = xb[t][3]; }
            } else if (ph == 2) {
                const XStrip s = xstrip_decode(p, sid); const int nr = tid >> 3, k8 = (tid & 7) * 8;
#pragma unroll
                for (int t = 0; t < 4; ++t) {
                    float v[8];
#pragma unroll
                    for (int i = 0; i < 8; ++i) v[i] = TR[t * (64 * 65) + (k8 + i) * 65 + nr];
                    u32x4 o; o.x = cvt_pk_bf16(v[0], v[1]); o.y = cvt_pk_bf16(v[2], v[3]); o.z = cvt_pk_bf16(v[4], v[5]); o.w = cvt_pk_bf16(v[6], v[7]);
                    *(u32x4*)(s.dst + (size_t)xstrip_drow(s.mode, s.n0 + t * 64 + nr) * s.dld + s.k0 + k8) = o;
                }
            }
        }
        f32x4 Rg = (f32x4){0.f, 0.f, 0.f, 0.f}, Ig = Rg;
#pragma unroll
        for (int ks = 0; ks < 4; ++ks) {
            const bf16x8 a = *(const LAS bf16x8*)(XC + (16 * tt + c16) * XSTR + (32 * ks + 8 * qd) * 2);
            Rg = mfma16(a, waf[ks], Rg); Ig = mfma16(a, wxf[ks], Ig);
        }
        float av[4], uv[4];
        float gA = 1.0f, gU = 0.f;
        const v4i16 xc4 = __builtin_amdgcn_ds_read_tr16_b64_v4i16((LAS v4i16*)(XC + (16 * tt + 4 * qd + (c16 >> 2)) * XSTR + (32 * q + 16 * dh + 4 * (c16 & 3)) * 2));
#pragma unroll
        for (int i = 0; i < 4; ++i) {
            const int tl = 16 * tt + 4 * qd + i;
            const float xcv = bf2f((bf16_t)xc4[i]);
            const float rr = fast_sigmoid(Rg[i] + bav), ii = fast_sigmoid(Ig[i] + bxv);
            float a = __builtin_amdgcn_exp2f(rr * c2);
            float u = __builtin_amdgcn_sqrtf(fmaxf(1.0f - a * a, 0.f)) * ii * xcv;
            if (c == 0 && tl < PADR) { a = 1.0f; u = 0.f; }
            gU = a * gU + u; gA *= a; av[i] = gA; uv[i] = gU;
        }
        float rA = 1.0f, rU = 0.f, stA = 1.0f, stU = 0.f;
        float Aq[4], Uq[4]; bcast_rows(gA, Aq); bcast_rows(gU, Uq);
#pragma unroll
        for (int j = 0; j < 4; ++j) {
            if (j == qd) { stA = rA; stU = rU; }
            rU = Aq[j] * rU + Uq[j]; rA = Aq[j] * rA;
        }
#pragma unroll
        for (int i = 0; i < 4; ++i) { const float ca = av[i]; uv[i] = ca * stU + uv[i]; av[i] = ca * stA; }
        if (qd == 0) { LSA[(par * 4 + tt) * 32 + dl] = rA; LSU[(par * 4 + tt) * 32 + dl] = rU; }
        __syncthreads();
        {
            float hin = CAR[par * 32 + dl];
#pragma unroll
            for (int t2 = 0; t2 < 3; ++t2) if (t2 < tt) hin = LSA[(par * 4 + t2) * 32 + dl] * hin + LSU[(par * 4 + t2) * 32 + dl];
            if (tt == 3 && qd == 0) CAR[(par ^ 1) * 32 + dl] = rA * hin + rU;
#pragma unroll
            for (int i = 0; i < 4; ++i) *(LAS bf16_t*)(O2 + (16 * tt + 4 * qd + i) * 64 + dl * 2) = f2bf_fast(av[i] * hin + uv[i]);
        }
        __syncthreads();
        {
            const u32x2 hh2 = *(const LAS u32x2*)(O2 + crow * 64 + c4 * 2);
            float hh[4], gg[4]; unpack4(hh2, hh); unpack4(g2, gg);
            if (!dry) *(u32x2*)(p.G2 + (R0 + crow) * D + CB + 32 * q + c4) = (u32x2){cvt_pk_bf16(hh[0] * gg[0], hh[1] * gg[1]), cvt_pk_bf16(hh[2] * gg[2], hh[3] * gg[3])};
            prefetch_g2(c + 1 < NCH ? c + 1 : 0);
        }
    }
    __syncthreads();
}
__device__ __forceinline__ bf16x8 tr_frag(const LAS unsigned char* img, const int stride, const int s0, const int col0, const int c16) {
    const LAS unsigned char* p0 = img + (s0 + (c16 >> 2)) * stride + (col0 + 4 * (c16 & 3)) * 2;
    const v4i16 lo = __builtin_amdgcn_ds_read_tr16_b64_v4i16((LAS v4i16*)p0);
    const v4i16 hi = __builtin_amdgcn_ds_read_tr16_b64_v4i16((LAS v4i16*)(p0 + 4 * stride));
    return __builtin_shufflevector(lo, hi, 0, 1, 2, 3, 4, 5, 6, 7);
}
__device__ __forceinline__ void hgrn_chain_q(const Params& p, LAS unsigned char* lds, const int b, const int hd, const int q, const bool dry = false, const unsigned tagbase = 0u, const int xflags = 0) {
    constexpr int QSTR = 272, TSTR = 144;
    LAS unsigned char* Qi = lds;
    LAS unsigned char* Ki = Qi + 64 * QSTR;
    constexpr int VSTR = 80;
    LAS unsigned char* Vi = Ki + 64 * QSTR;
    LAS unsigned char* St = Vi + 64 * VSTR;
    LAS unsigned char* Pi = St + 32 * QSTR;
    LAS unsigned char* O1 = Pi + 64 * TSTR;
    LAS float* Df = (LAS float*)(O1 + 2 * 64 * 64);
    LAS float* ssL = Df + 128;
    LAS float* ssO = ssL + 64;
    LAS float* rT = ssO + 128;
    const int tid = tid_opaque(), w = __builtin_amdgcn_readfirstlane(tid >> 6), lane = tid & 63, c16 = lane & 15, qd = lane >> 4, tt = w >> 1, vh = w & 1;
    const int CB = hd * 128, VB = CB + 32 * q;
    unsigned long long* xg = (unsigned long long*)p.xg + (size_t)(b * 8 + hd) * (4 * 4 * 64);
    for (int i = tid; i < 32 * QSTR / 16; i += NTHR) *(LAS u32x4*)(St + i * 16) = (u32x4){0u, 0u, 0u, 0u};
    for (int i = tid; i < 64 * TSTR / 16; i += NTHR) *(LAS u32x4*)(Pi + i * 16) = (u32x4){0u, 0u, 0u, 0u};
    if (tid < 64) ssL[tid] = 0.f;
    f32x4 Sacc[2];
    Sacc[0] = (f32x4){0.f, 0.f, 0.f, 0.f}; Sacc[1] = Sacc[0];
    const float ngv = p.hg_ng[32 * q + 16 * vh + c16];
    const int crow = tid >> 3, cseg = (tid & 7) * 16, c4 = (tid & 7) * 4;
    u32x4 pq[2], pk[2]; u32x2 pv, pg, pz; float pd = 0.f;
    auto prefetch = [&](int c) {
        const size_t R0 = (size_t)b * LP + c * 64;
        pq[0] = *(const u32x4*)(p.Qh + (R0 + crow) * D + CB + cseg); pq[1] = *(const u32x4*)(p.Qh + (R0 + crow) * D + CB + cseg + 8);
        pk[0] = *(const u32x4*)(p.Kh + (R0 + crow) * D + CB + cseg); pk[1] = *(const u32x4*)(p.Kh + (R0 + crow) * D + CB + cseg + 8);
        pv = *(const u32x2*)(p.Vv + (R0 + crow) * D + VB + c4);
        pd = p.Dk[((size_t)b * NCH + c) * D + CB + (tid & 127)];
    };
    auto fin_store = [&](int cf) {
        const size_t R = (size_t)b * LP + cf * 64 + crow;
        const u32x2 o2 = *(const LAS u32x2*)(O1 + ((cf & 1) * 64 + crow) * 64 + c4 * 2);
        float oo[4], gg[4], zz[4]; unpack4(o2, oo); unpack4(pg, gg); unpack4(pz, zz);
        const float rt = rT[crow];
        if (!dry) *(u32x2*)(p.G1 + R * D + VB + c4) = (u32x2){cvt_pk_bf16(oo[0] * rt * gg[0] + zz[0], oo[1] * rt * gg[1] + zz[1]), cvt_pk_bf16(oo[2] * rt * gg[2] + zz[2], oo[3] * rt * gg[3] + zz[3])};
    };
    auto fin_factors = [&](int cf, unsigned long long g0, unsigned long long g1, unsigned long long g2) {
        const unsigned tag = (unsigned)(cf + 1) + tagbase;
        unsigned spins = 0;
        while (!__all((unsigned)(g0 >> 32) == tag && (unsigned)(g1 >> 32) == tag && (unsigned)(g2 >> 32) == tag)) {
            if (++spins > (1u << 20)) break;
            __builtin_amdgcn_s_sleep(2);
            g0 = __hip_atomic_load(xg + (((q + 1) & 3) * 4 + (cf & 3)) * 64 + lane, __ATOMIC_RELAXED, __HIP_MEMORY_SCOPE_AGENT);
            g1 = __hip_atomic_load(xg + (((q + 2) & 3) * 4 + (cf & 3)) * 64 + lane, __ATOMIC_RELAXED, __HIP_MEMORY_SCOPE_AGENT);
            g2 = __hip_atomic_load(xg + (((q + 3) & 3) * 4 + (cf & 3)) * 64 + lane, __ATOMIC_RELAXED, __HIP_MEMORY_SCOPE_AGENT);
        }
        const float tot = ssO[(cf & 1) * 64 + lane] + __uint_as_float((unsigned)g0) + __uint_as_float((unsigned)g1) + __uint_as_float((unsigned)g2);
        rT[lane] = rsqrtf(tot * (1.0f / 128.0f) + 1e-6f);
    };
    prefetch(0);
    __syncthreads();
    for (int c = 0; c < NCH; ++c) {
        *(LAS u32x4*)(Qi + crow * QSTR + cseg * 2) = pq[0]; *(LAS u32x4*)(Qi + crow * QSTR + cseg * 2 + 16) = pq[1];
        *(LAS u32x4*)(Ki + crow * QSTR + cseg * 2) = pk[0]; *(LAS u32x4*)(Ki + crow * QSTR + cseg * 2 + 16) = pk[1];
        *(LAS u32x2*)(Vi + crow * VSTR + c4 * 2) = pv;
        if (tid < 128) Df[tid] = pd;
        __syncthreads();
        prefetch(c + 1 < NCH ? c + 1 : c);
        const int cf = c > 0 ? c - 1 : 0;
        {
            const size_t R = (size_t)b * LP + cf * 64 + crow;
            pg = *(const u32x2*)(p.G1 + R * D + VB + c4); pz = *(const u32x2*)(p.G2 + R * D + VB + c4);
        }
        unsigned long long g0 = 0ull, g1 = 0ull, g2 = 0ull;
        if (w == 7) {
            g0 = __hip_atomic_load(xg + (((q + 1) & 3) * 4 + (cf & 3)) * 64 + lane, __ATOMIC_RELAXED, __HIP_MEMORY_SCOPE_AGENT);
            g1 = __hip_atomic_load(xg + (((q + 2) & 3) * 4 + (cf & 3)) * 64 + lane, __ATOMIC_RELAXED, __HIP_MEMORY_SCOPE_AGENT);
            g2 = __hip_atomic_load(xg + (((q + 3) & 3) * 4 + (cf & 3)) * 64 + lane, __ATOMIC_RELAXED, __HIP_MEMORY_SCOPE_AGENT);
        }
        for (int ti = w; ti < 10; ti += 8) {
            const int pt = ti < 1 ? 0 : ti < 3 ? 1 : ti < 6 ? 2 : 3, ps = ti - (pt * (pt + 1)) / 2;
            f32x4 X = (f32x4){0.f, 0.f, 0.f, 0.f};
#pragma unroll
            for (int ks = 0; ks < 4; ++ks) {
                const bf16x8 a = *(const LAS bf16x8*)(Qi + (16 * pt + c16) * QSTR + (32 * ks + 8 * qd) * 2);
                const bf16x8 bb = *(const LAS bf16x8*)(Ki + (16 * ps + c16) * QSTR + (32 * ks + 8 * qd) * 2);
                X = mfma16(a, bb, X);
            }
            float xv[4];
#pragma unroll
            for (int i = 0; i < 4; ++i) xv[i] = (pt == ps && c16 > 4 * qd + i) ? 0.f : X[i];
            *(LAS u32x2*)(Pi + (16 * ps + c16) * TSTR + (16 * pt + 4 * qd) * 2) = (u32x2){cvt_pk_bf16(xv[0], xv[1]), cvt_pk_bf16(xv[2], xv[3])};
        }
        __syncthreads();
        {
            f32x4 O = (f32x4){0.f, 0.f, 0.f, 0.f};
            for (int ks = 0; ks < (tt + 2) / 2; ++ks) {
                const bf16x8 a = tr_frag(Pi, TSTR, 32 * ks + 8 * qd, 16 * tt, c16);
                const bf16x8 bb = tr_frag(Vi, VSTR, 32 * ks + 8 * qd, 16 * vh, c16);
                O = mfma16(a, bb, O);
            }
#pragma unroll
            for (int ks = 0; ks < 4; ++ks) {
                const bf16x8 a = *(const LAS bf16x8*)(Qi + (16 * tt + c16) * QSTR + (32 * ks + 8 * qd) * 2);
                const bf16x8 bb = *(const LAS bf16x8*)(St + (16 * vh + c16) * QSTR + (32 * ks + 8 * qd) * 2);
                O = mfma16(a, bb, O);
            }
#pragma unroll
            for (int i = 0; i < 4; ++i) {
                const float s = row16_incl_scan(O[i] * O[i]);
                if (c16 == 15) __hip_atomic_fetch_add(ssL + 16 * tt + 4 * qd + i, s, __ATOMIC_RELAXED, __HIP_MEMORY_SCOPE_WORKGROUP);
                *(LAS bf16_t*)(O1 + ((c & 1) * 64 + 16 * tt + 4 * qd + i) * 64 + (16 * vh + c16) * 2) = f2bf_fast(O[i] * ngv);
            }
            if (w == 7 && c > 0) fin_factors(cf, g0, g1, g2);
        }
        __syncthreads();
        if (w == 0) {
            const float s = ssL[lane];
            ssO[(c & 1) * 64 + lane] = s;
            __hip_atomic_store(xg + ((q * 4) + (c & 3)) * 64 + lane, ((unsigned long long)((unsigned)(c + 1) + tagbase) << 32) | (unsigned long long)__float_as_uint(s), __ATOMIC_RELAXED, __HIP_MEMORY_SCOPE_AGENT);
        }
#pragma unroll
        for (int i2 = 0; i2 < 2; ++i2) {
            const int kk = 2 * tt + i2;
#pragma unroll
            for (int ks = 0; ks < 2; ++ks) {
                const bf16x8 a = tr_frag(Ki, QSTR, 32 * ks + 8 * qd, 16 * kk, c16);
                const bf16x8 bb = tr_frag(Vi, VSTR, 32 * ks + 8 * qd, 16 * vh, c16);
                Sacc[i2] = mfma16(a, bb, Sacc[i2]);
            }
            const f32x4 d4 = *(const LAS f32x4*)(Df + 16 * kk + 4 * qd);
            Sacc[i2] = Sacc[i2] * d4;
            *(LAS u32x2*)(St + (16 * vh + c16) * QSTR + (16 * kk + 4 * qd) * 2) = (u32x2){cvt_pk_bf16(Sacc[i2][0], Sacc[i2][1]), cvt_pk_bf16(Sacc[i2][2], Sacc[i2][3])};
        }
        __syncthreads();
        if (tid < 64) ssL[tid] = 0.f;
        if (c > 0) fin_store(cf);
    }
    {
        const int cf = NCH - 1;
        const size_t R = (size_t)b * LP + cf * 64 + crow;
        pg = *(const u32x2*)(p.G1 + R * D + VB + c4); pz = *(const u32x2*)(p.G2 + R * D + VB + c4);
        __syncthreads();
        if (w == 7) {
            const unsigned long long g0 = __hip_atomic_load(xg + (((q + 1) & 3) * 4 + (cf & 3)) * 64 + lane, __ATOMIC_RELAXED, __HIP_MEMORY_SCOPE_AGENT);
            const unsigned long long g1 = __hip_atomic_load(xg + (((q + 2) & 3) * 4 + (cf & 3)) * 64 + lane, __ATOMIC_RELAXED, __HIP_MEMORY_SCOPE_AGENT);
            const unsigned long long g2 = __hip_atomic_load(xg + (((q + 3) & 3) * 4 + (cf & 3)) * 64 + lane, __ATOMIC_RELAXED, __HIP_MEMORY_SCOPE_AGENT);
            fin_factors(cf, g0, g1, g2);
        }
        __syncthreads();
        fin_store(cf);
    }
    __syncthreads();
}
__device__ __forceinline__ void phase2q(const Params& p, LAS unsigned char* lds) {
    const int bh = blockIdx.x & 63, q = blockIdx.x >> 6, b = bh >> 3, hd = bh & 7;
    const int nl = 1 + (p.flags & 15), nh = 1 + ((p.flags >> 4) & 15);
    for (int rep = 0; rep < nl; ++rep) lru_chain_q(p, lds, b, hd, q, rep > 0, rep == 0);
    asm volatile("s_waitcnt vmcnt(0)" ::: "memory");
    __syncthreads();
    if (threadIdx.x == 0) { __builtin_amdgcn_fence(__ATOMIC_ACQUIRE, "agent"); asm volatile("s_waitcnt vmcnt(0)" ::: "memory"); }
    __syncthreads();
    for (int rep = 0; rep < nh; ++rep) hgrn_chain_q(p, lds, b, hd, q, rep > 0, 1000u * rep, rep > 0 ? (p.flags >> 8) : 0);
}

__device__ __forceinline__ void phase2(const Params& p, LAS unsigned char* lds, const bool dry = false) {
    if (blockIdx.x >= NB * 8) return;
    const int b = blockIdx.x >> 3, hd = blockIdx.x & 7;
    lru_chain(p, lds, b, hd, dry);
    asm volatile("s_waitcnt vmcnt(0)" ::: "memory");
    __syncthreads();
    if (threadIdx.x == 0) { __builtin_amdgcn_fence(__ATOMIC_ACQUIRE, "agent"); asm volatile("s_waitcnt vmcnt(0)" ::: "memory"); }
    __syncthreads();
    hgrn_chain(p, lds, b, hd, dry);
}

__global__ __launch_bounds__(NTHR, 2) void k_mega(Params p) {
    extern __shared__ __attribute__((aligned(16))) unsigned char shm[];
    LAS unsigned char* lds = (LAS unsigned char*)shm;
    volatile LAS unsigned* xst = (volatile LAS unsigned*)(lds + LDS_BYTES - 16);
    if (threadIdx.x == 0) { xst[0] = 0u; xst[1] = 0u; }
    __syncthreads();
    (void)xcd_barrier_post(p.bar, xst);
#define XB_NOW() do { XcdBarrier xb_; xb_.bar = p.bar; xb_.x = xb_xcc_id(); xb_.st = (volatile LAS unsigned*)(lds + LDS_BYTES - 16); xcd_barrier(xb_); } while (0)
    phase_prep(p, lds);
    XB_NOW();
#if REPEAT_PHASE == 0
    phase_prep(p, lds); XB_NOW();
#endif
#if REPEAT_PHASE == 99
    XB_NOW(); XB_NOW(); XB_NOW(); XB_NOW();
#endif
    phase1(p, lds);
    XB_NOW();
#if REPEAT_PHASE == 1
    phase1(p, lds); XB_NOW();
#endif
    if (gridDim.x == 256) phase2q(p, lds); else phase2(p, lds);
    XB_NOW();
#if REPEAT_PHASE == 2
    phase2(p, lds, true); XB_NOW();
#endif
    phase3(p, lds);
    XB_NOW();
#if REPEAT_PHASE == 3
    phase3(p, lds); XB_NOW();
#endif
    phase4(p, lds);
    XB_NOW();
#if REPEAT_PHASE == 4
    if (blockIdx.x == 0 && threadIdx.x < 64) p.cnt[threadIdx.x * 64] = 0;
    XB_NOW(); phase4(p, lds); XB_NOW();
#endif
    phase5(p, lds);
    XB_NOW();
#if REPEAT_PHASE == 5
    phase5(p, lds); XB_NOW();
#endif
    phase6(p, lds);
    XB_NOW();
#if REPEAT_PHASE == 6
    phase6(p, lds); XB_NOW();
#endif
    phase7(p);
#if REPEAT_PHASE == 7
    XB_NOW(); phase7(p);
#endif
}

template <int PH> __global__ __launch_bounds__(NTHR, 2) void k_phase(Params p) {
    extern __shared__ __attribute__((aligned(16))) unsigned char shm[];
    LAS unsigned char* lds = (LAS unsigned char*)shm;
    if (PH == 0) phase_prep(p, lds);
    if (PH == 1) phase1(p, lds);
    if (PH == 3) phase3(p, lds);
    if (PH == 4) phase4(p, lds);
    if (PH == 5) phase5(p, lds);
    if (PH == 6) phase6(p, lds);
    if (PH == 7) phase7(p);
}

extern "C" void kernel_launch(void* const* d_in, const int* in_sizes, int n_in, void* d_out, int out_size, void* d_ws, size_t ws_size, hipStream_t stream) {
    Params p{};
#ifdef EXP_FLAGS
    p.flags = EXP_FLAGS;
#endif
    p.x = (const float*)d_in[0]; p.meta = (const float*)d_in[1]; p.ln_in_g = (const float*)d_in[2]; p.ln_in_b = (const float*)d_in[3];
    p.w_in = (const float*)d_in[4]; p.b_in = (const float*)d_in[5]; p.lbl = (const float*)d_in[6]; p.hg_ng = (const float*)d_in[7];
    p.conv_w = (const float*)d_in[8]; p.conv_b = (const float*)d_in[9]; p.lru_wa = (const float*)d_in[10]; p.lru_ba = (const float*)d_in[11];
    p.lru_wx = (const float*)d_in[12]; p.lru_bx = (const float*)d_in[13]; p.lru_lam = (const float*)d_in[14]; p.w_out = (const float*)d_in[15];
    p.ln1_g = (const float*)d_in[16]; p.ln1_b = (const float*)d_in[17]; p.router_w = (const float*)d_in[18]; p.router_b = (const float*)d_in[19];
    p.we_gate = (const float*)d_in[20]; p.we_up = (const float*)d_in[21]; p.we_down = (const float*)d_in[22];
    p.ws_gate = (const float*)d_in[23]; p.ws_up = (const float*)d_in[24]; p.ws_down = (const float*)d_in[25];
    p.ln2_g = (const float*)d_in[26]; p.ln2_b = (const float*)d_in[27];
    p.out = (float*)d_out;
    char* ws = (char*)d_ws;
    p.h0 = (bf16_t*)(ws + 0 * U); p.Qh = (bf16_t*)(ws + 1 * U); p.Kh = (bf16_t*)(ws + 2 * U); p.Vv = (bf16_t*)(ws + 3 * U);
    p.G1 = (bf16_t*)(ws + 4 * U); p.LX = (bf16_t*)(ws + 5 * U); p.G2 = (bf16_t*)(ws + 6 * U);
    char* misc = ws + 7 * U;
    const size_t MB = 1024 * 1024;
    p.Dk = (float*)misc;
    p.ridx = (int*)(misc + 9 * MB / 4);
    p.rwts = (float*)(misc + 13 * MB / 4);
    p.Bt_in = (bf16_t*)(misc + 17 * MB / 4);
    p.Bt_out = (bf16_t*)(misc + 81 * MB / 4);
    p.Bt_sgu = (bf16_t*)(misc + 89 * MB / 4);
    p.Bt_sd = (bf16_t*)(misc + 93 * MB / 4);
    p.Bt_wa = (bf16_t*)(misc + 95 * MB / 4);
    p.Bt_wx = (bf16_t*)(misc + 96 * MB / 4);
    p.Bt_r = (bf16_t*)(misc + 97 * MB / 4);
    p.bperm = (float*)(misc + 97 * MB / 4 + MB / 8);
    p.lb = (float*)(misc + 97 * MB / 4 + MB / 8 + 32768);
    p.act = (bf16_t*)ws; p.base = (bf16_t*)(ws + 2 * U); p.yrows = (unsigned char*)(ws + 4 * U);
    p.bar = (unsigned*)(misc + 43 * MB); p.xg = (unsigned long long*)(misc + 44 * MB);
    p.cnt = (int*)(misc + 25 * MB); p.list_tok = (int*)(misc + 26 * MB); p.list_w = (float*)(misc + 34 * MB);
    p.pre1 = (bf16_t*)(ws + 1 * U);
    p.h1 = (bf16_t*)(ws + 3 * U);
    p.Bt_gu = (bf16_t*)d_out;
    p.Bt_d = (bf16_t*)((char*)d_out + (size_t)NE * 512 * D * 2);

    static int grid_blocks = 0;
    if (!grid_blocks) {
        (void)hipFuncSetAttribute((const void*)k_mega, hipFuncAttributeMaxDynamicSharedMemorySize, LDS_BYTES);
        int dev = 0, cus = 0, per_cu = 0;
        (void)hipGetDevice(&dev);
        (void)hipDeviceGetAttribute(&cus, hipDeviceAttributeMultiprocessorCount, dev);
        (void)hipOccupancyMaxActiveBlocksPerMultiprocessor(&per_cu, (const void*)k_mega, NTHR, LDS_BYTES);
        if (per_cu > 1) per_cu = 1;
        grid_blocks = cus * per_cu;
    }
    (void)hipMemsetAsync(p.bar, 0, XCD_BAR_WORDS * 4, stream);
    void* args[] = {&p};
    hipError_t e = hipLaunchCooperativeKernel((const void*)k_mega, dim3(grid_blocks), dim3(NTHR), args, LDS_BYTES, stream);
    if (e != hipSuccess) fprintf(stderr, "cooperative launch failed: %s (grid %d)\n", hipGetErrorString(e), grid_blocks);
}
```

```cpp
#include <hip/hip_runtime.h>
#include <hip/hip_cooperative_groups.h>
#include <stdint.h>
#include <cstdio>
namespace cg = cooperative_groups;

typedef unsigned short bf16_t;
#ifndef REPEAT_PHASE
#define REPEAT_PHASE -1
#endif

constexpr int D = 1024;
constexpr int NB = 8;
constexpr int SEQ = 4096;
constexpr int LP = 4160;
constexpr int PADR = 48;
constexpr int TP = NB * LP;
constexpr int T = NB * SEQ;
constexpr int NCH = LP / 64;
constexpr int NE = 64, TOPK = 6, DE = 256;
constexpr float ALPHA = 1.189207115002721f;
constexpr size_t U = (size_t)TP * D * 2;

__device__ __forceinline__ float bf2f(bf16_t b) { return __uint_as_float(((unsigned)b) << 16); }
__device__ __forceinline__ bf16_t f2bf(float f) { unsigned u = __float_as_uint(f); u += 0x7FFFu + ((u >> 16) & 1u); return (bf16_t)(u >> 16); }
__device__ __forceinline__ float sigmoidf_(float x) { return 1.0f / (1.0f + __expf(-x)); }
__device__ __forceinline__ float siluf_(float x) { return x * sigmoidf_(x); }
__device__ __forceinline__ float gelu_tanh_(float x) { const float c = 0.7978845608028654f; float t = tanhf(c * (x + 0.044715f * x * x * x)); return 0.5f * x * (1.0f + t); }
__device__ __forceinline__ float wave_sum(float v) {
    v += __int_as_float(__builtin_amdgcn_update_dpp(0, __float_as_int(v), 0x111, 0xF, 0xF, false));
    v += __int_as_float(__builtin_amdgcn_update_dpp(0, __float_as_int(v), 0x112, 0xF, 0xF, false));
    v += __int_as_float(__builtin_amdgcn_update_dpp(0, __float_as_int(v), 0x114, 0xF, 0xF, false));
    v += __int_as_float(__builtin_amdgcn_update_dpp(0, __float_as_int(v), 0x118, 0xF, 0xF, false));
    v += __int_as_float(__builtin_amdgcn_update_dpp(0, __float_as_int(v), 0x142, 0xA, 0xF, false));
    v += __int_as_float(__builtin_amdgcn_update_dpp(0, __float_as_int(v), 0x143, 0xC, 0xF, false));
    return __int_as_float(__builtin_amdgcn_readlane(__float_as_int(v), 63));
}

#define LAS __attribute__((address_space(3)))
typedef short bf16x8 __attribute__((ext_vector_type(8)));
typedef float f32x4 __attribute__((ext_vector_type(4)));
typedef unsigned u32x4 __attribute__((ext_vector_type(4)));
typedef unsigned u32x2 __attribute__((ext_vector_type(2)));
typedef int v4i __attribute__((ext_vector_type(4)));
typedef int v8i __attribute__((ext_vector_type(8)));
typedef float f32x32 __attribute__((ext_vector_type(32)));
constexpr float WSCALE8 = 32.0f, ASCALE8 = 8.0f;
__device__ __forceinline__ v8i cat8(const short __attribute__((ext_vector_type(8))) lo, const short __attribute__((ext_vector_type(8))) hi) {
    const v4i a = __builtin_bit_cast(v4i, lo), b = __builtin_bit_cast(v4i, hi); return __builtin_shufflevector(a, b, 0, 1, 2, 3, 4, 5, 6, 7);
}
__device__ __forceinline__ unsigned pk_fp8x4(float a, float b, float c, float d) { int w = 0; w = __builtin_amdgcn_cvt_pk_fp8_f32(a, b, w, false); w = __builtin_amdgcn_cvt_pk_fp8_f32(c, d, w, true); return (unsigned)w; }
constexpr int BM = 256, BK = 64, HALF = 128, HTB = HALF * BK * 2, STAGE_BYTES = 8 * HTB, NXCD = 8, WGM = 16;
constexpr int NTHR = 512;
constexpr int LDS_BYTES = 160 * 1024;

struct Params {
    const float *x, *meta, *ln_in_g, *ln_in_b, *w_in, *b_in, *lbl, *hg_ng, *conv_w, *conv_b, *lru_wa, *lru_ba, *lru_wx, *lru_bx, *lru_lam, *w_out, *ln1_g, *ln1_b, *router_w, *router_b,
        *we_gate, *we_up, *we_down, *ws_gate, *ws_up, *ws_down, *ln2_g, *ln2_b;
    float* out;
    bf16_t *h0, *Qh, *Kh, *Vv, *G1, *LX, *G2;
    float* Dk; int* ridx; float* rwts;
    bf16_t* pre1; bf16_t* h1;
    bf16_t *Bt_in, *Bt_out, *Bt_wa, *Bt_wx, *Bt_r;
    unsigned char *Bt_gu, *Bt_d, *Bt_sgu, *Bt_sd, *h1q;
    float* bperm; float* lb;
    int* cnt; int* list_tok; float* list_w;
    unsigned char* act; bf16_t* base; unsigned char* yrows;
    unsigned* bar; unsigned long long* xg;
    int flags; int pad_;
};

__device__ __forceinline__ int lds_byte(int r, int c) { const int st = (r >> 4) * 2 + (c >> 5), rr = r & 15, cc = c & 31, ob = rr * 64 + cc * 2; return st * 1024 + (ob ^ (((ob >> 9) & 1) << 5)); }
__device__ __forceinline__ void stage_rc(int b, int& R, int& C) { const int st = b / 1024, sb = b % 1024, swz = sb ^ (((sb >> 9) & 1) << 5); R = (st >> 1) * 16 + swz / 64; C = (st & 1) * 32 + (swz % 64) / 2; }
__device__ __forceinline__ int perm32(int rho) { const int n = rho >> 4, i = rho & 15; return 8 * (i >> 2) + 4 * n + (i & 3); }
__device__ __forceinline__ unsigned cvt_pk_bf16(float lo, float hi) { unsigned r; asm volatile("v_cvt_pk_bf16_f32 %0, %1, %2" : "=v"(r) : "v"(lo), "v"(hi)); return r; }

__device__ __forceinline__ int tid_opaque() { int t = threadIdx.x; asm volatile("" : "+v"(t)); return t; }
struct Unit { int a0; long long boff; int pm; int pn; int e; int r; };
__device__ __forceinline__ void tile_order(int L, int nM, int nN, int& pm, int& pn) {
    const int nwg = nM * nN; int wgid = L;
    { const int q = nwg / NXCD, r = nwg % NXCD, xcd = wgid % NXCD, off = wgid / NXCD; wgid = (xcd < r ? xcd * (q + 1) : r * (q + 1) + (xcd - r) * q) + off; }
    const int nig = WGM * nN, gid = wgid / nig, fm = gid * WGM, gsz = (nM - fm) < WGM ? (nM - fm) : WGM;
    pm = fm + ((wgid % nig) % gsz); pn = (wgid % nig) / gsz;
}

#define XB_TMO      128
#define XB_XCNT(j)  (256  + 64 * (j))
#define XB_XSUB(j)  (1280 + 64 * (j))
#define XB_XGEN(j)  (2304 + 64 * (j))
#define XB_TOP      3328
#define XB_TOPGEN   3392
#define XCD_BAR_WORDS 3456
#define XB_SPIN_CAP (1u << 22)
__device__ __forceinline__ unsigned xb_ld(unsigned* p) { return __hip_atomic_load(p, __ATOMIC_RELAXED, __HIP_MEMORY_SCOPE_AGENT); }
__device__ __forceinline__ unsigned xb_add(unsigned* p, unsigned v) { return __hip_atomic_fetch_add(p, v, __ATOMIC_RELAXED, __HIP_MEMORY_SCOPE_AGENT); }
__device__ __forceinline__ unsigned xb_xcc_id() { return (unsigned)__builtin_amdgcn_s_getreg((3 << 11) | 20) & 0xFu; }
#define XB_SPIN(cond, bar) do { unsigned _sp = 0; while (cond) { __builtin_amdgcn_s_sleep(1); \
    if ((++_sp & 255u) == 0u) { if (xb_ld(&(bar)[XB_TMO])) break; if (_sp > XB_SPIN_CAP) { atomicAdd(&(bar)[XB_TMO], 1u); break; } } } } while (0)
struct XcdBarrier { unsigned* bar; unsigned x; volatile LAS unsigned* st; };
__device__ __forceinline__ XcdBarrier xcd_barrier_post(unsigned* bar, volatile LAS unsigned* st) {
    XcdBarrier b; b.bar = bar; b.x = xb_xcc_id(); b.st = st;
    if (threadIdx.x == 0) (void)xb_add(&bar[XB_XCNT(b.x)], 1u);
    return b;
}
__device__ __forceinline__ void xcd_barrier_complete(unsigned* bar, unsigned x, unsigned& nloc, unsigned& nx) {
    const unsigned G = gridDim.x * gridDim.y * gridDim.z;
    unsigned sum, cnt, mine, sp = 0u;
    for (;;) {
        sum = 0u; cnt = 0u; mine = 0u;
#pragma unroll
        for (unsigned j = 0; j < 16; ++j) { const unsigned c = xb_ld(&bar[XB_XCNT(j)]); sum += c; cnt += (c > 0u) ? 1u : 0u; mine = (j == x) ? c : mine; }
        if (sum == G) break;
        __builtin_amdgcn_s_sleep(1);
        if ((++sp & 255u) == 0u) { if (xb_ld(&bar[XB_TMO])) break; if (sp > XB_SPIN_CAP) { atomicAdd(&bar[XB_TMO], 1u); break; } }
    }
    nloc = mine > 0u ? mine : 1u; nx = cnt > 0u ? cnt : 1u;
}
__device__ __forceinline__ void xcd_barrier(const XcdBarrier& b) {
    asm volatile("s_waitcnt vmcnt(0)" ::: "memory");
    __syncthreads();
    if (threadIdx.x == 0) {
        unsigned* bar = b.bar;
        __builtin_amdgcn_s_waitcnt(0);
        unsigned nloc = b.st[0], nx = b.st[1];
        if (nloc == 0u) { xcd_barrier_complete(bar, b.x, nloc, nx); b.st[0] = nloc; b.st[1] = nx; }
        const unsigned old = xb_add(&bar[XB_XSUB(b.x)], 1u);
        const unsigned gen = old / nloc;
        if (old + 1u == (gen + 1u) * nloc) {
            __builtin_amdgcn_fence(__ATOMIC_RELEASE, "agent");
            asm volatile("s_waitcnt vmcnt(0)" ::: "memory");
            const unsigned og = xb_add(&bar[XB_TOP], 1u);
            const unsigned tg = og / nx;
            if (og + 1u == (tg + 1u) * nx) xb_add(&bar[XB_TOPGEN], 1u);
            else XB_SPIN(xb_ld(&bar[XB_TOPGEN]) == tg, bar);
            __builtin_amdgcn_fence(__ATOMIC_ACQUIRE, "agent");
            xb_add(&bar[XB_XGEN(b.x)], 1u);
            asm volatile("s_waitcnt vmcnt(0)" ::: "memory");
        } else {
            XB_SPIN(xb_ld(&bar[XB_XGEN(b.x)]) == gen, bar);
            __builtin_amdgcn_fence(__ATOMIC_ACQUIRE, "agent");
            asm volatile("s_waitcnt vmcnt(0)" ::: "memory");
        }
    }
    __syncthreads();
}

template <class Epi, class Sched>
__device__ __forceinline__ void gemm_phase(LAS unsigned char* lds, const void* Abase, const void* Btbase, const int KB  , const Sched& S, const Epi& E) {
    const int tid = tid_opaque(), wid = __builtin_amdgcn_readfirstlane(tid >> 6), lane = tid & 63, wr = wid >> 2, wc = wid & 3, fr = lane & 15, fq = lane >> 4;
    const int nt = KB / (BK * 2);
    int Rr[2], Cc[2]; unsigned voffB[2], voffB1[2];
#pragma unroll
    for (int i = 0; i < 2; ++i) { int R, C; stage_rc(tid * 16 + i * 8192, R, C); Rr[i] = R; Cc[i] = C;
        if (Epi::PERM == 2) {
            const int rb = 64 * (R >> 5) + 16 * ((R & 15) >> 2) + 4 * ((R >> 4) & 1) + (R & 3);
            voffB[i] = (unsigned)(rb * KB + C * 2); voffB1[i] = (unsigned)((rb + 8) * KB + C * 2);
        } else {
            const int Rb = Epi::PERM ? ((R & ~31) + perm32(R & 31)) : R; voffB[i] = (unsigned)(Rb * KB + C * 2); voffB1[i] = voffB[i] + (unsigned)(HALF * KB);
        } }
    const size_t kstep = (size_t)(BK * 2);
    const unsigned ldsw = (unsigned)wid * 1024u;
    const int aoff = lds_byte(wr * 64 + fr, fq * 8), boff = lds_byte(wc * 32 + fr, fq * 8);
#define G_SA(b, h) (((b) * 2 + (h)) * HTB)
#define G_SB(b, h) ((4 + (b) * 2 + (h)) * HTB)
#define G_STAGE(bufoff, gbase, voff) do { _Pragma("unroll") for (int _i = 0; _i < 2; ++_i) { unsigned _o = (voff)[_i]; asm volatile("" : "+v"(_o));     \
        __builtin_amdgcn_global_load_lds((const unsigned*)((const char*)(gbase) + _o), (LAS unsigned*)(lds + (bufoff) + ldsw + _i * 8192), 16, 0, 0); } } while (0)
#define G_LDA(dst, b, h) do { _Pragma("unroll") for (int m = 0; m < 4; ++m) _Pragma("unroll") for (int k = 0; k < 2; ++k) dst[m][k] = *(const LAS bf16x8*)(lds + G_SA(b, h) + aoff + m * 2048 + k * 1024); } while (0)
#define G_LDB(dst, b, h) do { _Pragma("unroll") for (int n = 0; n < 2; ++n) _Pragma("unroll") for (int k = 0; k < 2; ++k) dst[n][k] = *(const LAS bf16x8*)(lds + G_SB(b, h) + boff + n * 2048 + k * 1024); } while (0)
#define G_MMA(ai, bj, At, Bt) do { __builtin_amdgcn_s_setprio(1); _Pragma("unroll") for (int m = 0; m < 4; ++m) _Pragma("unroll") for (int n = 0; n < 2; ++n) { \
        if constexpr (Epi::F8) { f32x4 c_; _Pragma("unroll") for (int j = 0; j < 4; ++j) c_[j] = accv[ai][bj][(m * 2 + n) * 4 + j]; \
            c_ = __builtin_amdgcn_mfma_scale_f32_16x16x128_f8f6f4(cat8(Bt[n][0], Bt[n][1]), cat8(At[m][0], At[m][1]), c_, 0, 0, 0, 0, 0, 0); \
            _Pragma("unroll") for (int j = 0; j < 4; ++j) accv[ai][bj][(m * 2 + n) * 4 + j] = c_[j]; } \
        else { _Pragma("unroll") for (int k = 0; k < 2; ++k) acc[ai][bj][m][n] = __builtin_amdgcn_mfma_f32_16x16x32_bf16(Bt[n][k], At[m][k], acc[ai][bj][m][n], 0, 0, 0); } } \
        __builtin_amdgcn_s_setprio(0); } while (0)
#define G_WAIT_V(n) asm volatile("s_waitcnt vmcnt(" #n ")" ::: "memory")
#define G_WAIT_L(n) asm volatile("s_waitcnt lgkmcnt(" #n ")" ::: "memory")
#define G_BAR __builtin_amdgcn_s_barrier()
#define G_SCHED __builtin_amdgcn_sched_barrier(0)
    Unit cur, nxt; int ui = 0;
    if (!S.next(0, cur)) return;
    f32x4 acc[2][2][4][2];
    f32x32 accv[2][2];
#pragma unroll
    for (int a = 0; a < 2; ++a)
#pragma unroll
        for (int b = 0; b < 2; ++b)
#pragma unroll
            for (int j = 0; j < 32; ++j) accv[a][b][j] = 0.f;
#pragma unroll
    for (int a = 0; a < 2; ++a)
#pragma unroll
        for (int b = 0; b < 2; ++b)
#pragma unroll
            for (int m = 0; m < 4; ++m)
#pragma unroll
                for (int n = 0; n < 2; ++n) acc[a][b][m][n] = (f32x4){0.f, 0.f, 0.f, 0.f};
    bf16x8 At[4][2], B0[2][2], B1[2][2];
    unsigned vA0[2], vA1[2], vN0[2], vN1[2];
    S.a_off(cur, Rr, Cc, KB, vA0, vA1);
    const char* const cA = (const char*)Abase;
    const char* cB = (const char*)Btbase + cur.boff;
    G_STAGE(G_SB(0, 0), cB, voffB); G_STAGE(G_SA(0, 0), cA, vA0); G_STAGE(G_SB(0, 1), cB, voffB1); G_STAGE(G_SA(0, 1), cA, vA1);
    if (wr == 1) G_BAR;
    G_WAIT_V(4); G_BAR;
    G_STAGE(G_SB(1, 0), cB + kstep, voffB); G_STAGE(G_SA(1, 0), cA + kstep, vA0); G_STAGE(G_SB(1, 1), cB + kstep, voffB1);
    G_WAIT_V(6); G_BAR;
    for (;;) {
        const bool has_next = S.next(ui + 1, nxt);
        if (has_next) { S.a_off(nxt, Rr, Cc, KB, vN0, vN1); asm volatile("" : "+v"(vN0[0]), "+v"(vN0[1]), "+v"(vN1[0]), "+v"(vN1[1])); } else { vN0[0] = vA0[0]; vN0[1] = vA0[1]; vN1[0] = vA1[0]; vN1[1] = vA1[1]; }
        const char* nB = has_next ? (const char*)Btbase + nxt.boff : cB;
#pragma nounroll
        for (int t = 0; t < nt; t += 2) {
            const bool last = (t == nt - 2);
            const char* a1 = cA + (size_t)(t + 1) * kstep;
            const char* a2 = last ? cA : cA + (size_t)(t + 2) * kstep; const char* b2 = last ? nB : cB + (size_t)(t + 2) * kstep;
            const char* a3 = a2 + kstep; const char* b3 = b2 + kstep;
            unsigned w0[2], w1[2];
            w0[0] = last ? vN0[0] : vA0[0]; w0[1] = last ? vN0[1] : vA0[1]; w1[0] = last ? vN1[0] : vA1[0]; w1[1] = last ? vN1[1] : vA1[1];
            G_LDB(B0, 0, 0); G_SCHED; G_LDA(At, 0, 0); G_STAGE(G_SA(1, 1), a1, vA1);
            G_WAIT_L(8); G_BAR; G_WAIT_L(0); G_MMA(0, 0, At, B0); G_BAR; G_SCHED;
            G_LDB(B1, 0, 1); G_STAGE(G_SB(0, 0), b2, voffB);
            G_BAR; G_WAIT_L(0); G_MMA(0, 1, At, B1); G_BAR;
            G_LDA(At, 0, 1); G_STAGE(G_SA(0, 0), a2, w0);
            G_BAR; G_WAIT_L(0); G_MMA(1, 0, At, B0); G_BAR; G_SCHED;
            G_STAGE(G_SB(0, 1), b2, voffB1);
            G_WAIT_V(6); G_BAR; G_MMA(1, 1, At, B1); G_BAR;
            G_LDB(B0, 1, 0); G_SCHED; G_LDA(At, 1, 0); G_STAGE(G_SA(0, 1), a2, w1);
            G_WAIT_L(8); G_BAR; G_WAIT_L(0); G_MMA(0, 0, At, B0); G_BAR; G_SCHED;
            G_LDB(B1, 1, 1); G_STAGE(G_SB(1, 0), b3, voffB);
            G_BAR; G_WAIT_L(0); G_MMA(0, 1, At, B1); G_BAR;
            G_LDA(At, 1, 1); G_STAGE(G_SA(1, 0), a3, w0);
            G_BAR; G_WAIT_L(0); G_MMA(1, 0, At, B0); G_BAR; G_SCHED;
            G_STAGE(G_SB(1, 1), b3, voffB1);
            G_WAIT_V(6); G_BAR; G_MMA(1, 1, At, B1); G_BAR;
        }
        if constexpr (Epi::F8) {
#pragma unroll
            for (int a = 0; a < 2; ++a)
#pragma unroll
                for (int b = 0; b < 2; ++b)
#pragma unroll
                    for (int m = 0; m < 4; ++m)
#pragma unroll
                        for (int n = 0; n < 2; ++n)
#pragma unroll
                            for (int j = 0; j < 4; ++j) acc[a][b][m][n][j] = accv[a][b][(m * 2 + n) * 4 + j];
        }
        E(acc, cur, wr, wc, fr, fq);
        if (!has_next) break;
        if constexpr (Epi::F8) {
#pragma unroll
            for (int a = 0; a < 2; ++a)
#pragma unroll
                for (int b = 0; b < 2; ++b)
#pragma unroll
                    for (int j = 0; j < 32; ++j) accv[a][b][j] = 0.f;
        }
#pragma unroll
        for (int a = 0; a < 2; ++a)
#pragma unroll
            for (int b = 0; b < 2; ++b)
#pragma unroll
                for (int m = 0; m < 4; ++m)
#pragma unroll
                    for (int n = 0; n < 2; ++n) acc[a][b][m][n] = (f32x4){0.f, 0.f, 0.f, 0.f};
        cur = nxt; cB = nB; vA0[0] = vN0[0]; vA0[1] = vN0[1]; vA1[0] = vN1[0]; vA1[1] = vN1[1]; ++ui;
    }
    G_WAIT_V(0);
    if (wr == 0) G_BAR;
    G_BAR;
#undef G_SA
#undef G_SB
#undef G_STAGE
#undef G_LDA
#undef G_LDB
#undef G_MMA
#undef G_WAIT_V
#undef G_WAIT_L
#undef G_BAR
#undef G_SCHED
}

template <int NT, bool F8, class F>
__device__ __forceinline__ void transpose_strip(const float* __restrict__ src, int sld, int k0, int n0, void* __restrict__ dstv, int dld, F drow, LAS float* sm) {
    const int tid = threadIdx.x, kr = tid >> 3, c8 = (tid & 7) * 8;
    f32x4 a[NT], b[NT];
#pragma unroll
    for (int t = 0; t < NT; ++t) { a[t] = *(const f32x4*)(src + (size_t)(k0 + kr) * sld + n0 + t * 64 + c8); b[t] = *(const f32x4*)(src + (size_t)(k0 + kr) * sld + n0 + t * 64 + c8 + 4); }
#pragma unroll
    for (int t = 0; t < NT; ++t) {
        LAS float* w = sm + t * (64 * 65) + kr * 65 + c8;
        w[0] = a[t][0]; w[1] = a[t][1]; w[2] = a[t][2]; w[3] = a[t][3]; w[4] = b[t][0]; w[5] = b[t][1]; w[6] = b[t][2]; w[7] = b[t][3];
    }
    __syncthreads();
    const int nr = tid >> 3, k8 = (tid & 7) * 8;
#pragma unroll
    for (int t = 0; t < NT; ++t) {
        float v[8];
#pragma unroll
        for (int i = 0; i < 8; ++i) v[i] = sm[t * (64 * 65) + (k8 + i) * 65 + nr];
        if constexpr (F8) {
            *(u32x2*)((unsigned char*)dstv + (size_t)drow(n0 + t * 64 + nr) * dld + k0 + k8) =
                (u32x2){pk_fp8x4(v[0] * WSCALE8, v[1] * WSCALE8, v[2] * WSCALE8, v[3] * WSCALE8), pk_fp8x4(v[4] * WSCALE8, v[5] * WSCALE8, v[6] * WSCALE8, v[7] * WSCALE8)};
        } else {
            u32x4 o; o.x = cvt_pk_bf16(v[0], v[1]); o.y = cvt_pk_bf16(v[2], v[3]); o.z = cvt_pk_bf16(v[4], v[5]); o.w = cvt_pk_bf16(v[6], v[7]);
            *(u32x4*)((bf16_t*)dstv + (size_t)drow(n0 + t * 64 + nr) * dld + k0 + k8) = o;
        }
    }
    __syncthreads();
}
__device__ __forceinline__ int drow_in(int s) {
    const int sec = s >> 10, i = s & 1023, h = i >> 7, j = i & 127;
    switch (sec) {
        case 0: return h * 256 + j;
        case 1: return h * 256 + 128 + j;
        case 2: return (8 + (i >> 8)) * 256 + (i & 255);
        case 3: return (12 + h) * 256 + j;
        case 4: return (20 + (i >> 8)) * 256 + (i & 255);
        case 5: return (24 + h) * 256 + j;
        case 6: return (12 + h) * 256 + 128 + j;
        default: return (24 + h) * 256 + 128 + j;
    }
}
__device__ __forceinline__ void phase_prep(const Params& p, LAS unsigned char* lds) {
    LAS float* sm = (LAS float*)lds;
    const int nwg = gridDim.x, wg = blockIdx.x;
    constexpr int NT_TOTAL = 512 + 64 + 1024 * 3 + 16 * 3 + 16 * 2 + 16;
    const bool experts_here = gridDim.x != 256;
    for (int it = wg; it < NT_TOTAL; it += nwg) {
        int t = it;
        if (!experts_here && t >= 576 && t < 576 + 3072) continue;
        if (t < 512) { const int kt = t >> 5, ns = t & 31; transpose_strip<4, false>(p.w_in, 8192, kt * 64, ns * 256, p.Bt_in, 1024, [](int n) { return drow_in(n); }, sm); continue; }
        t -= 512;
        if (t < 64) { const int kt = t >> 2, ns = t & 3; transpose_strip<4, false>(p.w_out, 1024, kt * 64, ns * 256, p.Bt_out, 1024, [](int n) { return n; }, sm); continue; }
        t -= 64;
        if (t < 1024) { const int e = t >> 4, kt = t & 15; transpose_strip<4, true>(p.we_gate + (size_t)e * D * DE, DE, kt * 64, 0, p.Bt_gu + (size_t)e * 512 * D, D, [](int n) { return (n >> 7) * 256 + (n & 127); }, sm); continue; }
        t -= 1024;
        if (t < 1024) { const int e = t >> 4, kt = t & 15; transpose_strip<4, true>(p.we_up + (size_t)e * D * DE, DE, kt * 64, 0, p.Bt_gu + (size_t)e * 512 * D, D, [](int n) { return (n >> 7) * 256 + 128 + (n & 127); }, sm); continue; }
        t -= 1024;
        if (t < 1024) { const int e = t >> 4, r = t & 15, kt = r >> 2, ns = r & 3; transpose_strip<4, true>(p.we_down + (size_t)e * DE * D, D, kt * 64, ns * 256, p.Bt_d + (size_t)e * D * DE, DE, [](int n) { return n; }, sm); continue; }
        t -= 1024;
        if (t < 16) { transpose_strip<4, true>(p.ws_gate, DE, t * 64, 0, p.Bt_sgu, D, [](int n) { return (n >> 7) * 256 + (n & 127); }, sm); continue; }
        t -= 16;
        if (t < 16) { transpose_strip<4, true>(p.ws_up, DE, t * 64, 0, p.Bt_sgu, D, [](int n) { return (n >> 7) * 256 + 128 + (n & 127); }, sm); continue; }
        t -= 16;
        if (t < 16) { const int kt = t >> 2, ns = t & 3; transpose_strip<4, true>(p.ws_down, D, kt * 64, ns * 256, p.Bt_sd, DE, [](int n) { return n; }, sm); continue; }
        t -= 16;
        if (t < 16) { const int e = t >> 1, kt = t & 1; transpose_strip<2, false>(p.lru_wa + (size_t)e * 16384, 128, kt * 64, 0, p.Bt_wa + (size_t)e * 16384, 128, [](int n) { return n; }, sm); continue; }
        t -= 16;
        if (t < 16) { const int e = t >> 1, kt = t & 1; transpose_strip<2, false>(p.lru_wx + (size_t)e * 16384, 128, kt * 64, 0, p.Bt_wx + (size_t)e * 16384, 128, [](int n) { return n; }, sm); continue; }
        t -= 16;
        { transpose_strip<1, false>(p.router_w, NE, t * 64, 0, p.Bt_r, D, [](int n) { return n; }, sm); }
    }
    {
        const int wv = threadIdx.x >> 6, lane = threadIdx.x & 63;
        f32x4 g0v[4], b0v[4];
#pragma unroll
        for (int j = 0; j < 4; ++j) { g0v[j] = *(const f32x4*)(p.ln_in_g + j * 256 + lane * 4); b0v[j] = *(const f32x4*)(p.ln_in_b + j * 256 + lane * 4); }
        for (int it = wg; it < TP / 8; it += nwg) {
            const int row = it * 8 + wv;
            const int bb = row / LP, pos = row % LP;
            bf16_t* dst = p.h0 + (size_t)row * D;
            if (pos < PADR) {
#pragma unroll
                for (int j = 0; j < 4; ++j) *(u32x2*)(dst + j * 256 + lane * 4) = (u32x2){0u, 0u};
                continue;
            }
            const float* src = pos < 64 ? p.meta + (size_t)(pos - PADR) * D : p.x + ((size_t)bb * SEQ + (pos - 64)) * D;
            f32x4 v[4]; float s = 0.f;
#pragma unroll
            for (int j = 0; j < 4; ++j) { v[j] = *(const f32x4*)(src + j * 256 + lane * 4); s += (v[j][0] + v[j][1]) + (v[j][2] + v[j][3]); }
            const float mean = wave_sum(s) * (1.0f / D);
            float q = 0.f;
#pragma unroll
            for (int j = 0; j < 4; ++j) { const f32x4 d = v[j] - mean; q += (d[0] * d[0] + d[1] * d[1]) + (d[2] * d[2] + d[3] * d[3]); }
            const float rstd = rsqrtf(wave_sum(q) * (1.0f / D) + 1e-5f);
#pragma unroll
            for (int j = 0; j < 4; ++j) {
                const int c0 = j * 256 + lane * 4;
                const f32x4 o = (v[j] - mean) * rstd * g0v[j] + b0v[j];
                *(u32x2*)(dst + c0) = (u32x2){cvt_pk_bf16(o[0], o[1]), cvt_pk_bf16(o[2], o[3])};
            }
        }
    }
    { const int t0 = tid_opaque(); if (wg == 0 && t0 < 64) p.cnt[t0 * 64] = 0; }
    for (int i = wg * NTHR + threadIdx.x; i < 64 * 4 * 4 * 64; i += nwg * NTHR) p.xg[i] = 0ull;
    for (int s = wg * NTHR + threadIdx.x; s < 1024; s += nwg * NTHR) p.lb[s] = 1.0f / (1.0f + expf(p.lbl[D + s] - p.lbl[s]));
    for (int s = wg * NTHR + threadIdx.x; s < 8192; s += nwg * NTHR) p.bperm[drow_in(s)] = p.b_in[s];
}

struct Sched3 {
    int G, c;
    __device__ __forceinline__ bool next(int i, Unit& u) const {
        const int L = i * G + c; if (L >= 128 * 4) return false;
        int pm, pn; tile_order(L, 128, 4, pm, pn);
        u.pm = pm; u.pn = pn; u.a0 = (pm >> 4) * LP + 64 + (pm & 15) * 256; u.boff = (long long)pn * 256 * D * 2; u.e = 0; u.r = 0; return true;
    }
    __device__ __forceinline__ void a_off(const Unit& u, const int (&R)[2], const int (&C)[2], int KB, unsigned (&v0)[2], unsigned (&v1)[2]) const {
#pragma unroll
        for (int i = 0; i < 2; ++i) { v0[i] = (unsigned)((u.a0 + R[i]) * KB + C[i] * 2); v1[i] = (unsigned)((u.a0 + HALF + R[i]) * KB + C[i] * 2); }
    }
};
struct Epi3 {
    static constexpr int PERM = 1; static constexpr bool F8 = false;
    const bf16_t* __restrict__ h0; bf16_t* __restrict__ pre1;
    __device__ __forceinline__ void operator()(const f32x4 (&acc)[2][2][4][2], const Unit& u, int wr, int wc, int fr, int fq) const {
        int c0 = u.pn * 256 + wc * 32 + 8 * fq, rit = wr * 64 + fr;
        asm volatile("" : "+v"(c0), "+v"(rit));
        const bf16_t* hb = h0 + ((size_t)u.a0 + rit) * D + c0;
        bf16_t* pb = pre1 + ((size_t)u.pm * 256 + rit) * D + c0;
#pragma unroll
        for (int ai = 0; ai < 2; ++ai) {
            u32x4 hv[4][2];
#pragma unroll
            for (int m = 0; m < 4; ++m)
#pragma unroll
                for (int bj = 0; bj < 2; ++bj) hv[m][bj] = *(const u32x4*)(hb + (size_t)(ai * HALF + m * 16) * D + bj * HALF);
#pragma unroll
            for (int m = 0; m < 4; ++m)
#pragma unroll
                for (int bj = 0; bj < 2; ++bj) {
                    const u32x4 h = hv[m][bj]; const f32x4 v0 = acc[ai][bj][m][0], v1 = acc[ai][bj][m][1];
                    u32x4 w;
                    w.x = cvt_pk_bf16(v0[0] + ALPHA * __uint_as_float(h.x << 16), v0[1] + ALPHA * __uint_as_float(h.x & 0xffff0000u));
                    w.y = cvt_pk_bf16(v0[2] + ALPHA * __uint_as_float(h.y << 16), v0[3] + ALPHA * __uint_as_float(h.y & 0xffff0000u));
                    w.z = cvt_pk_bf16(v1[0] + ALPHA * __uint_as_float(h.z << 16), v1[1] + ALPHA * __uint_as_float(h.z & 0xffff0000u));
                    w.w = cvt_pk_bf16(v1[2] + ALPHA * __uint_as_float(h.w << 16), v1[3] + ALPHA * __uint_as_float(h.w & 0xffff0000u));
                    *(u32x4*)(pb + (size_t)(ai * HALF + m * 16) * D + bj * HALF) = w;
                }
            asm volatile("" ::: "memory");
        }
    }
};
__device__ __forceinline__ void phase3(const Params& p, LAS unsigned char* lds) {
    Sched3 S{(int)gridDim.x, (int)blockIdx.x}; Epi3 E{p.h0, p.pre1};
    gemm_phase(lds, p.G1, p.Bt_out, D * 2, S, E);
}

__device__ __forceinline__ float fast_sigmoid(float z) { return __builtin_amdgcn_rcpf(1.0f + __builtin_amdgcn_exp2f(-1.4426950408889634f * z)); }
template <int N> __device__ __forceinline__ float dpp_row_shr(float v) { return __int_as_float(__builtin_amdgcn_update_dpp(0, __float_as_int(v), 0x110 + N, 0xF, 0xF, false)); }
__device__ __forceinline__ float row16_incl_scan(float v) { v += dpp_row_shr<1>(v); v += dpp_row_shr<2>(v); v += dpp_row_shr<4>(v); v += dpp_row_shr<8>(v); return v; }
struct Sched1 {
    int G, c;
    __device__ __forceinline__ bool next(int i, Unit& u) const {
        const int L = i * G + c; if (L >= 130 * 32) return false;
        int pm, pn; tile_order(L, 130, 32, pm, pn);
        u.pm = pm; u.pn = pn; u.a0 = pm * 256; u.boff = (long long)pn * 256 * D * 2; u.e = 0; u.r = 0; return true;
    }
    __device__ __forceinline__ void a_off(const Unit& u, const int (&R)[2], const int (&C)[2], int KB, unsigned (&v0)[2], unsigned (&v1)[2]) const {
#pragma unroll
        for (int i = 0; i < 2; ++i) { v0[i] = (unsigned)((u.a0 + R[i]) * KB + C[i] * 2); v1[i] = (unsigned)((u.a0 + HALF + R[i]) * KB + C[i] * 2); }
    }
};
struct Epi1 {
    static constexpr int PERM = 1; static constexpr bool F8 = false;
    const LAS bf16_t* sbias; const LAS float* slb;
    bf16_t* __restrict__ Qh; bf16_t* __restrict__ Kh; bf16_t* __restrict__ Vv; bf16_t* __restrict__ G1; bf16_t* __restrict__ LX; bf16_t* __restrict__ G2; float* __restrict__ Dk;
    __device__ __forceinline__ void ld8(const LAS bf16_t* p, f32x4& lo, f32x4& hi) const {
        const u32x4 v = *(const LAS u32x4*)p;
        lo = (f32x4){__uint_as_float(v.x << 16), __uint_as_float(v.x & 0xffff0000u), __uint_as_float(v.y << 16), __uint_as_float(v.y & 0xffff0000u)};
        hi = (f32x4){__uint_as_float(v.z << 16), __uint_as_float(v.z & 0xffff0000u), __uint_as_float(v.w << 16), __uint_as_float(v.w & 0xffff0000u)};
    }
    __device__ __forceinline__ void operator()(const f32x4 (&acc)[2][2][4][2], const Unit& u, int wr, int wc, int fr, int fq) const {
        const int pn = u.pn, col8 = wc * 32 + fq * 8;
        const size_t row0 = (size_t)u.pm * 256 + wr * 64 + fr;
        if (pn < 8) {
            f32x4 bq0, bq1, bf0, bf1; ld8(sbias + pn * 256 + col8, bq0, bq1); ld8(sbias + pn * 256 + 128 + col8, bf0, bf1);
            const f32x4 lb0 = *(const LAS f32x4*)(slb + pn * 128 + col8), lb1 = *(const LAS f32x4*)(slb + pn * 128 + col8 + 4);
            const int lane16 = (int)(threadIdx.x & 48) | 15;
#pragma unroll
            for (int ai = 0; ai < 2; ++ai) {
                const int chunk = u.pm * 4 + ai * 2 + wr;
                const bool first = (chunk % NCH) == 0;
                float carry[2][4];
#pragma unroll
                for (int n = 0; n < 2; ++n)
#pragma unroll
                    for (int j = 0; j < 4; ++j) carry[n][j] = 0.f;
#pragma unroll
                for (int m = 0; m < 4; ++m) {
                    const bool pad = first && (m * 16 + fr < PADR);
                    float qo[2][4], ko[2][4];
#pragma unroll
                    for (int n = 0; n < 2; ++n)
#pragma unroll
                        for (int j = 0; j < 4; ++j) {
                            const float qv = acc[ai][0][m][n][j] + (n ? bq1[j] : bq0[j]);
                            const float z = acc[ai][1][m][n][j] + (n ? bf1[j] : bf0[j]);
                            const float lbv = n ? lb1[j] : lb0[j];
                            const float f = lbv + (1.0f - lbv) * fast_sigmoid(z);
                            const float l2 = pad ? 0.f : __builtin_amdgcn_logf(f);
                            const float s = row16_incl_scan(l2) + carry[n][j];
                            carry[n][j] = __shfl(s, lane16);
                            qo[n][j] = qv * fast_sigmoid(qv) * __builtin_amdgcn_exp2f(s);
                            ko[n][j] = pad ? 0.f : (1.0f - f) * __builtin_amdgcn_exp2f(fminf(-s, 120.0f));
                        }
                    const size_t o = (row0 + ai * HALF + m * 16) * D + pn * 128 + col8;
                    u32x4 wq, wk;
                    wq.x = cvt_pk_bf16(qo[0][0], qo[0][1]); wq.y = cvt_pk_bf16(qo[0][2], qo[0][3]); wq.z = cvt_pk_bf16(qo[1][0], qo[1][1]); wq.w = cvt_pk_bf16(qo[1][2], qo[1][3]);
                    wk.x = cvt_pk_bf16(ko[0][0], ko[0][1]); wk.y = cvt_pk_bf16(ko[0][2], ko[0][3]); wk.z = cvt_pk_bf16(ko[1][0], ko[1][1]); wk.w = cvt_pk_bf16(ko[1][2], ko[1][3]);
                    *(u32x4*)(Qh + o) = wq; *(u32x4*)(Kh + o) = wk;
                }
                if (fr == 0) {
                    float* dp = Dk + (size_t)chunk * D + pn * 128 + col8;
                    *(f32x4*)dp = (f32x4){__builtin_amdgcn_exp2f(carry[0][0]), __builtin_amdgcn_exp2f(carry[0][1]), __builtin_amdgcn_exp2f(carry[0][2]), __builtin_amdgcn_exp2f(carry[0][3])};
                    *(f32x4*)(dp + 4) = (f32x4){__builtin_amdgcn_exp2f(carry[1][0]), __builtin_amdgcn_exp2f(carry[1][1]), __builtin_amdgcn_exp2f(carry[1][2]), __builtin_amdgcn_exp2f(carry[1][3])};
                }
            }
        } else if ((pn >= 8 && pn < 12) || (pn >= 20 && pn < 24)) {
            bf16_t* dst = pn < 12 ? Vv : LX; const int cb = (pn - (pn < 12 ? 8 : 20)) * 256;
#pragma unroll
            for (int bj = 0; bj < 2; ++bj) {
                f32x4 b0, b1; ld8(sbias + pn * 256 + bj * HALF + col8, b0, b1);
#pragma unroll
                for (int ai = 0; ai < 2; ++ai)
#pragma unroll
                    for (int m = 0; m < 4; ++m) {
                        const f32x4 v0 = acc[ai][bj][m][0] + b0, v1 = acc[ai][bj][m][1] + b1;
                        u32x4 w; w.x = cvt_pk_bf16(v0[0], v0[1]); w.y = cvt_pk_bf16(v0[2], v0[3]); w.z = cvt_pk_bf16(v1[0], v1[1]); w.w = cvt_pk_bf16(v1[2], v1[3]);
                        *(u32x4*)(dst + (row0 + ai * HALF + m * 16) * D + cb + bj * HALF + col8) = w;
                    }
            }
        } else {
            const bool is1 = pn < 20; bf16_t* dst = is1 ? G1 : G2; const int cb = (pn - (is1 ? 12 : 24)) * 128;
            f32x4 ba0, ba1, bg0, bg1; ld8(sbias + pn * 256 + col8, ba0, ba1); ld8(sbias + pn * 256 + 128 + col8, bg0, bg1);
#pragma unroll
            for (int ai = 0; ai < 2; ++ai)
#pragma unroll
                for (int m = 0; m < 4; ++m) {
                    float o[2][4];
#pragma unroll
                    for (int n = 0; n < 2; ++n)
#pragma unroll
                        for (int j = 0; j < 4; ++j) {
                            const float a = acc[ai][0][m][n][j] + (n ? ba1[j] : ba0[j]);
                            const float g = acc[ai][1][m][n][j] + (n ? bg1[j] : bg0[j]);
                            const float arg = is1 ? a : 1.5957691216057308f * (a + 0.044715f * a * a * a);
                            o[n][j] = a * fast_sigmoid(arg) * fast_sigmoid(g);
                        }
                    u32x4 w; w.x = cvt_pk_bf16(o[0][0], o[0][1]); w.y = cvt_pk_bf16(o[0][2], o[0][3]); w.z = cvt_pk_bf16(o[1][0], o[1][1]); w.w = cvt_pk_bf16(o[1][2], o[1][3]);
                    *(u32x4*)(dst + (row0 + ai * HALF + m * 16) * D + cb + col8) = w;
                }
        }
    }
};
__device__ __forceinline__ void phase1(const Params& p, LAS unsigned char* lds) {
    LAS bf16_t* sbias = (LAS bf16_t*)(lds + STAGE_BYTES); LAS float* slb = (LAS float*)(lds + STAGE_BYTES + 16384);
    for (int i = threadIdx.x; i < 8192; i += NTHR) sbias[i] = f2bf(p.bperm[i]);
    for (int i = threadIdx.x; i < 1024; i += NTHR) slb[i] = p.lb[i];
    __syncthreads();
    Sched1 S{(int)gridDim.x, (int)blockIdx.x}; Epi1 E{sbias, slb, p.Qh, p.Kh, p.Vv, p.G1, p.LX, p.G2, p.Dk};
    gemm_phase(lds, p.h0, p.Bt_in, D * 2, S, E);
}

__device__ __forceinline__ void phase4(const Params& p, LAS unsigned char* lds) {
    constexpr int ASTR = 2064;
    LAS unsigned char* Aimg = lds;
    LAS float* sc = (LAS float*)(lds + 64 * ASTR);
    LAS int* asg_e = (LAS int*)(lds + 64 * ASTR + 16384);
    LAS float* asg_w = (LAS float*)(asg_e + 384);
    LAS int* asg_r = (LAS int*)(asg_w + 384);
    LAS int* cntL = asg_r + 384;
    LAS int* baseL = cntL + 64;
    const int tid = tid_opaque(), wv = tid >> 6, lane = tid & 63;
    bf16x8 rwf[16];
#pragma unroll
    for (int ks = 0; ks < 16; ++ks) rwf[ks] = *(const bf16x8*)(p.Bt_r + (size_t)((wv & 3) * 16 + (lane & 15)) * D + 512 * (wv >> 2) + 32 * ks + 8 * (lane >> 4));
    f32x4 g1v[4], b1v[4];
#pragma unroll
    for (int j = 0; j < 4; ++j) { g1v[j] = *(const f32x4*)(p.ln1_g + j * 256 + lane * 4); b1v[j] = *(const f32x4*)(p.ln1_b + j * 256 + lane * 4); }
    for (int tile = blockIdx.x; tile < T / 64; tile += gridDim.x) {
        if (tid < 64) cntL[tid] = 0;
        *(LAS f32x4*)(sc + tid * 8) = (f32x4){0.f, 0.f, 0.f, 0.f}; *(LAS f32x4*)(sc + tid * 8 + 4) = (f32x4){0.f, 0.f, 0.f, 0.f};
        u32x2 vn[4];
#pragma unroll
        for (int j = 0; j < 4; ++j) vn[j] = *(const u32x2*)(p.pre1 + ((size_t)tile * 64 + wv * 8) * D + j * 256 + lane * 4);
        for (int i = 0; i < 8; ++i) {
            const int tl = wv * 8 + i; const size_t tok = (size_t)tile * 64 + tl;
            f32x4 v[4]; float s = 0.f;
#pragma unroll
            for (int j = 0; j < 4; ++j) { v[j] = (f32x4){__uint_as_float(vn[j].x << 16), __uint_as_float(vn[j].x & 0xffff0000u), __uint_as_float(vn[j].y << 16), __uint_as_float(vn[j].y & 0xffff0000u)}; s += (v[j][0] + v[j][1]) + (v[j][2] + v[j][3]); }
            { const size_t tokn = tok + (i < 7 ? 1 : 0);
#pragma unroll
              for (int j = 0; j < 4; ++j) vn[j] = *(const u32x2*)(p.pre1 + tokn * D + j * 256 + lane * 4); }
            const float mean = wave_sum(s) * (1.0f / D);
            float q = 0.f;
#pragma unroll
            for (int j = 0; j < 4; ++j) { const f32x4 d = v[j] - mean; q += (d[0] * d[0] + d[1] * d[1]) + (d[2] * d[2] + d[3] * d[3]); }
            const float rstd = rsqrtf(wave_sum(q) * (1.0f / D) + 1e-5f);
#pragma unroll
            for (int j = 0; j < 4; ++j) {
                const int c0 = j * 256 + lane * 4;
                const f32x4 o = (v[j] - mean) * rstd * g1v[j] + b1v[j];
                const u32x2 w = (u32x2){cvt_pk_bf16(o[0], o[1]), cvt_pk_bf16(o[2], o[3])};
                *(u32x2*)(p.h1 + tok * D + c0) = w;
                *(unsigned*)(p.h1q + tok * D + c0) = pk_fp8x4(o[0], o[1], o[2], o[3]);
                *(LAS u32x2*)(Aimg + tl * ASTR + c0 * 2) = w;
            }
        }
        __syncthreads();
        {
            const int fr = lane & 15, fq = lane >> 4, nt = wv & 3, kh = wv >> 2;
            f32x4 ac[4];
#pragma unroll
            for (int mt = 0; mt < 4; ++mt) ac[mt] = (f32x4){0.f, 0.f, 0.f, 0.f};
#pragma unroll
            for (int ks = 0; ks < 16; ++ks)
#pragma unroll
                for (int mt = 0; mt < 4; ++mt) {
                    const bf16x8 a = *(const LAS bf16x8*)(Aimg + (mt * 16 + fr) * ASTR + (512 * kh + 32 * ks + 8 * fq) * 2);
                    ac[mt] = __builtin_amdgcn_mfma_f32_16x16x32_bf16(a, rwf[ks], ac[mt], 0, 0, 0);
                }
#pragma unroll
            for (int mt = 0; mt < 4; ++mt)
#pragma unroll
                for (int r = 0; r < 4; ++r) __hip_atomic_fetch_add(sc + (mt * 16 + fq * 4 + r) * 64 + nt * 16 + fr, ac[mt][r], __ATOMIC_RELAXED, __HIP_MEMORY_SCOPE_WORKGROUP);
        }
        __syncthreads();
        const float rb = p.router_b[lane];
        for (int i = 0; i < 8; ++i) {
            const int tl = wv * 8 + i; const size_t tok = (size_t)tile * 64 + tl;
            const float sg = fast_sigmoid(sc[tl * 64 + lane]);
            float sel = sg + rb; float ssum = 0.f; int my_e = 0; float my_s = 0.f;
#pragma unroll
            for (int kk = 0; kk < TOPK; ++kk) {
                const int NEG = (int)0xff800000u;
                float v = sel;
                v = fmaxf(v, __int_as_float(__builtin_amdgcn_update_dpp(NEG, __float_as_int(v), 0x111, 0xF, 0xF, false)));
                v = fmaxf(v, __int_as_float(__builtin_amdgcn_update_dpp(NEG, __float_as_int(v), 0x112, 0xF, 0xF, false)));
                v = fmaxf(v, __int_as_float(__builtin_amdgcn_update_dpp(NEG, __float_as_int(v), 0x114, 0xF, 0xF, false)));
                v = fmaxf(v, __int_as_float(__builtin_amdgcn_update_dpp(NEG, __float_as_int(v), 0x118, 0xF, 0xF, false)));
                v = fmaxf(v, __int_as_float(__builtin_amdgcn_update_dpp(NEG, __float_as_int(v), 0x142, 0xA, 0xF, false)));
                v = fmaxf(v, __int_as_float(__builtin_amdgcn_update_dpp(NEG, __float_as_int(v), 0x143, 0xC, 0xF, false)));
                const float mx = __int_as_float(__builtin_amdgcn_readlane(__float_as_int(v), 63));
                const unsigned long long mk = __ballot(sel == mx);
                const int bi = __builtin_amdgcn_readfirstlane((int)__builtin_ctzll(mk));
                const float ws = __int_as_float(__builtin_amdgcn_readlane(__float_as_int(sg), bi)); ssum += ws;
                if (lane == kk) { my_e = bi; my_s = ws; }
                if (lane == bi) sel = -3.0e38f;
            }
            if (lane < TOPK) {
                const float w = my_s / ssum * 2.5f;
                asg_e[tl * TOPK + lane] = my_e; asg_w[tl * TOPK + lane] = w;
                p.ridx[tok * TOPK + lane] = my_e; p.rwts[tok * TOPK + lane] = w;
            }
        }
        __syncthreads();
        if (tid < 384) asg_r[tid] = __hip_atomic_fetch_add(cntL + asg_e[tid], 1, __ATOMIC_RELAXED, __HIP_MEMORY_SCOPE_WORKGROUP);
        __syncthreads();
        if (tid < 64) { const int c = cntL[tid]; baseL[tid] = c ? __hip_atomic_fetch_add(p.cnt + tid * 64, c, __ATOMIC_RELAXED, __HIP_MEMORY_SCOPE_AGENT) : 0; }
        __syncthreads();
        if (tid < 384) { const int e = asg_e[tid]; const int slot = baseL[e] + asg_r[tid]; p.list_tok[(size_t)e * T + slot] = tile * 384 + tid; p.list_w[(size_t)e * T + slot] = asg_w[tid]; }
        __syncthreads();
    }
}

constexpr int ACT_S_ROW0 = 832 * 256;
__device__ __forceinline__ void moe_table(const Params& p, LAS unsigned char* lds) {
    LAS int* tb = (LAS int*)(lds + STAGE_BYTES); LAS int* ce = tb + 80;
    const int tm = tid_opaque();
    if (tm < 64) {
        const int lane = tm; const int c = p.cnt[lane * 64]; const int tl = (c + 255) >> 8;
        int s = tl;
#pragma unroll
        for (int o = 1; o < 64; o <<= 1) { const int t = __shfl_up(s, o); if (lane >= o) s += t; }
        tb[lane] = s - tl; ce[lane] = c; if (lane == 63) tb[64] = s;
    }
    __syncthreads();
}
template <int NCU  >
struct SchedMoe {
    int G, c; const LAS int* tb; const LAS int* ce; const int* list_tok; long long sh_boff; long long e_stride; int KB;
    __device__ __forceinline__ bool next(int i, Unit& u) const {
        const int NT = __builtin_amdgcn_readfirstlane(tb[64]); const int L = i * G + c;
        if (L >= NCU * NT + NCU * 128) return false;
        if (L < NCU * NT) {
            int t, j; tile_order(L, NT, NCU, t, j);
            int lane = threadIdx.x & 63; asm volatile("" : "+v"(lane));
            const unsigned long long mk = __ballot(tb[lane] <= t);
            const int e = __builtin_amdgcn_readfirstlane((int)__popcll(mk) - 1);
            const int tbe = __builtin_amdgcn_readfirstlane(tb[e]);
            u.e = e; u.r = t - tbe; u.pm = t; u.pn = j; u.a0 = t * 256; u.boff = (long long)e * e_stride + (long long)j * 256 * KB;
        } else {
            int pm, j; tile_order(L - NCU * NT, 128, NCU, pm, j);
            u.e = -1; u.r = 0; u.pm = pm; u.pn = j; u.a0 = ACT_S_ROW0 + pm * 256; u.boff = sh_boff + (long long)j * 256 * KB;
        }
        return true;
    }
    __device__ __forceinline__ void a_off(const Unit& u, const int (&R)[2], const int (&C)[2], int K_, unsigned (&v0)[2], unsigned (&v1)[2]) const {
        if (NCU == 4) {
#pragma unroll
            for (int i = 0; i < 2; ++i) { v0[i] = (unsigned)((u.a0 + R[i]) * K_ + C[i] * 2); v1[i] = (unsigned)((u.a0 + HALF + R[i]) * K_ + C[i] * 2); }
        } else if (u.e < 0) {
#pragma unroll
            for (int i = 0; i < 2; ++i) { v0[i] = (unsigned)((u.pm * 256 + R[i]) * K_ + C[i] * 2); v1[i] = (unsigned)((u.pm * 256 + HALF + R[i]) * K_ + C[i] * 2); }
        } else {
            const int n = __builtin_amdgcn_readfirstlane(ce[u.e]); const int* lt = list_tok + (size_t)u.e * T;
#pragma unroll
            for (int i = 0; i < 2; ++i) {
                const int s0 = u.r * 256 + R[i], s1 = s0 + HALF;
                const int t0 = s0 < n ? lt[s0] / TOPK : 0, t1 = s1 < n ? lt[s1] / TOPK : 0;
                v0[i] = (unsigned)(t0 * K_ + C[i] * 2); v1[i] = (unsigned)(t1 * K_ + C[i] * 2);
            }
        }
    }
};
struct Epi5 {
    static constexpr int PERM = 1; static constexpr bool F8 = true;
    const LAS int* ce; const float* __restrict__ list_w; unsigned char* __restrict__ act;
    __device__ __forceinline__ void operator()(const f32x4 (&acc)[2][2][4][2], const Unit& u, int wr, int wc, int fr, int fq) const {
        int col8 = wc * 32 + fq * 8, rit = wr * 64 + fr;
        asm volatile("" : "+v"(col8), "+v"(rit));
        float w[2][4];
        if (u.e >= 0) {
            const int n = __builtin_amdgcn_readfirstlane(ce[u.e]); const float* lw = list_w + (size_t)u.e * T + u.r * 256;
#pragma unroll
            for (int ai = 0; ai < 2; ++ai)
#pragma unroll
                for (int m = 0; m < 4; ++m) { const int s = ai * HALF + m * 16 + rit; w[ai][m] = (u.r * 256 + s < n) ? lw[s] * (ASCALE8 / (WSCALE8 * WSCALE8)) : 0.f; }
        } else {
#pragma unroll
            for (int ai = 0; ai < 2; ++ai)
#pragma unroll
                for (int m = 0; m < 4; ++m) w[ai][m] = ASCALE8 / (WSCALE8 * WSCALE8);
        }
        unsigned char* ob = act + ((size_t)u.a0 + rit) * DE + u.pn * 128 + col8;
#pragma unroll
        for (int ai = 0; ai < 2; ++ai)
#pragma unroll
            for (int m = 0; m < 4; ++m) {
                float o[2][4];
#pragma unroll
                for (int n = 0; n < 2; ++n)
#pragma unroll
                    for (int j = 0; j < 4; ++j) { const float g = acc[ai][0][m][n][j], uu = acc[ai][1][m][n][j]; o[n][j] = __builtin_amdgcn_fmed3f(g * __builtin_amdgcn_rcpf(1.0f + __builtin_amdgcn_exp2f(g * (-1.4426950408889634f / WSCALE8))) * uu * w[ai][m], -448.0f, 448.0f); }
                *(u32x2*)(ob + (size_t)(ai * HALF + m * 16) * DE) = (u32x2){pk_fp8x4(o[0][0], o[0][1], o[0][2], o[0][3]), pk_fp8x4(o[1][0], o[1][1], o[1][2], o[1][3])};
            }
    }
};
constexpr float YSCALE = 16.0f;
struct Epi6 {
    static constexpr int PERM = 2; static constexpr bool F8 = true;
    const LAS int* ce; const int* __restrict__ list_tok; unsigned char* __restrict__ yrows; const bf16_t* __restrict__ h1; bf16_t* __restrict__ base;
    __device__ __forceinline__ void operator()(const f32x4 (&acc)[2][2][4][2], const Unit& u, int wr, int wc, int fr, int fq) const {
        int col16 = wc * 64 + fq * 16, rit = wr * 64 + fr;
        asm volatile("" : "+v"(col16), "+v"(rit));
        if (u.e >= 0) {
            const int n = __builtin_amdgcn_readfirstlane(ce[u.e]); const int* lt = list_tok + (size_t)u.e * T + u.r * 256;
            int aid[2][4];
#pragma unroll
            for (int ai = 0; ai < 2; ++ai)
#pragma unroll
                for (int m = 0; m < 4; ++m) { const int s = ai * HALF + m * 16 + rit; aid[ai][m] = (u.r * 256 + s < n) ? lt[s] : -1; }
#pragma unroll
            for (int ai = 0; ai < 2; ++ai)
#pragma unroll
                for (int m = 0; m < 4; ++m) {
                    if (aid[ai][m] < 0) continue;
                    int wd[4];
#pragma unroll
                    for (int bj = 0; bj < 2; ++bj) {
                        const f32x4 v0 = acc[ai][bj][m][0] * (YSCALE / (ASCALE8 * WSCALE8)), v1 = acc[ai][bj][m][1] * (YSCALE / (ASCALE8 * WSCALE8));
                        int w0 = 0, w1 = 0;
                        w0 = __builtin_amdgcn_cvt_pk_fp8_f32(v0[0], v0[1], w0, false); w0 = __builtin_amdgcn_cvt_pk_fp8_f32(v0[2], v0[3], w0, true);
                        w1 = __builtin_amdgcn_cvt_pk_fp8_f32(v1[0], v1[1], w1, false); w1 = __builtin_amdgcn_cvt_pk_fp8_f32(v1[2], v1[3], w1, true);
                        wd[2 * bj] = w0; wd[2 * bj + 1] = w1;
                    }
                    *(u32x4*)(yrows + (size_t)aid[ai][m] * D + u.pn * 256 + col16) = (u32x4){(unsigned)wd[0], (unsigned)wd[1], (unsigned)wd[2], (unsigned)wd[3]};
                }
        } else {
            const size_t tok0 = (size_t)u.pm * 256 + rit;
            const int c0 = u.pn * 256 + col16;
#pragma unroll
            for (int ai = 0; ai < 2; ++ai) {
                u32x4 hv[4][2];
#pragma unroll
                for (int m = 0; m < 4; ++m)
#pragma unroll
                    for (int bj = 0; bj < 2; ++bj) hv[m][bj] = *(const u32x4*)(h1 + (tok0 + ai * HALF + m * 16) * D + c0 + bj * 8);
#pragma unroll
                for (int m = 0; m < 4; ++m)
#pragma unroll
                    for (int bj = 0; bj < 2; ++bj) {
                        const u32x4 h = hv[m][bj]; const f32x4 v0 = acc[ai][bj][m][0] * (1.0f / (ASCALE8 * WSCALE8)), v1 = acc[ai][bj][m][1] * (1.0f / (ASCALE8 * WSCALE8));
                        u32x4 w;
                        w.x = cvt_pk_bf16(v0[0] + ALPHA * __uint_as_float(h.x << 16), v0[1] + ALPHA * __uint_as_float(h.x & 0xffff0000u));
                        w.y = cvt_pk_bf16(v0[2] + ALPHA * __uint_as_float(h.y << 16), v0[3] + ALPHA * __uint_as_float(h.y & 0xffff0000u));
                        w.z = cvt_pk_bf16(v1[0] + ALPHA * __uint_as_float(h.z << 16), v1[1] + ALPHA * __uint_as_float(h.z & 0xffff0000u));
                        w.w = cvt_pk_bf16(v1[2] + ALPHA * __uint_as_float(h.w << 16), v1[3] + ALPHA * __uint_as_float(h.w & 0xffff0000u));
                        *(u32x4*)(base + (tok0 + ai * HALF + m * 16) * D + c0 + bj * 8) = w;
                    }
                asm volatile("" ::: "memory");
            }
        }
    }
};
__device__ __forceinline__ void phase5(const Params& p, LAS unsigned char* lds) {
    moe_table(p, lds);
    const LAS int* tb = (const LAS int*)(lds + STAGE_BYTES); const LAS int* ce = tb + 80;
    SchedMoe<2> S{(int)gridDim.x, (int)blockIdx.x, tb, ce, p.list_tok, (long long)((const char*)p.Bt_sgu - (const char*)p.Bt_gu), (long long)512 * D, D};
    Epi5 E{ce, p.list_w, p.act};
    gemm_phase(lds, p.h1q, p.Bt_gu, D, S, E);
}
__device__ __forceinline__ void phase6(const Params& p, LAS unsigned char* lds) {
    moe_table(p, lds);
    const LAS int* tb = (const LAS int*)(lds + STAGE_BYTES); const LAS int* ce = tb + 80;
    SchedMoe<4> S{(int)gridDim.x, (int)blockIdx.x, tb, ce, p.list_tok, (long long)((const char*)p.Bt_sd - (const char*)p.Bt_d), (long long)D * DE, DE};
    Epi6 E{ce, p.list_tok, p.yrows, p.h1, p.base};
    gemm_phase(lds, p.act, p.Bt_d, DE, S, E);
}
__device__ __forceinline__ void phase7(const Params& p) {
    const int tid7 = tid_opaque(); const int wv = tid7 >> 6, lane = tid7 & 63;
    const int c0 = lane * 16;
    f32x4 g[4], b[4];
#pragma unroll
    for (int q = 0; q < 4; ++q) { g[q] = *(const f32x4*)(p.ln2_g + c0 + q * 4); b[q] = *(const f32x4*)(p.ln2_b + c0 + q * 4); }
    u32x4 nb0, nb1, ny[TOPK];
    {
        const int tok = blockIdx.x * 8 + wv;
        nb0 = *(const u32x4*)(p.base + (size_t)tok * D + c0); nb1 = *(const u32x4*)(p.base + (size_t)tok * D + c0 + 8);
#pragma unroll
        for (int k = 0; k < TOPK; ++k) ny[k] = *(const u32x4*)(p.yrows + ((size_t)tok * TOPK + k) * D + c0);
    }
    for (int tok = blockIdx.x * 8 + wv; tok < T; tok += gridDim.x * 8) {
        const u32x4 b0 = nb0, b1 = nb1;
        u32x4 y[TOPK];
#pragma unroll
        for (int k = 0; k < TOPK; ++k) y[k] = ny[k];
        {
            const int tn = tok + (int)gridDim.x * 8 < T ? tok + (int)gridDim.x * 8 : tok;
            nb0 = *(const u32x4*)(p.base + (size_t)tn * D + c0); nb1 = *(const u32x4*)(p.base + (size_t)tn * D + c0 + 8);
#pragma unroll
            for (int k = 0; k < TOPK; ++k) ny[k] = *(const u32x4*)(p.yrows + ((size_t)tn * TOPK + k) * D + c0);
        }
        float r[16];
#pragma unroll
        for (int q = 0; q < 16; ++q) r[q] = 0.f;
#pragma unroll
        for (int k = 0; k < TOPK; ++k)
#pragma unroll
            for (int q = 0; q < 4; ++q) {
                const int wd = (int)y[k][q];
                const auto lo = __builtin_amdgcn_cvt_pk_f32_fp8(wd, false); const auto hi = __builtin_amdgcn_cvt_pk_f32_fp8(wd, true);
                r[q * 4 + 0] += lo[0]; r[q * 4 + 1] += lo[1]; r[q * 4 + 2] += hi[0]; r[q * 4 + 3] += hi[1];
            }
        float v[16];
#pragma unroll
        for (int q = 0; q < 4; ++q) {
            const unsigned w0 = q < 2 ? b0[q * 2] : b1[(q - 2) * 2], w1 = q < 2 ? b0[q * 2 + 1] : b1[(q - 2) * 2 + 1];
            v[q * 4 + 0] = __uint_as_float(w0 << 16) + r[q * 4 + 0] * (1.0f / YSCALE); v[q * 4 + 1] = __uint_as_float(w0 & 0xffff0000u) + r[q * 4 + 1] * (1.0f / YSCALE);
            v[q * 4 + 2] = __uint_as_float(w1 << 16) + r[q * 4 + 2] * (1.0f / YSCALE); v[q * 4 + 3] = __uint_as_float(w1 & 0xffff0000u) + r[q * 4 + 3] * (1.0f / YSCALE);
        }
        float s = 0.f;
#pragma unroll
        for (int q = 0; q < 16; ++q) s += v[q];
        const float mean = wave_sum(s) * (1.0f / D);
        float qq = 0.f;
#pragma unroll
        for (int q = 0; q < 16; ++q) { const float d = v[q] - mean; qq += d * d; }
        const float rstd = rsqrtf(wave_sum(qq) * (1.0f / D) + 1e-5f);
#pragma unroll
        for (int q = 0; q < 4; ++q) {
            f32x4 o;
#pragma unroll
            for (int j = 0; j < 4; ++j) o[j] = (v[q * 4 + j] - mean) * rstd * g[q][j] + b[q][j];
            *(f32x4*)(p.out + (size_t)tok * D + c0 + q * 4) = o;
        }
    }
}

typedef float f32x16 __attribute__((ext_vector_type(16)));
#define CROW(i, h) (((i) & 3) + 8 * ((i) >> 2) + 4 * (h))
__device__ __forceinline__ f32x16 mfma32(bf16x8 a, bf16x8 b, f32x16 c) { return __builtin_amdgcn_mfma_f32_32x32x16_bf16(a, b, c, 0, 0, 0); }
__device__ __forceinline__ bf16_t f2bf_fast(float f) { return (bf16_t)(cvt_pk_bf16(f, f) & 0xffffu); }
__device__ __forceinline__ void unpack8(const u32x4 v, float (&o)[8]) {
    o[0] = __uint_as_float(v.x << 16); o[1] = __uint_as_float(v.x & 0xffff0000u); o[2] = __uint_as_float(v.y << 16); o[3] = __uint_as_float(v.y & 0xffff0000u);
    o[4] = __uint_as_float(v.z << 16); o[5] = __uint_as_float(v.z & 0xffff0000u); o[6] = __uint_as_float(v.w << 16); o[7] = __uint_as_float(v.w & 0xffff0000u);
}
__device__ __forceinline__ void lru_chain(const Params& p, LAS unsigned char* lds, const int b, const int n, const bool dry = false) {
    constexpr int WSTR = 272, XSTR = 272;
    LAS unsigned char* WA = lds;
    LAS unsigned char* WX = lds + 128 * WSTR;
    LAS unsigned char* XC = lds + 2 * 128 * WSTR;
    LAS unsigned char* O2 = XC + 64 * XSTR;
    LAS float* CW = (LAS float*)(O2 + 64 * 256);
    LAS float* LSA = CW + 640;
    LAS float* LSU = LSA + 256;
    LAS float* CAR = LSU + 256;
    const int tid = threadIdx.x, w = __builtin_amdgcn_readfirstlane(tid >> 6), lane = tid & 63, r = lane & 31, h = lane >> 5, tau = w & 1, q4 = w >> 1;
    const int CB = n * 128;
    for (int i = tid; i < 128 * 16; i += NTHR) {
        const int row = i >> 4, pc = i & 15;
        *(LAS u32x4*)(WA + row * WSTR + pc * 16) = *(const u32x4*)(p.Bt_wa + ((size_t)n * 128 + row) * 128 + pc * 8);
        *(LAS u32x4*)(WX + row * WSTR + pc * 16) = *(const u32x4*)(p.Bt_wx + ((size_t)n * 128 + row) * 128 + pc * 8);
    }
    for (int i = tid; i < 640; i += NTHR) { const int j = i >> 7, c = i & 127; CW[i] = j < 4 ? p.conv_w[j * D + CB + c] : p.conv_b[CB + c]; }
    if (tid < 256) CAR[tid] = 0.f;
    const int dcol = CB + q4 * 32 + r;
    const float bav = p.lru_ba[dcol], bxv = p.lru_bx[dcol];
    const float c2 = -8.0f * log1pf(expf(-p.lru_lam[dcol])) * 1.4426950408889634f;
    const int cg = tid & 15, tg = tid >> 4, crow = tid >> 3, cseg = (tid & 7) * 16;
    u32x4 lx[5]; u32x4 g2[2];
    auto prefetch_lx = [&](int c) {
#pragma unroll
        for (int j = 0; j < 5; ++j) { int pos = c * 64 + 2 * tg - 3 + j; pos = pos < 0 ? 0 : pos; lx[j] = *(const u32x4*)(p.LX + ((size_t)b * LP + pos) * D + CB + cg * 8); }
    };
    auto prefetch_g2 = [&](int c) {
        const size_t R0 = (size_t)b * LP + c * 64;
        g2[0] = *(const u32x4*)(p.G2 + (R0 + crow) * D + CB + cseg); g2[1] = *(const u32x4*)(p.G2 + (R0 + crow) * D + CB + cseg + 8);
    };
    prefetch_lx(0); prefetch_g2(0);
    __syncthreads();
    for (int c = 0; c < NCH; ++c) {
        const size_t R0 = (size_t)b * LP + c * 64; const int par = c & 1;
        {
            float x[5][8];
#pragma unroll
            for (int j = 0; j < 5; ++j) { unpack8(lx[j], x[j]);
                if (c == 0 && 2 * tg - 3 + j < PADR) {
#pragma unroll
                    for (int e = 0; e < 8; ++e) x[j][e] = 0.f; } }
            float cw[5][8];
#pragma unroll
            for (int j = 0; j < 5; ++j) { const f32x4 a = *(const LAS f32x4*)(CW + j * 128 + cg * 8), bq = *(const LAS f32x4*)(CW + j * 128 + cg * 8 + 4);
                cw[j][0] = a[0]; cw[j][1] = a[1]; cw[j][2] = a[2]; cw[j][3] = a[3]; cw[j][4] = bq[0]; cw[j][5] = bq[1]; cw[j][6] = bq[2]; cw[j][7] = bq[3]; }
#pragma unroll
            for (int rr = 0; rr < 2; ++rr) {
                float y[8];
#pragma unroll
                for (int e = 0; e < 8; ++e) y[e] = __builtin_fmaf(cw[3][e], x[rr + 3][e], __builtin_fmaf(cw[2][e], x[rr + 2][e], __builtin_fmaf(cw[1][e], x[rr + 1][e], __builtin_fmaf(cw[0][e], x[rr][e], cw[4][e]))));
                u32x4 o; o.x = cvt_pk_bf16(y[0], y[1]); o.y = cvt_pk_bf16(y[2], y[3]); o.z = cvt_pk_bf16(y[4], y[5]); o.w = cvt_pk_bf16(y[6], y[7]);
                *(LAS u32x4*)(XC + (2 * tg + rr) * XSTR + cg * 16) = o;
            }
        }
        __syncthreads();
        prefetch_lx(c + 1 < NCH ? c + 1 : c);
        f32x16 Rg, Ig;
#pragma unroll
        for (int i = 0; i < 16; ++i) { Rg[i] = 0.f; Ig[i] = 0.f; }
#pragma unroll
        for (int ks = 0; ks < 8; ++ks) {
            const bf16x8 a = *(const LAS bf16x8*)(XC + (32 * tau + r) * XSTR + (16 * ks + 8 * h) * 2);
            const bf16x8 ba = *(const LAS bf16x8*)(WA + (32 * q4 + r) * WSTR + (16 * ks + 8 * h) * 2);
            const bf16x8 bx = *(const LAS bf16x8*)(WX + (32 * q4 + r) * WSTR + (16 * ks + 8 * h) * 2);
            Rg = mfma32(a, ba, Rg); Ig = mfma32(a, bx, Ig);
        }
        float av[16], uv[16];
#pragma unroll
        for (int i = 0; i < 16; ++i) {
            const int tl = 32 * tau + CROW(i, h);
            const float xcv = bf2f(*(const LAS bf16_t*)(XC + tl * XSTR + (32 * q4 + r) * 2));
            const float rr = fast_sigmoid(Rg[i] + bav), ii = fast_sigmoid(Ig[i] + bxv);
            float a = __builtin_amdgcn_exp2f(rr * c2);
            float u = __builtin_amdgcn_sqrtf(fmaxf(1.0f - a * a, 0.f)) * ii * xcv;
            if (c == 0 && tl < PADR) { a = 1.0f; u = 0.f; }
            av[i] = a; uv[i] = u;
        }
        float gA[4], gU[4];
#pragma unroll
        for (int g = 0; g < 4; ++g) {
            float cA = 1.0f, hl = 0.f;
#pragma unroll
            for (int j = 0; j < 4; ++j) { hl = av[4 * g + j] * hl + uv[4 * g + j]; cA *= av[4 * g + j]; av[4 * g + j] = cA; uv[4 * g + j] = hl; }
            gA[g] = cA; gU[g] = hl;
        }
        float rA = 1.0f, rU = 0.f;
#pragma unroll
        for (int g = 0; g < 4; ++g) {
            const float pA = __shfl_xor(gA[g], 32), pU = __shfl_xor(gU[g], 32);
            const float fA = h ? pA : gA[g], fU = h ? pU : gU[g];
            const float sA = h ? gA[g] : pA, sU = h ? gU[g] : pU;
            const float r1U = fA * rU + fU, r1A = fA * rA;
            const float stA = h ? r1A : rA, stU = h ? r1U : rU;
            rU = sA * r1U + sU; rA = sA * r1A;
#pragma unroll
            for (int j = 0; j < 4; ++j) { const float ca = av[4 * g + j]; uv[4 * g + j] = ca * stU + uv[4 * g + j]; av[4 * g + j] = ca * stA; }
        }
        if (tau == 0 && h == 0) { LSA[par * 128 + 32 * q4 + r] = rA; LSU[par * 128 + 32 * q4 + r] = rU; }
        __syncthreads();
        {
            const float cin = CAR[par * 128 + 32 * q4 + r];
            float hin = cin;
            if (tau == 1) { hin = LSA[par * 128 + 32 * q4 + r] * cin + LSU[par * 128 + 32 * q4 + r]; if (h == 0) CAR[(par ^ 1) * 128 + 32 * q4 + r] = rA * hin + rU; }
#pragma unroll
            for (int i = 0; i < 16; ++i) {
                const int tl = 32 * tau + CROW(i, h);
                *(LAS bf16_t*)(O2 + tl * 256 + (32 * q4 + r) * 2) = f2bf_fast(av[i] * hin + uv[i]);
            }
        }
        __syncthreads();
        {
            const u32x4 h0 = *(const LAS u32x4*)(O2 + crow * 256 + cseg * 2), h1 = *(const LAS u32x4*)(O2 + crow * 256 + cseg * 2 + 16);
            float hh[8], gg[8]; u32x4 o0, o1;
            unpack8(h0, hh); unpack8(g2[0], gg);
            o0.x = cvt_pk_bf16(hh[0] * gg[0], hh[1] * gg[1]); o0.y = cvt_pk_bf16(hh[2] * gg[2], hh[3] * gg[3]); o0.z = cvt_pk_bf16(hh[4] * gg[4], hh[5] * gg[5]); o0.w = cvt_pk_bf16(hh[6] * gg[6], hh[7] * gg[7]);
            unpack8(h1, hh); unpack8(g2[1], gg);
            o1.x = cvt_pk_bf16(hh[0] * gg[0], hh[1] * gg[1]); o1.y = cvt_pk_bf16(hh[2] * gg[2], hh[3] * gg[3]); o1.z = cvt_pk_bf16(hh[4] * gg[4], hh[5] * gg[5]); o1.w = cvt_pk_bf16(hh[6] * gg[6], hh[7] * gg[7]);
            if (!dry) { *(u32x4*)(p.G2 + (R0 + crow) * D + CB + cseg) = o0; *(u32x4*)(p.G2 + (R0 + crow) * D + CB + cseg + 8) = o1; }
            prefetch_g2(c + 1 < NCH ? c + 1 : 0);
        }
    }
    __syncthreads();
}
__device__ __forceinline__ void hgrn_chain(const Params& p, LAS unsigned char* lds, const int b, const int hd, const bool dry = false) {
    constexpr int QSTR = 272, TSTR = 144;
    LAS unsigned char* Qi = lds;
    LAS unsigned char* Ki = Qi + 64 * QSTR;
    LAS unsigned char* Kt = Ki + 64 * QSTR;
    LAS unsigned char* Vt = Kt + 128 * TSTR;
    LAS unsigned char* St = Vt + 128 * TSTR;
    LAS unsigned char* Pi = St + 128 * QSTR;
    LAS unsigned char* O1 = Pi + 64 * TSTR;
    LAS float* Df = (LAS float*)(O1 + 64 * 256);
    LAS float* ssL = Df + 128;
    const int tid = threadIdx.x, w = __builtin_amdgcn_readfirstlane(tid >> 6), lane = tid & 63, r = lane & 31, h = lane >> 5, tau = w & 1, q4 = w >> 1;
    const int CB = hd * 128;
    for (int i = tid; i < 128 * QSTR / 16; i += NTHR) *(LAS u32x4*)(St + i * 16) = (u32x4){0u, 0u, 0u, 0u};
    if (tid < 64) ssL[tid] = 0.f;
    f32x16 Sacc[2];
#pragma unroll
    for (int i2 = 0; i2 < 2; ++i2)
#pragma unroll
        for (int i = 0; i < 16; ++i) Sacc[i2][i] = 0.f;
    const float ngv = p.hg_ng[q4 * 32 + r];
    const int crow = tid >> 3, cseg = (tid & 7) * 16;
    const int trow = lane, tseg = w * 16;
    u32x4 pq[2], pk[2], pv[2], pg[2], pz[2]; float pd = 0.f;
    auto prefetch = [&](int c) {
        const size_t R0 = (size_t)b * LP + c * 64;
        pq[0] = *(const u32x4*)(p.Qh + (R0 + crow) * D + CB + cseg); pq[1] = *(const u32x4*)(p.Qh + (R0 + crow) * D + CB + cseg + 8);
        pk[0] = *(const u32x4*)(p.Kh + (R0 + trow) * D + CB + tseg); pk[1] = *(const u32x4*)(p.Kh + (R0 + trow) * D + CB + tseg + 8);
        pv[0] = *(const u32x4*)(p.Vv + (R0 + trow) * D + CB + tseg); pv[1] = *(const u32x4*)(p.Vv + (R0 + trow) * D + CB + tseg + 8);
        pd = p.Dk[((size_t)b * NCH + c) * D + CB + (tid & 127)];
    };
    auto prefetch_g = [&](int c) {
        const size_t R0 = (size_t)b * LP + c * 64;
        pg[0] = *(const u32x4*)(p.G1 + (R0 + crow) * D + CB + cseg); pg[1] = *(const u32x4*)(p.G1 + (R0 + crow) * D + CB + cseg + 8);
        pz[0] = *(const u32x4*)(p.G2 + (R0 + crow) * D + CB + cseg); pz[1] = *(const u32x4*)(p.G2 + (R0 + crow) * D + CB + cseg + 8);
    };
    prefetch(0); prefetch_g(0);
    __syncthreads();
    for (int c = 0; c < NCH; ++c) {
        const size_t R0 = (size_t)b * LP + c * 64;
        *(LAS u32x4*)(Qi + crow * QSTR + cseg * 2) = pq[0]; *(LAS u32x4*)(Qi + crow * QSTR + cseg * 2 + 16) = pq[1];
        *(LAS u32x4*)(Ki + trow * QSTR + tseg * 2) = pk[0]; *(LAS u32x4*)(Ki + trow * QSTR + tseg * 2 + 16) = pk[1];
        {
            const unsigned kw[8] = {pk[0].x, pk[0].y, pk[0].z, pk[0].w, pk[1].x, pk[1].y, pk[1].z, pk[1].w};
            const unsigned vw[8] = {pv[0].x, pv[0].y, pv[0].z, pv[0].w, pv[1].x, pv[1].y, pv[1].z, pv[1].w};
#pragma unroll
            for (int e = 0; e < 8; ++e) {
                *(LAS bf16_t*)(Kt + (tseg + 2 * e) * TSTR + trow * 2) = (bf16_t)(kw[e] & 0xffffu); *(LAS bf16_t*)(Kt + (tseg + 2 * e + 1) * TSTR + trow * 2) = (bf16_t)(kw[e] >> 16);
                *(LAS bf16_t*)(Vt + (tseg + 2 * e) * TSTR + trow * 2) = (bf16_t)(vw[e] & 0xffffu); *(LAS bf16_t*)(Vt + (tseg + 2 * e + 1) * TSTR + trow * 2) = (bf16_t)(vw[e] >> 16);
            }
        }
        if (tid < 128) Df[tid] = pd;
        __syncthreads();
        prefetch(c + 1 < NCH ? c + 1 : c);
        if (w < 3) {
            const int tx = w ? 1 : 0, sx = w == 2 ? 1 : 0;
            f32x16 X;
#pragma unroll
            for (int i = 0; i < 16; ++i) X[i] = 0.f;
#pragma unroll
            for (int ks = 0; ks < 8; ++ks) {
                const bf16x8 a = *(const LAS bf16x8*)(Qi + (32 * tx + r) * QSTR + (16 * ks + 8 * h) * 2);
                const bf16x8 bb = *(const LAS bf16x8*)(Ki + (32 * sx + r) * QSTR + (16 * ks + 8 * h) * 2);
                X = mfma32(a, bb, X);
            }
#pragma unroll
            for (int i = 0; i < 16; ++i) {
                const int tl = CROW(i, h);
                const float v = (tx == sx && r > tl) ? 0.f : X[i];
                *(LAS bf16_t*)(Pi + (32 * tx + tl) * TSTR + (32 * sx + r) * 2) = f2bf_fast(v);
            }
        }
        __syncthreads();
        f32x16 O;
#pragma unroll
        for (int i = 0; i < 16; ++i) O[i] = 0.f;
        for (int ks = 0; ks < 2 * (tau + 1); ++ks) {
            const bf16x8 a = *(const LAS bf16x8*)(Pi + (32 * tau + r) * TSTR + (16 * ks + 8 * h) * 2);
            const bf16x8 bb = *(const LAS bf16x8*)(Vt + (32 * q4 + r) * TSTR + (16 * ks + 8 * h) * 2);
            O = mfma32(a, bb, O);
        }
#pragma unroll
        for (int ks = 0; ks < 8; ++ks) {
            const bf16x8 a = *(const LAS bf16x8*)(Qi + (32 * tau + r) * QSTR + (16 * ks + 8 * h) * 2);
            const bf16x8 bb = *(const LAS bf16x8*)(St + (32 * q4 + r) * QSTR + (16 * ks + 8 * h) * 2);
            O = mfma32(a, bb, O);
        }
        {
            float x[16];
#pragma unroll
            for (int i = 0; i < 16; ++i) x[i] = O[i] * O[i];
#pragma unroll
            for (int i = 0; i < 8; ++i) { const float snd = (lane & 16) ? x[i] : x[i + 8]; const float rcv = __shfl_xor(snd, 16); x[i] = ((lane & 16) ? x[i + 8] : x[i]) + rcv; }
#pragma unroll
            for (int i = 0; i < 4; ++i) { const float snd = (lane & 8) ? x[i] : x[i + 4]; const float rcv = __shfl_xor(snd, 8); x[i] = ((lane & 8) ? x[i + 4] : x[i]) + rcv; }
#pragma unroll
            for (int i = 0; i < 2; ++i) { const float snd = (lane & 4) ? x[i] : x[i + 2]; const float rcv = __shfl_xor(snd, 4); x[i] = ((lane & 4) ? x[i + 2] : x[i]) + rcv; }
            { const float snd = (lane & 2) ? x[0] : x[1]; const float rcv = __shfl_xor(snd, 2); x[0] = ((lane & 2) ? x[1] : x[0]) + rcv; }
            x[0] += __shfl_xor(x[0], 1);
            const int idx = ((lane >> 4) & 1) * 8 + ((lane >> 3) & 1) * 4 + ((lane >> 2) & 1) * 2 + ((lane >> 1) & 1);
            if ((lane & 1) == 0) __hip_atomic_fetch_add(ssL + 32 * tau + CROW(idx, h), x[0], __ATOMIC_RELAXED, __HIP_MEMORY_SCOPE_WORKGROUP);
        }
        __syncthreads();
#pragma unroll
        for (int g = 0; g < 4; ++g) {
            const f32x4 s4 = *(const LAS f32x4*)(ssL + 32 * tau + 8 * g + 4 * h);
#pragma unroll
            for (int j = 0; j < 4; ++j) {
                const float rt = rsqrtf(s4[j] * (1.0f / 128.0f) + 1e-6f);
                *(LAS bf16_t*)(O1 + (32 * tau + 8 * g + 4 * h + j) * 256 + (32 * q4 + r) * 2) = f2bf_fast(O[4 * g + j] * rt * ngv);
            }
        }
#pragma unroll
        for (int i2 = 0; i2 < 2; ++i2) {
            const int kap = 2 * tau + i2;
#pragma unroll
            for (int ks = 0; ks < 4; ++ks) {
                const bf16x8 a = *(const LAS bf16x8*)(Kt + (32 * kap + r) * TSTR + (16 * ks + 8 * h) * 2);
                const bf16x8 bb = *(const LAS bf16x8*)(Vt + (32 * q4 + r) * TSTR + (16 * ks + 8 * h) * 2);
                Sacc[i2] = mfma32(a, bb, Sacc[i2]);
            }
#pragma unroll
            for (int g = 0; g < 4; ++g) {
                const f32x4 d4 = *(const LAS f32x4*)(Df + 32 * kap + 8 * g + 4 * h);
#pragma unroll
                for (int j = 0; j < 4; ++j) Sacc[i2][4 * g + j] *= d4[j];
                *(LAS u32x2*)(St + (32 * q4 + r) * QSTR + (32 * kap + 8 * g + 4 * h) * 2) =
                    (u32x2){cvt_pk_bf16(Sacc[i2][4 * g], Sacc[i2][4 * g + 1]), cvt_pk_bf16(Sacc[i2][4 * g + 2], Sacc[i2][4 * g + 3])};
            }
        }
        __syncthreads();
        {
            if (tid < 64) ssL[tid] = 0.f;
            const u32x4 z0 = *(const LAS u32x4*)(O1 + crow * 256 + cseg * 2), z1 = *(const LAS u32x4*)(O1 + crow * 256 + cseg * 2 + 16);
            float oo[8], gg[8], zz[8]; u32x4 o0, o1;
            unpack8(z0, oo); unpack8(pg[0], gg); unpack8(pz[0], zz);
            o0.x = cvt_pk_bf16(oo[0] * gg[0] + zz[0], oo[1] * gg[1] + zz[1]); o0.y = cvt_pk_bf16(oo[2] * gg[2] + zz[2], oo[3] * gg[3] + zz[3]);
            o0.z = cvt_pk_bf16(oo[4] * gg[4] + zz[4], oo[5] * gg[5] + zz[5]); o0.w = cvt_pk_bf16(oo[6] * gg[6] + zz[6], oo[7] * gg[7] + zz[7]);
            unpack8(z1, oo); unpack8(pg[1], gg); unpack8(pz[1], zz);
            o1.x = cvt_pk_bf16(oo[0] * gg[0] + zz[0], oo[1] * gg[1] + zz[1]); o1.y = cvt_pk_bf16(oo[2] * gg[2] + zz[2], oo[3] * gg[3] + zz[3]);
            o1.z = cvt_pk_bf16(oo[4] * gg[4] + zz[4], oo[5] * gg[5] + zz[5]); o1.w = cvt_pk_bf16(oo[6] * gg[6] + zz[6], oo[7] * gg[7] + zz[7]);
            if (!dry) { *(u32x4*)(p.G1 + (R0 + crow) * D + CB + cseg) = o0; *(u32x4*)(p.G1 + (R0 + crow) * D + CB + cseg + 8) = o1; }
            prefetch_g(c + 1 < NCH ? c + 1 : 0);
        }
    }
    __syncthreads();
}
__device__ __forceinline__ f32x4 mfma16(bf16x8 a, bf16x8 b, f32x4 c) { return __builtin_amdgcn_mfma_f32_16x16x32_bf16(a, b, c, 0, 0, 0); }
__device__ __forceinline__ void unpack4(const u32x2 v, float (&o)[4]) {
    o[0] = __uint_as_float(v.x << 16); o[1] = __uint_as_float(v.x & 0xffff0000u); o[2] = __uint_as_float(v.y << 16); o[3] = __uint_as_float(v.y & 0xffff0000u);
}
typedef short v4i16 __attribute__((ext_vector_type(4)));
struct XStrip { const float* src; unsigned char* dst; int sld, dld, k0, n0, mode; };
__device__ __forceinline__ XStrip xstrip_decode(const Params& p, int sid) {
    XStrip s; const int j = sid >> 10, t = sid & 1023, e = t >> 4;
    if (j < 2) { s.src = (j ? p.we_up : p.we_gate) + (size_t)e * D * DE; s.sld = DE; s.k0 = (t & 15) * 64; s.n0 = 0; s.dst = p.Bt_gu + (size_t)e * 512 * D; s.dld = D; s.mode = j; }
    else { const int r = t & 15; s.src = p.we_down + (size_t)e * DE * D; s.sld = D; s.k0 = (r >> 2) * 64; s.n0 = (r & 3) * 256; s.dst = p.Bt_d + (size_t)e * D * DE; s.dld = DE; s.mode = 2; }
    return s;
}
__device__ __forceinline__ int xstrip_drow(int mode, int n) { return mode == 2 ? n : (n >> 7) * 256 + mode * 128 + (n & 127); }
__device__ __forceinline__ void bcast_rows(float x, float (&v)[4]) {
    const auto r = __builtin_amdgcn_permlane32_swap(__float_as_uint(x), __float_as_uint(x), false, false);
    const auto a = __builtin_amdgcn_permlane16_swap(r[0], r[0], false, false);
    const auto b = __builtin_amdgcn_permlane16_swap(r[1], r[1], false, false);
    v[0] = __uint_as_float(a[0]); v[1] = __uint_as_float(a[1]); v[2] = __uint_as_float(b[0]); v[3] = __uint_as_float(b[1]);
}
__device__ __forceinline__ void lru_chain_q(const Params& p, LAS unsigned char* lds, const int b, const int n, const int q, const bool dry = false, const bool do_strips = false) {
    constexpr int XSTR = 272;
    LAS unsigned char* XC = lds;
    LAS unsigned char* O2 = XC + 64 * XSTR;
    LAS float* CW = (LAS float*)(O2 + 64 * 64);
    LAS float* LSA = CW + 640;
    LAS float* LSU = LSA + 256;
    LAS float* CAR = LSU + 256;
    const int tid = tid_opaque(), w = __builtin_amdgcn_readfirstlane(tid >> 6), lane = tid & 63, c16 = lane & 15, qd = lane >> 4, tt = w >> 1, dh = w & 1;
    const int CB = n * 128;
    const int dl = 16 * dh + c16;
    const int dcol = CB + 32 * q + dl;
    for (int i = tid; i < 640; i += NTHR) { const int j = i >> 7, c = i & 127; CW[i] = j < 4 ? p.conv_w[j * D + CB + c] : p.conv_b[CB + c]; }
    if (tid < 64) CAR[tid] = 0.f;
    bf16x8 waf[4], wxf[4];
#pragma unroll
    for (int ks = 0; ks < 4; ++ks) {
        waf[ks] = *(const bf16x8*)(p.Bt_wa + ((size_t)n * 128 + 32 * q + dl) * 128 + 32 * ks + 8 * qd);
        wxf[ks] = *(const bf16x8*)(p.Bt_wx + ((size_t)n * 128 + 32 * q + dl) * 128 + 32 * ks + 8 * qd);
    }
    const float bav = p.lru_ba[dcol], bxv = p.lru_bx[dcol];
    const float c2 = -8.0f * log1pf(expf(-p.lru_lam[dcol])) * 1.4426950408889634f;
    const int cg = tid & 15, tg = tid >> 4, crow = tid >> 3, c4 = (tid & 7) * 4;
    u32x4 lx[5]; u32x2 g2;
    LAS float* TR = (LAS float*)(lds + 32768);
    f32x4 xa[4], xb[4];
#pragma unroll
    for (int t = 0; t < 4; ++t) { xa[t] = (f32x4){0.f, 0.f, 0.f, 0.f}; xb[t] = xa[t]; }
    auto prefetch_lx = [&](int c) {
#pragma unroll
        for (int j = 0; j < 5; ++j) { int pos = c * 64 + 2 * tg - 3 + j; pos = pos < 0 ? 0 : pos; lx[j] = *(const u32x4*)(p.LX + ((size_t)b * LP + pos) * D + CB + cg * 8); }
    };
    auto prefetch_g2 = [&](int c) { g2 = *(const u32x2*)(p.G2 + ((size_t)b * LP + c * 64 + crow) * D + CB + 32 * q + c4); };
    prefetch_lx(0); prefetch_g2(0);
    __syncthreads();
    float cw[5][8];
#pragma unroll
    for (int j = 0; j < 5; ++j) { const f32x4 a = *(const LAS f32x4*)(CW + j * 128 + cg * 8), bq = *(const LAS f32x4*)(CW + j * 128 + cg * 8 + 4);
        cw[j][0] = a[0]; cw[j][1] = a[1]; cw[j][2] = a[2]; cw[j][3] = a[3]; cw[j][4] = bq[0]; cw[j][5] = bq[1]; cw[j][6] = bq[2]; cw[j][7] = bq[3]; }
    for (int c = 0; c < NCH; ++c) {
        const size_t R0 = (size_t)b * LP + c * 64; const int par = c & 1;
        {
            float x[5][8];
#pragma unroll
            for (int j = 0; j < 5; ++j) { unpack8(lx[j], x[j]);
                if (c == 0 && 2 * tg - 3 + j < PADR) {
#pragma unroll
                    for (int e = 0; e < 8; ++e) x[j][e] = 0.f; } }
#pragma unroll
            for (int rr = 0; rr < 2; ++rr) {
                float y[8];
#pragma unroll
                for (int e = 0; e < 8; ++e) y[e] = __builtin_fmaf(cw[3][e], x[rr + 3][e], __builtin_fmaf(cw[2][e], x[rr + 2][e], __builtin_fmaf(cw[1][e], x[rr + 1][e], __builtin_fmaf(cw[0][e], x[rr][e], cw[4][e]))));
                u32x4 o; o.x = cvt_pk_bf16(y[0], y[1]); o.y = cvt_pk_bf16(y[2], y[3]); o.z = cvt_pk_bf16(y[4], y[5]); o.w = cvt_pk_bf16(y[6], y[7]);
                *(LAS u32x4*)(XC + (2 * tg + rr) * XSTR + cg * 16) = o;
            }
        }
        __syncthreads();
        prefetch_lx(c + 1 < NCH ? c + 1 : c);
        if (do_strips && c < 60) {
            const int ph = c % 5; const int sid = (int)blockIdx.x + 256 * (c / 5);
            if (ph == 0) {
                const XStrip s = xstrip_decode(p, sid); const int kr = tid >> 3, c8 = (tid & 7) * 8;
#pragma unroll
                for (int t = 0; t < 4; ++t) { const float* sp = s.src + (size_t)(s.k0 + kr) * s.sld + s.n0 + t * 64 + c8; xa[t] = *(const f32x4*)sp; xb[t] = *(const f32x4*)(sp + 4); }
            } else if (ph == 1) {
                const int kr = tid >> 3, c8 = (tid & 7) * 8;
#pragma unroll
                for (int t = 0; t < 4; ++t) { LAS float* wp = TR + t * (64 * 65) + kr * 65 + c8;
                    wp[0] = xa[t][0]; wp[1] = xa[t][1]; wp[2] = xa[t][2]; wp[3] = xa[t][3]; wp[4] = xb[t][0]; wp[5] = xb[t][1]; wp[6] = xb[t][2]; wp[7] = xb[t][3]; }
            } else if (ph == 2) {
                const XStrip s = xstrip_decode(p, sid); const int nr = tid >> 3, k8 = (tid & 7) * 8;
#pragma unroll
                for (int t = 0; t < 4; ++t) {
                    float v[8];
#pragma unroll
                    for (int i = 0; i < 8; ++i) v[i] = TR[t * (64 * 65) + (k8 + i) * 65 + nr];
                    *(u32x2*)(s.dst + (size_t)xstrip_drow(s.mode, s.n0 + t * 64 + nr) * s.dld + s.k0 + k8) =
                        (u32x2){pk_fp8x4(v[0] * WSCALE8, v[1] * WSCALE8, v[2] * WSCALE8, v[3] * WSCALE8), pk_fp8x4(v[4] * WSCALE8, v[5] * WSCALE8, v[6] * WSCALE8, v[7] * WSCALE8)};
                }
            }
        }
        f32x4 Rg = (f32x4){0.f, 0.f, 0.f, 0.f}, Ig = Rg;
#pragma unroll
        for (int ks = 0; ks < 4; ++ks) {
            const bf16x8 a = *(const LAS bf16x8*)(XC + (16 * tt + c16) * XSTR + (32 * ks + 8 * qd) * 2);
            Rg = mfma16(a, waf[ks], Rg); Ig = mfma16(a, wxf[ks], Ig);
        }
        float av[4], uv[4];
        float gA = 1.0f, gU = 0.f;
        const v4i16 xc4 = __builtin_amdgcn_ds_read_tr16_b64_v4i16((LAS v4i16*)(XC + (16 * tt + 4 * qd + (c16 >> 2)) * XSTR + (32 * q + 16 * dh + 4 * (c16 & 3)) * 2));
#pragma unroll
        for (int i = 0; i < 4; ++i) {
            const int tl = 16 * tt + 4 * qd + i;
            const float xcv = bf2f((bf16_t)xc4[i]);
            const float rr = fast_sigmoid(Rg[i] + bav), ii = fast_sigmoid(Ig[i] + bxv);
            float a = __builtin_amdgcn_exp2f(rr * c2);
            float u = __builtin_amdgcn_sqrtf(fmaxf(1.0f - a * a, 0.f)) * ii * xcv;
            if (c == 0 && tl < PADR) { a = 1.0f; u = 0.f; }
            gU = a * gU + u; gA *= a; av[i] = gA; uv[i] = gU;
        }
        float rA = 1.0f, rU = 0.f, stA = 1.0f, stU = 0.f;
        float Aq[4], Uq[4]; bcast_rows(gA, Aq); bcast_rows(gU, Uq);
#pragma unroll
        for (int j = 0; j < 4; ++j) {
            if (j == qd) { stA = rA; stU = rU; }
            rU = Aq[j] * rU + Uq[j]; rA = Aq[j] * rA;
        }
#pragma unroll
        for (int i = 0; i < 4; ++i) { const float ca = av[i]; uv[i] = ca * stU + uv[i]; av[i] = ca * stA; }
        if (qd == 0) { LSA[(par * 4 + tt) * 32 + dl] = rA; LSU[(par * 4 + tt) * 32 + dl] = rU; }
        __syncthreads();
        {
            float hin = CAR[par * 32 + dl];
#pragma unroll
            for (int t2 = 0; t2 < 3; ++t2) if (t2 < tt) hin = LSA[(par * 4 + t2) * 32 + dl] * hin + LSU[(par * 4 + t2) * 32 + dl];
            if (tt == 3 && qd == 0) CAR[(par ^ 1) * 32 + dl] = rA * hin + rU;
#pragma unroll
            for (int i = 0; i < 4; ++i) *(LAS bf16_t*)(O2 + (16 * tt + 4 * qd + i) * 64 + dl * 2) = f2bf_fast(av[i] * hin + uv[i]);
        }
        __syncthreads();
        {
            const u32x2 hh2 = *(const LAS u32x2*)(O2 + crow * 64 + c4 * 2);
            float hh[4], gg[4]; unpack4(hh2, hh); unpack4(g2, gg);
            if (!dry) *(u32x2*)(p.G2 + (R0 + crow) * D + CB + 32 * q + c4) = (u32x2){cvt_pk_bf16(hh[0] * gg[0], hh[1] * gg[1]), cvt_pk_bf16(hh[2] * gg[2], hh[3] * gg[3])};
            prefetch_g2(c + 1 < NCH ? c + 1 : 0);
        }
    }
    __syncthreads();
}
__device__ __forceinline__ bf16x8 tr_frag(const LAS unsigned char* img, const int stride, const int s0, const int col0, const int c16) {
    const LAS unsigned char* p0 = img + (s0 + (c16 >> 2)) * stride + (col0 + 4 * (c16 & 3)) * 2;
    const v4i16 lo = __builtin_amdgcn_ds_read_tr16_b64_v4i16((LAS v4i16*)p0);
    const v4i16 hi = __builtin_amdgcn_ds_read_tr16_b64_v4i16((LAS v4i16*)(p0 + 4 * stride));
    return __builtin_shufflevector(lo, hi, 0, 1, 2, 3, 4, 5, 6, 7);
}
__device__ __forceinline__ void hgrn_chain_q(const Params& p, LAS unsigned char* lds, const int b, const int hd, const int q, const bool dry = false, const unsigned tagbase = 0u, const int xflags = 0) {
    constexpr int QSTR = 272, TSTR = 144;
    LAS unsigned char* Qi = lds;
    LAS unsigned char* Ki = Qi + 64 * QSTR;
    constexpr int VSTR = 80;
    LAS unsigned char* Vi = Ki + 64 * QSTR;
    LAS unsigned char* St = Vi + 64 * VSTR;
    LAS unsigned char* Pi = St + 32 * QSTR;
    LAS unsigned char* O1 = Pi + 64 * TSTR;
    LAS float* Df = (LAS float*)(O1 + 2 * 64 * 64);
    LAS float* ssL = Df + 128;
    LAS float* ssO = ssL + 64;
    LAS float* rT = ssO + 128;
    const int tid = tid_opaque(), w = __builtin_amdgcn_readfirstlane(tid >> 6), lane = tid & 63, c16 = lane & 15, qd = lane >> 4, tt = w >> 1, vh = w & 1;
    const int CB = hd * 128, VB = CB + 32 * q;
    unsigned long long* xg = (unsigned long long*)p.xg + (size_t)(b * 8 + hd) * (4 * 4 * 64);
    for (int i = tid; i < 32 * QSTR / 16; i += NTHR) *(LAS u32x4*)(St + i * 16) = (u32x4){0u, 0u, 0u, 0u};
    for (int i = tid; i < 64 * TSTR / 16; i += NTHR) *(LAS u32x4*)(Pi + i * 16) = (u32x4){0u, 0u, 0u, 0u};
    if (tid < 64) ssL[tid] = 0.f;
    f32x4 Sacc[2];
    Sacc[0] = (f32x4){0.f, 0.f, 0.f, 0.f}; Sacc[1] = Sacc[0];
    const float ngv = p.hg_ng[32 * q + 16 * vh + c16];
    const int crow = tid >> 3, cseg = (tid & 7) * 16, c4 = (tid & 7) * 4;
    u32x4 pq[2], pk[2]; u32x2 pv, pg, pz; float pd = 0.f;
    auto prefetch = [&](int c) {
        const size_t R0 = (size_t)b * LP + c * 64;
        pq[0] = *(const u32x4*)(p.Qh + (R0 + crow) * D + CB + cseg); pq[1] = *(const u32x4*)(p.Qh + (R0 + crow) * D + CB + cseg + 8);
        pk[0] = *(const u32x4*)(p.Kh + (R0 + crow) * D + CB + cseg); pk[1] = *(const u32x4*)(p.Kh + (R0 + crow) * D + CB + cseg + 8);
        pv = *(const u32x2*)(p.Vv + (R0 + crow) * D + VB + c4);
        pd = p.Dk[((size_t)b * NCH + c) * D + CB + (tid & 127)];
    };
    auto fin_store = [&](int cf) {
        const size_t R = (size_t)b * LP + cf * 64 + crow;
        const u32x2 o2 = *(const LAS u32x2*)(O1 + ((cf & 1) * 64 + crow) * 64 + c4 * 2);
        float oo[4], gg[4], zz[4]; unpack4(o2, oo); unpack4(pg, gg); unpack4(pz, zz);
        const float rt = rT[crow];
        if (!dry) *(u32x2*)(p.G1 + R * D + VB + c4) = (u32x2){cvt_pk_bf16(oo[0] * rt * gg[0] + zz[0], oo[1] * rt * gg[1] + zz[1]), cvt_pk_bf16(oo[2] * rt * gg[2] + zz[2], oo[3] * rt * gg[3] + zz[3])};
    };
    auto fin_factors = [&](int cf, unsigned long long g0, unsigned long long g1, unsigned long long g2) {
        const unsigned tag = (unsigned)(cf + 1) + tagbase;
        unsigned spins = 0;
        while (!__all((unsigned)(g0 >> 32) == tag && (unsigned)(g1 >> 32) == tag && (unsigned)(g2 >> 32) == tag)) {
            if (++spins > (1u << 20)) break;
            __builtin_amdgcn_s_sleep(2);
            g0 = __hip_atomic_load(xg + (((q + 1) & 3) * 4 + (cf & 3)) * 64 + lane, __ATOMIC_RELAXED, __HIP_MEMORY_SCOPE_AGENT);
            g1 = __hip_atomic_load(xg + (((q + 2) & 3) * 4 + (cf & 3)) * 64 + lane, __ATOMIC_RELAXED, __HIP_MEMORY_SCOPE_AGENT);
            g2 = __hip_atomic_load(xg + (((q + 3) & 3) * 4 + (cf & 3)) * 64 + lane, __ATOMIC_RELAXED, __HIP_MEMORY_SCOPE_AGENT);
        }
        const float tot = ssO[(cf & 1) * 64 + lane] + __uint_as_float((unsigned)g0) + __uint_as_float((unsigned)g1) + __uint_as_float((unsigned)g2);
        rT[lane] = rsqrtf(tot * (1.0f / 128.0f) + 1e-6f);
    };
    prefetch(0);
    __syncthreads();
    for (int c = 0; c < NCH; ++c) {
        *(LAS u32x4*)(Qi + crow * QSTR + cseg * 2) = pq[0]; *(LAS u32x4*)(Qi + crow * QSTR + cseg * 2 + 16) = pq[1];
        *(LAS u32x4*)(Ki + crow * QSTR + cseg * 2) = pk[0]; *(LAS u32x4*)(Ki + crow * QSTR + cseg * 2 + 16) = pk[1];
        *(LAS u32x2*)(Vi + crow * VSTR + c4 * 2) = pv;
        if (tid < 128) Df[tid] = pd;
        __syncthreads();
        prefetch(c + 1 < NCH ? c + 1 : c);
        const int cf = c > 0 ? c - 1 : 0;
        {
            const size_t R = (size_t)b * LP + cf * 64 + crow;
            pg = *(const u32x2*)(p.G1 + R * D + VB + c4); pz = *(const u32x2*)(p.G2 + R * D + VB + c4);
        }
        unsigned long long g0 = 0ull, g1 = 0ull, g2 = 0ull;
        if (w == 7) {
            g0 = __hip_atomic_load(xg + (((q + 1) & 3) * 4 + (cf & 3)) * 64 + lane, __ATOMIC_RELAXED, __HIP_MEMORY_SCOPE_AGENT);
            g1 = __hip_atomic_load(xg + (((q + 2) & 3) * 4 + (cf & 3)) * 64 + lane, __ATOMIC_RELAXED, __HIP_MEMORY_SCOPE_AGENT);
            g2 = __hip_atomic_load(xg + (((q + 3) & 3) * 4 + (cf & 3)) * 64 + lane, __ATOMIC_RELAXED, __HIP_MEMORY_SCOPE_AGENT);
        }
        for (int ti = w; ti < 10; ti += 8) {
            const int pt = ti < 1 ? 0 : ti < 3 ? 1 : ti < 6 ? 2 : 3, ps = ti - (pt * (pt + 1)) / 2;
            f32x4 X = (f32x4){0.f, 0.f, 0.f, 0.f};
#pragma unroll
            for (int ks = 0; ks < 4; ++ks) {
                const bf16x8 a = *(const LAS bf16x8*)(Qi + (16 * pt + c16) * QSTR + (32 * ks + 8 * qd) * 2);
                const bf16x8 bb = *(const LAS bf16x8*)(Ki + (16 * ps + c16) * QSTR + (32 * ks + 8 * qd) * 2);
                X = mfma16(a, bb, X);
            }
            float xv[4];
#pragma unroll
            for (int i = 0; i < 4; ++i) xv[i] = (pt == ps && c16 > 4 * qd + i) ? 0.f : X[i];
            *(LAS u32x2*)(Pi + (16 * ps + c16) * TSTR + (16 * pt + 4 * qd) * 2) = (u32x2){cvt_pk_bf16(xv[0], xv[1]), cvt_pk_bf16(xv[2], xv[3])};
        }
        __syncthreads();
        {
            f32x4 O = (f32x4){0.f, 0.f, 0.f, 0.f};
            for (int ks = 0; ks < (tt + 2) / 2; ++ks) {
                const bf16x8 a = tr_frag(Pi, TSTR, 32 * ks + 8 * qd, 16 * tt, c16);
                const bf16x8 bb = tr_frag(Vi, VSTR, 32 * ks + 8 * qd, 16 * vh, c16);
                O = mfma16(a, bb, O);
            }
#pragma unroll
            for (int ks = 0; ks < 4; ++ks) {
                const bf16x8 a = *(const LAS bf16x8*)(Qi + (16 * tt + c16) * QSTR + (32 * ks + 8 * qd) * 2);
                const bf16x8 bb = *(const LAS bf16x8*)(St + (16 * vh + c16) * QSTR + (32 * ks + 8 * qd) * 2);
                O = mfma16(a, bb, O);
            }
#pragma unroll
            for (int i = 0; i < 4; ++i) {
                const float s = row16_incl_scan(O[i] * O[i]);
                if (c16 == 15) __hip_atomic_fetch_add(ssL + 16 * tt + 4 * qd + i, s, __ATOMIC_RELAXED, __HIP_MEMORY_SCOPE_WORKGROUP);
                *(LAS bf16_t*)(O1 + ((c & 1) * 64 + 16 * tt + 4 * qd + i) * 64 + (16 * vh + c16) * 2) = f2bf_fast(O[i] * ngv);
            }
            if (w == 7 && c > 0) fin_factors(cf, g0, g1, g2);
        }
        __syncthreads();
        if (w == 0) {
            const float s = ssL[lane];
            ssO[(c & 1) * 64 + lane] = s;
            __hip_atomic_store(xg + ((q * 4) + (c & 3)) * 64 + lane, ((unsigned long long)((unsigned)(c + 1) + tagbase) << 32) | (unsigned long long)__float_as_uint(s), __ATOMIC_RELAXED, __HIP_MEMORY_SCOPE_AGENT);
        }
#pragma unroll
        for (int i2 = 0; i2 < 2; ++i2) {
            const int kk = 2 * tt + i2;
#pragma unroll
            for (int ks = 0; ks < 2; ++ks) {
                const bf16x8 a = tr_frag(Ki, QSTR, 32 * ks + 8 * qd, 16 * kk, c16);
                const bf16x8 bb = tr_frag(Vi, VSTR, 32 * ks + 8 * qd, 16 * vh, c16);
                Sacc[i2] = mfma16(a, bb, Sacc[i2]);
            }
            const f32x4 d4 = *(const LAS f32x4*)(Df + 16 * kk + 4 * qd);
            Sacc[i2] = Sacc[i2] * d4;
            *(LAS u32x2*)(St + (16 * vh + c16) * QSTR + (16 * kk + 4 * qd) * 2) = (u32x2){cvt_pk_bf16(Sacc[i2][0], Sacc[i2][1]), cvt_pk_bf16(Sacc[i2][2], Sacc[i2][3])};
        }
        __syncthreads();
        if (tid < 64) ssL[tid] = 0.f;
        if (c > 0) fin_store(cf);
    }
    {
        const int cf = NCH - 1;
        const size_t R = (size_t)b * LP + cf * 64 + crow;
        pg = *(const u32x2*)(p.G1 + R * D + VB + c4); pz = *(const u32x2*)(p.G2 + R * D + VB + c4);
        __syncthreads();
        if (w == 7) {
            const unsigned long long g0 = __hip_atomic_load(xg + (((q + 1) & 3) * 4 + (cf & 3)) * 64 + lane, __ATOMIC_RELAXED, __HIP_MEMORY_SCOPE_AGENT);
            const unsigned long long g1 = __hip_atomic_load(xg + (((q + 2) & 3) * 4 + (cf & 3)) * 64 + lane, __ATOMIC_RELAXED, __HIP_MEMORY_SCOPE_AGENT);
            const unsigned long long g2 = __hip_atomic_load(xg + (((q + 3) & 3) * 4 + (cf & 3)) * 64 + lane, __ATOMIC_RELAXED, __HIP_MEMORY_SCOPE_AGENT);
            fin_factors(cf, g0, g1, g2);
        }
        __syncthreads();
        fin_store(cf);
    }
    __syncthreads();
}
__device__ __forceinline__ void phase2q(const Params& p, LAS unsigned char* lds) {
    const int bh = blockIdx.x & 63, q = blockIdx.x >> 6, b = bh >> 3, hd = bh & 7;
    const int nl = 1 + (p.flags & 15), nh = 1 + ((p.flags >> 4) & 15);
    for (int rep = 0; rep < nl; ++rep) lru_chain_q(p, lds, b, hd, q, rep > 0, rep == 0);
    asm volatile("s_waitcnt vmcnt(0)" ::: "memory");
    __syncthreads();
    if (threadIdx.x == 0) { __builtin_amdgcn_fence(__ATOMIC_ACQUIRE, "agent"); asm volatile("s_waitcnt vmcnt(0)" ::: "memory"); }
    __syncthreads();
    for (int rep = 0; rep < nh; ++rep) hgrn_chain_q(p, lds, b, hd, q, rep > 0, 1000u * rep, rep > 0 ? (p.flags >> 8) : 0);
}

__device__ __forceinline__ void phase2(const Params& p, LAS unsigned char* lds, const bool dry = false) {
    if (blockIdx.x >= NB * 8) return;
    const int b = blockIdx.x >> 3, hd = blockIdx.x & 7;
    lru_chain(p, lds, b, hd, dry);
    asm volatile("s_waitcnt vmcnt(0)" ::: "memory");
    __syncthreads();
    if (threadIdx.x == 0) { __builtin_amdgcn_fence(__ATOMIC_ACQUIRE, "agent"); asm volatile("s_waitcnt vmcnt(0)" ::: "memory"); }
    __syncthreads();
    hgrn_chain(p, lds, b, hd, dry);
}

__global__ __launch_bounds__(NTHR, 2) void k_mega(Params p) {
    extern __shared__ __attribute__((aligned(16))) unsigned char shm[];
    LAS unsigned char* lds = (LAS unsigned char*)shm;
    volatile LAS unsigned* xst = (volatile LAS unsigned*)(lds + LDS_BYTES - 16);
    if (threadIdx.x == 0) { xst[0] = 0u; xst[1] = 0u; }
    __syncthreads();
    (void)xcd_barrier_post(p.bar, xst);
#define XB_NOW() do { XcdBarrier xb_; xb_.bar = p.bar; xb_.x = xb_xcc_id(); xb_.st = (volatile LAS unsigned*)(lds + LDS_BYTES - 16); xcd_barrier(xb_); } while (0)
    phase_prep(p, lds);
    XB_NOW();
#if REPEAT_PHASE == 0
    phase_prep(p, lds); XB_NOW();
#endif
#if REPEAT_PHASE == 99
    XB_NOW(); XB_NOW(); XB_NOW(); XB_NOW();
#endif
    phase1(p, lds);
    XB_NOW();
#if REPEAT_PHASE == 1
    phase1(p, lds); XB_NOW();
#endif
    if (gridDim.x == 256) phase2q(p, lds); else phase2(p, lds);
    XB_NOW();
#if REPEAT_PHASE == 2
    phase2(p, lds, true); XB_NOW();
#endif
    phase3(p, lds);
    XB_NOW();
#if REPEAT_PHASE == 3
    phase3(p, lds); XB_NOW();
#endif
    phase4(p, lds);
    XB_NOW();
#if REPEAT_PHASE == 4
    if (blockIdx.x == 0 && threadIdx.x < 64) p.cnt[threadIdx.x * 64] = 0;
    XB_NOW(); phase4(p, lds); XB_NOW();
#endif
    phase5(p, lds);
    XB_NOW();
#if REPEAT_PHASE == 5
    phase5(p, lds); XB_NOW();
#endif
    phase6(p, lds);
    XB_NOW();
#if REPEAT_PHASE == 6
    phase6(p, lds); XB_NOW();
#endif
    phase7(p);
#if REPEAT_PHASE == 7
    XB_NOW(); phase7(p);
#endif
}

template <int PH> __global__ __launch_bounds__(NTHR, 2) void k_phase(Params p) {
    extern __shared__ __attribute__((aligned(16))) unsigned char shm[];
    LAS unsigned char* lds = (LAS unsigned char*)shm;
    if (PH == 0) phase_prep(p, lds);
    if (PH == 1) phase1(p, lds);
    if (PH == 3) phase3(p, lds);
    if (PH == 4) phase4(p, lds);
    if (PH == 5) phase5(p, lds);
    if (PH == 6) phase6(p, lds);
    if (PH == 7) phase7(p);
}

extern "C" void kernel_launch(void* const* d_in, const int* in_sizes, int n_in, void* d_out, int out_size, void* d_ws, size_t ws_size, hipStream_t stream) {
    Params p{};
#ifdef EXP_FLAGS
    p.flags = EXP_FLAGS;
#endif
    p.x = (const float*)d_in[0]; p.meta = (const float*)d_in[1]; p.ln_in_g = (const float*)d_in[2]; p.ln_in_b = (const float*)d_in[3];
    p.w_in = (const float*)d_in[4]; p.b_in = (const float*)d_in[5]; p.lbl = (const float*)d_in[6]; p.hg_ng = (const float*)d_in[7];
    p.conv_w = (const float*)d_in[8]; p.conv_b = (const float*)d_in[9]; p.lru_wa = (const float*)d_in[10]; p.lru_ba = (const float*)d_in[11];
    p.lru_wx = (const float*)d_in[12]; p.lru_bx = (const float*)d_in[13]; p.lru_lam = (const float*)d_in[14]; p.w_out = (const float*)d_in[15];
    p.ln1_g = (const float*)d_in[16]; p.ln1_b = (const float*)d_in[17]; p.router_w = (const float*)d_in[18]; p.router_b = (const float*)d_in[19];
    p.we_gate = (const float*)d_in[20]; p.we_up = (const float*)d_in[21]; p.we_down = (const float*)d_in[22];
    p.ws_gate = (const float*)d_in[23]; p.ws_up = (const float*)d_in[24]; p.ws_down = (const float*)d_in[25];
    p.ln2_g = (const float*)d_in[26]; p.ln2_b = (const float*)d_in[27];
    p.out = (float*)d_out;
    char* ws = (char*)d_ws;
    p.h0 = (bf16_t*)(ws + 0 * U); p.Qh = (bf16_t*)(ws + 1 * U); p.Kh = (bf16_t*)(ws + 2 * U); p.Vv = (bf16_t*)(ws + 3 * U);
    p.G1 = (bf16_t*)(ws + 4 * U); p.LX = (bf16_t*)(ws + 5 * U); p.G2 = (bf16_t*)(ws + 6 * U);
    char* misc = ws + 7 * U;
    const size_t MB = 1024 * 1024;
    p.Dk = (float*)misc;
    p.ridx = (int*)(misc + 9 * MB / 4);
    p.rwts = (float*)(misc + 13 * MB / 4);
    p.Bt_in = (bf16_t*)(misc + 17 * MB / 4);
    p.Bt_out = (bf16_t*)(misc + 81 * MB / 4);
    p.Bt_sgu = (unsigned char*)(misc + 89 * MB / 4);
    p.Bt_sd = (unsigned char*)(misc + 93 * MB / 4);
    p.Bt_wa = (bf16_t*)(misc + 95 * MB / 4);
    p.Bt_wx = (bf16_t*)(misc + 96 * MB / 4);
    p.Bt_r = (bf16_t*)(misc + 97 * MB / 4);
    p.bperm = (float*)(misc + 97 * MB / 4 + MB / 8);
    p.lb = (float*)(misc + 97 * MB / 4 + MB / 8 + 32768);
    p.act = (unsigned char*)ws; p.base = (bf16_t*)(ws + 2 * U); p.yrows = (unsigned char*)(ws + 4 * U);
    p.bar = (unsigned*)(misc + 43 * MB); p.xg = (unsigned long long*)(misc + 44 * MB);
    p.cnt = (int*)(misc + 25 * MB); p.list_tok = (int*)(misc + 26 * MB); p.list_w = (float*)(misc + 34 * MB);
    p.pre1 = (bf16_t*)(ws + 1 * U);
    p.h1 = (bf16_t*)(ws + 3 * U);
    p.Bt_gu = (unsigned char*)d_out;
    p.Bt_d = (unsigned char*)d_out + (size_t)NE * 512 * D;
    p.h1q = (unsigned char*)d_out + (size_t)NE * 512 * D + (size_t)NE * D * DE;

    static int grid_blocks = 0;
    if (!grid_blocks) {
        (void)hipFuncSetAttribute((const void*)k_mega, hipFuncAttributeMaxDynamicSharedMemorySize, LDS_BYTES);
        int dev = 0, cus = 0, per_cu = 0;
        (void)hipGetDevice(&dev);
        (void)hipDeviceGetAttribute(&cus, hipDeviceAttributeMultiprocessorCount, dev);
        (void)hipOccupancyMaxActiveBlocksPerMultiprocessor(&per_cu, (const void*)k_mega, NTHR, LDS_BYTES);
        if (per_cu > 1) per_cu = 1;
        grid_blocks = cus * per_cu;
    }
    (void)hipMemsetAsync(p.bar, 0, XCD_BAR_WORDS * 4, stream);
    void* args[] = {&p};
    hipError_t e = hipLaunchCooperativeKernel((const void*)k_mega, dim3(grid_blocks), dim3(NTHR), args, LDS_BYTES, stream);
    if (e != hipSuccess) fprintf(stderr, "cooperative launch failed: %s (grid %d)\n", hipGetErrorString(e), grid_blocks);
}
```

```cpp
#include <hip/hip_runtime.h>
#include <hip/hip_cooperative_groups.h>
#include <stdint.h>
#include <cstdio>
namespace cg = cooperative_groups;

typedef unsigned short bf16_t;
#ifndef REPEAT_PHASE
#define REPEAT_PHASE -1
#endif

constexpr int D = 1024;
constexpr int NB = 8;
constexpr int SEQ = 4096;
constexpr int LP = 4160;
constexpr int PADR = 48;
constexpr int TP = NB * LP;
constexpr int T = NB * SEQ;
constexpr int NCH = LP / 64;
constexpr int NE = 64, TOPK = 6, DE = 256;
constexpr float ALPHA = 1.189207115002721f;
constexpr size_t U = (size_t)TP * D * 2;

__device__ __forceinline__ float bf2f(bf16_t b) { return __uint_as_float(((unsigned)b) << 16); }
__device__ __forceinline__ bf16_t f2bf(float f) { unsigned u = __float_as_uint(f); u += 0x7FFFu + ((u >> 16) & 1u); return (bf16_t)(u >> 16); }
__device__ __forceinline__ float sigmoidf_(float x) { return 1.0f / (1.0f + __expf(-x)); }
__device__ __forceinline__ float siluf_(float x) { return x * sigmoidf_(x); }
__device__ __forceinline__ float gelu_tanh_(float x) { const float c = 0.7978845608028654f; float t = tanhf(c * (x + 0.044715f * x * x * x)); return 0.5f * x * (1.0f + t); }
__device__ __forceinline__ float wave_sum(float v) {
    v += __int_as_float(__builtin_amdgcn_update_dpp(0, __float_as_int(v), 0x111, 0xF, 0xF, false));
    v += __int_as_float(__builtin_amdgcn_update_dpp(0, __float_as_int(v), 0x112, 0xF, 0xF, false));
    v += __int_as_float(__builtin_amdgcn_update_dpp(0, __float_as_int(v), 0x114, 0xF, 0xF, false));
    v += __int_as_float(__builtin_amdgcn_update_dpp(0, __float_as_int(v), 0x118, 0xF, 0xF, false));
    v += __int_as_float(__builtin_amdgcn_update_dpp(0, __float_as_int(v), 0x142, 0xA, 0xF, false));
    v += __int_as_float(__builtin_amdgcn_update_dpp(0, __float_as_int(v), 0x143, 0xC, 0xF, false));
    return __int_as_float(__builtin_amdgcn_readlane(__float_as_int(v), 63));
}

#define LAS __attribute__((address_space(3)))
typedef short bf16x8 __attribute__((ext_vector_type(8)));
typedef float f32x4 __attribute__((ext_vector_type(4)));
typedef unsigned u32x4 __attribute__((ext_vector_type(4)));
typedef unsigned u32x2 __attribute__((ext_vector_type(2)));
typedef int v4i __attribute__((ext_vector_type(4)));
typedef int v8i __attribute__((ext_vector_type(8)));
typedef float f32x32 __attribute__((ext_vector_type(32)));
constexpr float WSCALE8 = 32.0f, ASCALE8 = 8.0f;
__device__ __forceinline__ v8i cat8(const short __attribute__((ext_vector_type(8))) lo, const short __attribute__((ext_vector_type(8))) hi) {
    const v4i a = __builtin_bit_cast(v4i, lo), b = __builtin_bit_cast(v4i, hi); return __builtin_shufflevector(a, b, 0, 1, 2, 3, 4, 5, 6, 7);
}
__device__ __forceinline__ unsigned pk_fp8x4(float a, float b, float c, float d) { int w = 0; w = __builtin_amdgcn_cvt_pk_fp8_f32(a, b, w, false); w = __builtin_amdgcn_cvt_pk_fp8_f32(c, d, w, true); return (unsigned)w; }
constexpr int BM = 256, BK = 64, HALF = 128, HTB = HALF * BK * 2, STAGE_BYTES = 8 * HTB, NXCD = 8, WGM = 16;
constexpr int NTHR = 512;
constexpr int LDS_BYTES = 160 * 1024;

struct Params {
    const float *x, *meta, *ln_in_g, *ln_in_b, *w_in, *b_in, *lbl, *hg_ng, *conv_w, *conv_b, *lru_wa, *lru_ba, *lru_wx, *lru_bx, *lru_lam, *w_out, *ln1_g, *ln1_b, *router_w, *router_b,
        *we_gate, *we_up, *we_down, *ws_gate, *ws_up, *ws_down, *ln2_g, *ln2_b;
    float* out;
    bf16_t *h0, *Qh, *Kh, *Vv, *G1, *LX, *G2;
    float* Dk; int* ridx; float* rwts;
    bf16_t* pre1; bf16_t* h1;
    bf16_t *Bt_in, *Bt_out, *Bt_wa, *Bt_wx, *Bt_r;
    unsigned char *Bt_gu, *Bt_d, *Bt_sgu, *Bt_sd, *h1q;
    float* bperm; float* lb;
    int* cnt; int* list_tok; float* list_w;
    unsigned char* act; bf16_t* base; unsigned char* yrows;
    unsigned* bar; unsigned long long* xg;
    int flags; int pad_;
};

__device__ __forceinline__ int lds_byte(int r, int c) { const int st = (r >> 4) * 2 + (c >> 5), rr = r & 15, cc = c & 31, ob = rr * 64 + cc * 2; return st * 1024 + (ob ^ (((ob >> 9) & 1) << 5)); }
__device__ __forceinline__ void stage_rc(int b, int& R, int& C) { const int st = b / 1024, sb = b % 1024, swz = sb ^ (((sb >> 9) & 1) << 5); R = (st >> 1) * 16 + swz / 64; C = (st & 1) * 32 + (swz % 64) / 2; }
__device__ __forceinline__ int perm32(int rho) { const int n = rho >> 4, i = rho & 15; return 8 * (i >> 2) + 4 * n + (i & 3); }
__device__ __forceinline__ unsigned cvt_pk_bf16(float lo, float hi) { unsigned r; asm volatile("v_cvt_pk_bf16_f32 %0, %1, %2" : "=v"(r) : "v"(lo), "v"(hi)); return r; }

__device__ __forceinline__ int tid_opaque() { int t = threadIdx.x; asm volatile("" : "+v"(t)); return t; }
struct Unit { int a0; long long boff; int pm; int pn; int e; int r; int i; };
__device__ __forceinline__ void tile_order(int L, int nM, int nN, int& pm, int& pn) {
    const int nwg = nM * nN; int wgid = L;
    { const int q = nwg / NXCD, r = nwg % NXCD, xcd = wgid % NXCD, off = wgid / NXCD; wgid = (xcd < r ? xcd * (q + 1) : r * (q + 1) + (xcd - r) * q) + off; }
    const int nig = WGM * nN, gid = wgid / nig, fm = gid * WGM, gsz = (nM - fm) < WGM ? (nM - fm) : WGM;
    pm = fm + ((wgid % nig) % gsz); pn = (wgid % nig) / gsz;
}

#define XB_TMO      128
#define XB_XCNT(j)  (256  + 64 * (j))
#define XB_XSUB(j)  (1280 + 64 * (j))
#define XB_XGEN(j)  (2304 + 64 * (j))
#define XB_TOP      3328
#define XB_TOPGEN   3392
#define XCD_BAR_WORDS 3456
#define XB_SPIN_CAP (1u << 22)
__device__ __forceinline__ unsigned xb_ld(unsigned* p) { return __hip_atomic_load(p, __ATOMIC_RELAXED, __HIP_MEMORY_SCOPE_AGENT); }
__device__ __forceinline__ unsigned xb_add(unsigned* p, unsigned v) { return __hip_atomic_fetch_add(p, v, __ATOMIC_RELAXED, __HIP_MEMORY_SCOPE_AGENT); }
__device__ __forceinline__ unsigned xb_xcc_id() { return (unsigned)__builtin_amdgcn_s_getreg((3 << 11) | 20) & 0xFu; }
#define XB_SPIN(cond, bar) do { unsigned _sp = 0; while (cond) { __builtin_amdgcn_s_sleep(1); \
    if ((++_sp & 255u) == 0u) { if (xb_ld(&(bar)[XB_TMO])) break; if (_sp > XB_SPIN_CAP) { atomicAdd(&(bar)[XB_TMO], 1u); break; } } } } while (0)
struct XcdBarrier { unsigned* bar; unsigned x; volatile LAS unsigned* st; };
__device__ __forceinline__ XcdBarrier xcd_barrier_post(unsigned* bar, volatile LAS unsigned* st) {
    XcdBarrier b; b.bar = bar; b.x = xb_xcc_id(); b.st = st;
    if (threadIdx.x == 0) (void)xb_add(&bar[XB_XCNT(b.x)], 1u);
    return b;
}
__device__ __forceinline__ void xcd_barrier_complete(unsigned* bar, unsigned x, unsigned& nloc, unsigned& nx) {
    const unsigned G = gridDim.x * gridDim.y * gridDim.z;
    unsigned sum, cnt, mine, sp = 0u;
    for (;;) {
        sum = 0u; cnt = 0u; mine = 0u;
#pragma unroll
        for (unsigned j = 0; j < 16; ++j) { const unsigned c = xb_ld(&bar[XB_XCNT(j)]); sum += c; cnt += (c > 0u) ? 1u : 0u; mine = (j == x) ? c : mine; }
        if (sum == G) break;
        __builtin_amdgcn_s_sleep(1);
        if ((++sp & 255u) == 0u) { if (xb_ld(&bar[XB_TMO])) break; if (sp > XB_SPIN_CAP) { atomicAdd(&bar[XB_TMO], 1u); break; } }
    }
    nloc = mine > 0u ? mine : 1u; nx = cnt > 0u ? cnt : 1u;
}
__device__ __forceinline__ void xcd_barrier(const XcdBarrier& b) {
    asm volatile("s_waitcnt vmcnt(0)" ::: "memory");
    __syncthreads();
    if (threadIdx.x == 0) {
        unsigned* bar = b.bar;
        __builtin_amdgcn_s_waitcnt(0);
        unsigned nloc = b.st[0], nx = b.st[1];
        if (nloc == 0u) { xcd_barrier_complete(bar, b.x, nloc, nx); b.st[0] = nloc; b.st[1] = nx; }
        const unsigned old = xb_add(&bar[XB_XSUB(b.x)], 1u);
        const unsigned gen = old / nloc;
        if (old + 1u == (gen + 1u) * nloc) {
            __builtin_amdgcn_fence(__ATOMIC_RELEASE, "agent");
            asm volatile("s_waitcnt vmcnt(0)" ::: "memory");
            const unsigned og = xb_add(&bar[XB_TOP], 1u);
            const unsigned tg = og / nx;
            if (og + 1u == (tg + 1u) * nx) xb_add(&bar[XB_TOPGEN], 1u);
            else XB_SPIN(xb_ld(&bar[XB_TOPGEN]) == tg, bar);
            __builtin_amdgcn_fence(__ATOMIC_ACQUIRE, "agent");
            xb_add(&bar[XB_XGEN(b.x)], 1u);
            asm volatile("s_waitcnt vmcnt(0)" ::: "memory");
        } else {
            XB_SPIN(xb_ld(&bar[XB_XGEN(b.x)]) == gen, bar);
            __builtin_amdgcn_fence(__ATOMIC_ACQUIRE, "agent");
            asm volatile("s_waitcnt vmcnt(0)" ::: "memory");
        }
    }
    __syncthreads();
}

template <class Epi, class Sched>
__device__ __forceinline__ void gemm_phase(LAS unsigned char* lds, const void* Abase, const void* Btbase, const int KB  , const Sched& S, const Epi& E) {
    const int tid = tid_opaque(), wid = __builtin_amdgcn_readfirstlane(tid >> 6), lane = tid & 63, wr = wid >> 2, wc = wid & 3, fr = lane & 15, fq = lane >> 4;
    const int nt = KB / (BK * 2);
    int Rr[2], Cc[2]; unsigned voffB0;
    { int R, C; stage_rc(tid * 16, R, C); Rr[0] = R; Rr[1] = R + 64; Cc[0] = C; Cc[1] = C;
        if (Epi::PERM == 2) {
            const int rb = 64 * (R >> 5) + 16 * ((R & 15) >> 2) + 4 * ((R >> 4) & 1) + (R & 3);
            voffB0 = (unsigned)(rb * KB + C * 2);
        } else {
            const int Rb = Epi::PERM ? ((R & ~31) + perm32(R & 31)) : R; voffB0 = (unsigned)(Rb * KB + C * 2);
        } }
    const size_t dBi = (size_t)(Epi::PERM == 2 ? 128 : 64) * KB, dBh = (size_t)(Epi::PERM == 2 ? 8 : HALF) * KB;
    const size_t kstep = (size_t)(BK * 2);
    const unsigned ldsw = (unsigned)wid * 1024u;
    const int aoff = lds_byte(wr * 64 + fr, fq * 8), boff = lds_byte(wc * 32 + fr, fq * 8);
#define G_SA(b, h) (((b) * 2 + (h)) * HTB)
#define G_SB(b, h) ((4 + (b) * 2 + (h)) * HTB)
#define G_STAGE(bufoff, gbase, voff) do { _Pragma("unroll") for (int _i = 0; _i < 2; ++_i) { unsigned _o = (voff)[_i]; asm volatile("" : "+v"(_o));     \
        __builtin_amdgcn_global_load_lds((const unsigned*)((const char*)(gbase) + _o), (LAS unsigned*)(lds + (bufoff) + ldsw + _i * 8192), 16, 0, 0); } } while (0)
#define G_STAGE_B(bufoff, gbase, h) do { _Pragma("unroll") for (int _i = 0; _i < 2; ++_i) { unsigned _o = voffB0; asm volatile("" : "+v"(_o)); \
        __builtin_amdgcn_global_load_lds((const unsigned*)((const char*)(gbase) + ((h) ? dBh : 0) + (_i ? dBi : 0) + _o), (LAS unsigned*)(lds + (bufoff) + ldsw + _i * 8192), 16, 0, 0); } } while (0)
#define G_LDA(dst, b, h) do { _Pragma("unroll") for (int m = 0; m < 4; ++m) _Pragma("unroll") for (int k = 0; k < 2; ++k) dst[m][k] = *(const LAS bf16x8*)(lds + G_SA(b, h) + aoff + m * 2048 + k * 1024); } while (0)
#define G_LDB(dst, b, h) do { _Pragma("unroll") for (int n = 0; n < 2; ++n) _Pragma("unroll") for (int k = 0; k < 2; ++k) dst[n][k] = *(const LAS bf16x8*)(lds + G_SB(b, h) + boff + n * 2048 + k * 1024); } while (0)
#define G_MMA(ai, bj, At, Bt) do { __builtin_amdgcn_s_setprio(1); _Pragma("unroll") for (int m = 0; m < 4; ++m) _Pragma("unroll") for (int n = 0; n < 2; ++n) { \
        if constexpr (Epi::F8) { f32x4 c_; _Pragma("unroll") for (int j = 0; j < 4; ++j) c_[j] = accv[ai][bj][(m * 2 + n) * 4 + j]; \
            c_ = __builtin_amdgcn_mfma_scale_f32_16x16x128_f8f6f4(cat8(Bt[n][0], Bt[n][1]), cat8(At[m][0], At[m][1]), c_, 0, 0, 0, 0, 0, 0); \
            _Pragma("unroll") for (int j = 0; j < 4; ++j) accv[ai][bj][(m * 2 + n) * 4 + j] = c_[j]; } \
        else { _Pragma("unroll") for (int k = 0; k < 2; ++k) acc[ai][bj][m][n] = __builtin_amdgcn_mfma_f32_16x16x32_bf16(Bt[n][k], At[m][k], acc[ai][bj][m][n], 0, 0, 0); } } \
        __builtin_amdgcn_s_setprio(0); } while (0)
#define G_WAIT_V(n) asm volatile("s_waitcnt vmcnt(" #n ")" ::: "memory")
#define G_WAIT_L(n) asm volatile("s_waitcnt lgkmcnt(" #n ")" ::: "memory")
#define G_BAR __builtin_amdgcn_s_barrier()
#define G_SCHED __builtin_amdgcn_sched_barrier(0)
    Unit cur, nxt; int ui = 0;
    if (!S.next(0, cur)) return;
    f32x4 acc[2][2][4][2];
    f32x32 accv[2][2];
#pragma unroll
    for (int a = 0; a < 2; ++a)
#pragma unroll
        for (int b = 0; b < 2; ++b)
#pragma unroll
            for (int j = 0; j < 32; ++j) accv[a][b][j] = 0.f;
#pragma unroll
    for (int a = 0; a < 2; ++a)
#pragma unroll
        for (int b = 0; b < 2; ++b)
#pragma unroll
            for (int m = 0; m < 4; ++m)
#pragma unroll
                for (int n = 0; n < 2; ++n) acc[a][b][m][n] = (f32x4){0.f, 0.f, 0.f, 0.f};
    bf16x8 At[4][2], B0[2][2], B1[2][2];
    unsigned vA0[2], vA1[2], vN0[2], vN1[2];
    S.a_off(cur, Rr, Cc, KB, vA0, vA1);
    const char* const cA = (const char*)Abase;
    const char* cB = (const char*)Btbase + cur.boff;
    G_STAGE_B(G_SB(0, 0), cB, 0); G_STAGE(G_SA(0, 0), cA, vA0); G_STAGE_B(G_SB(0, 1), cB, 1); G_STAGE(G_SA(0, 1), cA, vA1);
    if (wr == 1) G_BAR;
    G_WAIT_V(4); G_BAR;
    G_STAGE_B(G_SB(1, 0), cB + kstep, 0); G_STAGE(G_SA(1, 0), cA + kstep, vA0); G_STAGE_B(G_SB(1, 1), cB + kstep, 1);
    G_WAIT_V(6); G_BAR;
    for (;;) {
        const bool has_next = S.next(ui + 1, nxt);
        if (has_next) { S.a_off(nxt, Rr, Cc, KB, vN0, vN1); asm volatile("" : "+v"(vN0[0]), "+v"(vN0[1]), "+v"(vN1[0]), "+v"(vN1[1])); } else { vN0[0] = vA0[0]; vN0[1] = vA0[1]; vN1[0] = vA1[0]; vN1[1] = vA1[1]; }
        const char* nB = has_next ? (const char*)Btbase + nxt.boff : cB;
#pragma nounroll
        for (int t = 0; t < nt; t += 2) {
            const bool last = (t == nt - 2);
            const char* a1 = cA + (size_t)(t + 1) * kstep;
            const char* a2 = last ? cA : cA + (size_t)(t + 2) * kstep; const char* b2 = last ? nB : cB + (size_t)(t + 2) * kstep;
            const char* a3 = a2 + kstep; const char* b3 = b2 + kstep;
            unsigned w0[2], w1[2];
            w0[0] = last ? vN0[0] : vA0[0]; w0[1] = last ? vN0[1] : vA0[1]; w1[0] = last ? vN1[0] : vA1[0]; w1[1] = last ? vN1[1] : vA1[1];
            G_LDB(B0, 0, 0); G_SCHED; G_LDA(At, 0, 0); G_STAGE(G_SA(1, 1), a1, vA1);
            G_WAIT_L(8); G_BAR; G_WAIT_L(0); G_MMA(0, 0, At, B0); G_BAR; G_SCHED;
            G_LDB(B1, 0, 1); G_STAGE_B(G_SB(0, 0), b2, 0);
            G_BAR; G_WAIT_L(0); G_MMA(0, 1, At, B1); G_BAR;
            G_LDA(At, 0, 1); G_STAGE(G_SA(0, 0), a2, w0);
            G_BAR; G_WAIT_L(0); G_MMA(1, 0, At, B0); G_BAR; G_SCHED;
            G_STAGE_B(G_SB(0, 1), b2, 1);
            G_WAIT_V(6); G_BAR; G_MMA(1, 1, At, B1); G_BAR;
            G_LDB(B0, 1, 0); G_SCHED; G_LDA(At, 1, 0); G_STAGE(G_SA(0, 1), a2, w1);
            G_WAIT_L(8); G_BAR; G_WAIT_L(0); G_MMA(0, 0, At, B0); G_BAR; G_SCHED;
            G_LDB(B1, 1, 1); G_STAGE_B(G_SB(1, 0), b3, 0);
            G_BAR; G_WAIT_L(0); G_MMA(0, 1, At, B1); G_BAR;
            G_LDA(At, 1, 1); G_STAGE(G_SA(1, 0), a3, w0);
            G_BAR; G_WAIT_L(0); G_MMA(1, 0, At, B0); G_BAR; G_SCHED;
            G_STAGE_B(G_SB(1, 1), b3, 1);
            G_WAIT_V(6); G_BAR; G_MMA(1, 1, At, B1); G_BAR;
        }
        if constexpr (Epi::F8) {
#pragma unroll
            for (int a = 0; a < 2; ++a)
#pragma unroll
                for (int b = 0; b < 2; ++b)
#pragma unroll
                    for (int m = 0; m < 4; ++m)
#pragma unroll
                        for (int n = 0; n < 2; ++n)
#pragma unroll
                            for (int j = 0; j < 4; ++j) acc[a][b][m][n][j] = accv[a][b][(m * 2 + n) * 4 + j];
        }
        E(acc, cur, wr, wc, fr, fq);
        if (!has_next) break;
        if constexpr (Epi::F8) {
#pragma unroll
            for (int a = 0; a < 2; ++a)
#pragma unroll
                for (int b = 0; b < 2; ++b)
#pragma unroll
                    for (int j = 0; j < 32; ++j) accv[a][b][j] = 0.f;
        }
#pragma unroll
        for (int a = 0; a < 2; ++a)
#pragma unroll
            for (int b = 0; b < 2; ++b)
#pragma unroll
                for (int m = 0; m < 4; ++m)
#pragma unroll
                    for (int n = 0; n < 2; ++n) acc[a][b][m][n] = (f32x4){0.f, 0.f, 0.f, 0.f};
        cur = nxt; cB = nB; vA0[0] = vN0[0]; vA0[1] = vN0[1]; vA1[0] = vN1[0]; vA1[1] = vN1[1]; ++ui;
    }
    G_WAIT_V(0);
    if (wr == 0) G_BAR;
    G_BAR;
#undef G_SA
#undef G_SB
#undef G_STAGE
#undef G_STAGE_B
#undef G_LDA
#undef G_LDB
#undef G_MMA
#undef G_WAIT_V
#undef G_WAIT_L
#undef G_BAR
#undef G_SCHED
}

template <int NT, bool F8, class F>
__device__ __forceinline__ void transpose_strip(const float* __restrict__ src, int sld, int k0, int n0, void* __restrict__ dstv, int dld, F drow, LAS float* sm) {
    const int tid = threadIdx.x, kr = tid >> 3, c8 = (tid & 7) * 8;
    f32x4 a[NT], b[NT];
#pragma unroll
    for (int t = 0; t < NT; ++t) { a[t] = *(const f32x4*)(src + (size_t)(k0 + kr) * sld + n0 + t * 64 + c8); b[t] = *(const f32x4*)(src + (size_t)(k0 + kr) * sld + n0 + t * 64 + c8 + 4); }
#pragma unroll
    for (int t = 0; t < NT; ++t) {
        LAS float* w = sm + t * (64 * 65) + kr * 65 + c8;
        w[0] = a[t][0]; w[1] = a[t][1]; w[2] = a[t][2]; w[3] = a[t][3]; w[4] = b[t][0]; w[5] = b[t][1]; w[6] = b[t][2]; w[7] = b[t][3];
    }
    __syncthreads();
    const int nr = tid >> 3, k8 = (tid & 7) * 8;
#pragma unroll
    for (int t = 0; t < NT; ++t) {
        float v[8];
#pragma unroll
        for (int i = 0; i < 8; ++i) v[i] = sm[t * (64 * 65) + (k8 + i) * 65 + nr];
        if constexpr (F8) {
            *(u32x2*)((unsigned char*)dstv + (size_t)drow(n0 + t * 64 + nr) * dld + k0 + k8) =
                (u32x2){pk_fp8x4(v[0] * WSCALE8, v[1] * WSCALE8, v[2] * WSCALE8, v[3] * WSCALE8), pk_fp8x4(v[4] * WSCALE8, v[5] * WSCALE8, v[6] * WSCALE8, v[7] * WSCALE8)};
        } else {
            u32x4 o; o.x = cvt_pk_bf16(v[0], v[1]); o.y = cvt_pk_bf16(v[2], v[3]); o.z = cvt_pk_bf16(v[4], v[5]); o.w = cvt_pk_bf16(v[6], v[7]);
            *(u32x4*)((bf16_t*)dstv + (size_t)drow(n0 + t * 64 + nr) * dld + k0 + k8) = o;
        }
    }
    __syncthreads();
}
__device__ __forceinline__ int drow_in(int s) {
    const int sec = s >> 10, i = s & 1023, h = i >> 7, j = i & 127;
    switch (sec) {
        case 0: return h * 256 + j;
        case 1: return h * 256 + 128 + j;
        case 2: return (8 + (i >> 8)) * 256 + (i & 255);
        case 3: return (12 + h) * 256 + j;
        case 4: return (20 + (i >> 8)) * 256 + (i & 255);
        case 5: return (24 + h) * 256 + j;
        case 6: return (12 + h) * 256 + 128 + j;
        default: return (24 + h) * 256 + 128 + j;
    }
}
__device__ __forceinline__ void phase_prep(const Params& p, LAS unsigned char* lds) {
    LAS float* sm = (LAS float*)lds;
    const int nwg = gridDim.x, wg = blockIdx.x;
    constexpr int NT_TOTAL = 512 + 64 + 1024 * 3 + 16 * 3 + 16 * 2 + 16;
    const bool experts_here = gridDim.x != 256;
    for (int it = wg; it < NT_TOTAL; it += nwg) {
        int t = it;
        if (!experts_here && t >= 576 && t < 576 + 3072) continue;
        if (t < 512) { const int kt = t >> 5, ns = t & 31; transpose_strip<4, false>(p.w_in, 8192, kt * 64, ns * 256, p.Bt_in, 1024, [](int n) { return drow_in(n); }, sm); continue; }
        t -= 512;
        if (t < 64) { const int kt = t >> 2, ns = t & 3; transpose_strip<4, false>(p.w_out, 1024, kt * 64, ns * 256, p.Bt_out, 1024, [](int n) { return n; }, sm); continue; }
        t -= 64;
        if (t < 1024) { const int e = t >> 4, kt = t & 15; transpose_strip<4, true>(p.we_gate + (size_t)e * D * DE, DE, kt * 64, 0, p.Bt_gu + (size_t)e * 512 * D, D, [](int n) { return (n >> 7) * 256 + (n & 127); }, sm); continue; }
        t -= 1024;
        if (t < 1024) { const int e = t >> 4, kt = t & 15; transpose_strip<4, true>(p.we_up + (size_t)e * D * DE, DE, kt * 64, 0, p.Bt_gu + (size_t)e * 512 * D, D, [](int n) { return (n >> 7) * 256 + 128 + (n & 127); }, sm); continue; }
        t -= 1024;
        if (t < 1024) { const int e = t >> 4, r = t & 15, kt = r >> 2, ns = r & 3; transpose_strip<4, true>(p.we_down + (size_t)e * DE * D, D, kt * 64, ns * 256, p.Bt_d + (size_t)e * D * DE, DE, [](int n) { return n; }, sm); continue; }
        t -= 1024;
        if (t < 16) { transpose_strip<4, true>(p.ws_gate, DE, t * 64, 0, p.Bt_sgu, D, [](int n) { return (n >> 7) * 256 + (n & 127); }, sm); continue; }
        t -= 16;
        if (t < 16) { transpose_strip<4, true>(p.ws_up, DE, t * 64, 0, p.Bt_sgu, D, [](int n) { return (n >> 7) * 256 + 128 + (n & 127); }, sm); continue; }
        t -= 16;
        if (t < 16) { const int kt = t >> 2, ns = t & 3; transpose_strip<4, true>(p.ws_down, D, kt * 64, ns * 256, p.Bt_sd, DE, [](int n) { return n; }, sm); continue; }
        t -= 16;
        if (t < 16) { const int e = t >> 1, kt = t & 1; transpose_strip<2, false>(p.lru_wa + (size_t)e * 16384, 128, kt * 64, 0, p.Bt_wa + (size_t)e * 16384, 128, [](int n) { return n; }, sm); continue; }
        t -= 16;
        if (t < 16) { const int e = t >> 1, kt = t & 1; transpose_strip<2, false>(p.lru_wx + (size_t)e * 16384, 128, kt * 64, 0, p.Bt_wx + (size_t)e * 16384, 128, [](int n) { return n; }, sm); continue; }
        t -= 16;
        { transpose_strip<1, false>(p.router_w, NE, t * 64, 0, p.Bt_r, D, [](int n) { return n; }, sm); }
    }
    {
        const int wv = threadIdx.x >> 6, lane = threadIdx.x & 63;
        f32x4 g0v[4], b0v[4];
#pragma unroll
        for (int j = 0; j < 4; ++j) { g0v[j] = *(const f32x4*)(p.ln_in_g + j * 256 + lane * 4); b0v[j] = *(const f32x4*)(p.ln_in_b + j * 256 + lane * 4); }
        for (int it = wg; it < TP / 8; it += nwg) {
            const int row = it * 8 + wv;
            const int bb = row / LP, pos = row % LP;
            bf16_t* dst = p.h0 + (size_t)row * D;
            if (pos < PADR) {
#pragma unroll
                for (int j = 0; j < 4; ++j) *(u32x2*)(dst + j * 256 + lane * 4) = (u32x2){0u, 0u};
                continue;
            }
            const float* src = pos < 64 ? p.meta + (size_t)(pos - PADR) * D : p.x + ((size_t)bb * SEQ + (pos - 64)) * D;
            f32x4 v[4]; float s = 0.f;
#pragma unroll
            for (int j = 0; j < 4; ++j) { v[j] = *(const f32x4*)(src + j * 256 + lane * 4); s += (v[j][0] + v[j][1]) + (v[j][2] + v[j][3]); }
            const float mean = wave_sum(s) * (1.0f / D);
            float q = 0.f;
#pragma unroll
            for (int j = 0; j < 4; ++j) { const f32x4 d = v[j] - mean; q += (d[0] * d[0] + d[1] * d[1]) + (d[2] * d[2] + d[3] * d[3]); }
            const float rstd = rsqrtf(wave_sum(q) * (1.0f / D) + 1e-5f);
#pragma unroll
            for (int j = 0; j < 4; ++j) {
                const int c0 = j * 256 + lane * 4;
                const f32x4 o = (v[j] - mean) * rstd * g0v[j] + b0v[j];
                *(u32x2*)(dst + c0) = (u32x2){cvt_pk_bf16(o[0], o[1]), cvt_pk_bf16(o[2], o[3])};
            }
        }
    }
    { const int t0 = tid_opaque(); if (wg == 0 && t0 < 64) p.cnt[t0 * 64] = 0; }
    for (int i = wg * NTHR + threadIdx.x; i < 64 * 4 * 4 * 64; i += nwg * NTHR) p.xg[i] = 0ull;
    for (int s = wg * NTHR + threadIdx.x; s < 1024; s += nwg * NTHR) p.lb[s] = 1.0f / (1.0f + expf(p.lbl[D + s] - p.lbl[s]));
    for (int s = wg * NTHR + threadIdx.x; s < 8192; s += nwg * NTHR) p.bperm[drow_in(s)] = p.b_in[s];
}

struct Sched3 {
    int G, c;
    __device__ __forceinline__ bool next(int i, Unit& u) const {
        const int L = i * G + c; if (L >= 128 * 4) return false;
        int pm, pn; tile_order(L, 128, 4, pm, pn);
        u.pm = pm; u.pn = pn; u.a0 = (pm >> 4) * LP + 64 + (pm & 15) * 256; u.boff = (long long)pn * 256 * D * 2; u.e = 0; u.r = 0; u.i = i; return true;
    }
    __device__ __forceinline__ void a_off(const Unit& u, const int (&R)[2], const int (&C)[2], int KB, unsigned (&v0)[2], unsigned (&v1)[2]) const {
#pragma unroll
        for (int i = 0; i < 2; ++i) { v0[i] = (unsigned)((u.a0 + R[i]) * KB + C[i] * 2); v1[i] = (unsigned)((u.a0 + HALF + R[i]) * KB + C[i] * 2); }
    }
};
struct Epi3 {
    static constexpr int PERM = 1; static constexpr bool F8 = false;
    const bf16_t* __restrict__ h0; bf16_t* __restrict__ pre1;
    __device__ __forceinline__ void operator()(const f32x4 (&acc)[2][2][4][2], const Unit& u, int wr, int wc, int fr, int fq) const {
        int c0 = u.pn * 256 + wc * 32 + 8 * fq, rit = wr * 64 + fr;
        asm volatile("" : "+v"(c0), "+v"(rit));
        const bf16_t* hb = h0 + ((size_t)u.a0 + rit) * D + c0;
        bf16_t* pb = pre1 + ((size_t)u.pm * 256 + rit) * D + c0;
#pragma unroll
        for (int ai = 0; ai < 2; ++ai) {
            u32x4 hv[4][2];
#pragma unroll
            for (int m = 0; m < 4; ++m)
#pragma unroll
                for (int bj = 0; bj < 2; ++bj) hv[m][bj] = *(const u32x4*)(hb + (size_t)(ai * HALF + m * 16) * D + bj * HALF);
#pragma unroll
            for (int m = 0; m < 4; ++m)
#pragma unroll
                for (int bj = 0; bj < 2; ++bj) {
                    const u32x4 h = hv[m][bj]; const f32x4 v0 = acc[ai][bj][m][0], v1 = acc[ai][bj][m][1];
                    u32x4 w;
                    w.x = cvt_pk_bf16(v0[0] + ALPHA * __uint_as_float(h.x << 16), v0[1] + ALPHA * __uint_as_float(h.x & 0xffff0000u));
                    w.y = cvt_pk_bf16(v0[2] + ALPHA * __uint_as_float(h.y << 16), v0[3] + ALPHA * __uint_as_float(h.y & 0xffff0000u));
                    w.z = cvt_pk_bf16(v1[0] + ALPHA * __uint_as_float(h.z << 16), v1[1] + ALPHA * __uint_as_float(h.z & 0xffff0000u));
                    w.w = cvt_pk_bf16(v1[2] + ALPHA * __uint_as_float(h.w << 16), v1[3] + ALPHA * __uint_as_float(h.w & 0xffff0000u));
                    *(u32x4*)(pb + (size_t)(ai * HALF + m * 16) * D + bj * HALF) = w;
                }
            asm volatile("" ::: "memory");
        }
    }
};
__device__ __forceinline__ void phase3(const Params& p, LAS unsigned char* lds) {
    Sched3 S{(int)gridDim.x, (int)blockIdx.x}; Epi3 E{p.h0, p.pre1};
    gemm_phase(lds, p.G1, p.Bt_out, D * 2, S, E);
}

__device__ __forceinline__ float fast_sigmoid(float z) { return __builtin_amdgcn_rcpf(1.0f + __builtin_amdgcn_exp2f(-1.4426950408889634f * z)); }
template <int N> __device__ __forceinline__ float dpp_row_shr(float v) { return __int_as_float(__builtin_amdgcn_update_dpp(0, __float_as_int(v), 0x110 + N, 0xF, 0xF, false)); }
__device__ __forceinline__ float row16_incl_scan(float v) { v += dpp_row_shr<1>(v); v += dpp_row_shr<2>(v); v += dpp_row_shr<4>(v); v += dpp_row_shr<8>(v); return v; }
struct Sched1 {
    int G, c;
    __device__ __forceinline__ bool next(int i, Unit& u) const {
        const int L = i * G + c; if (L >= 130 * 32) return false;
        int pm, pn; tile_order(L, 130, 32, pm, pn);
        u.pm = pm; u.pn = pn; u.a0 = pm * 256; u.boff = (long long)pn * 256 * D * 2; u.e = 0; u.r = 0; u.i = i; return true;
    }
    __device__ __forceinline__ void a_off(const Unit& u, const int (&R)[2], const int (&C)[2], int KB, unsigned (&v0)[2], unsigned (&v1)[2]) const {
#pragma unroll
        for (int i = 0; i < 2; ++i) { v0[i] = (unsigned)((u.a0 + R[i]) * KB + C[i] * 2); v1[i] = (unsigned)((u.a0 + HALF + R[i]) * KB + C[i] * 2); }
    }
};
struct Epi1 {
    static constexpr int PERM = 1; static constexpr bool F8 = false;
    const LAS bf16_t* sbias; const LAS float* slb;
    bf16_t* __restrict__ Qh; bf16_t* __restrict__ Kh; bf16_t* __restrict__ Vv; bf16_t* __restrict__ G1; bf16_t* __restrict__ LX; bf16_t* __restrict__ G2; float* __restrict__ Dk;
    __device__ __forceinline__ void ld8(const LAS bf16_t* p, f32x4& lo, f32x4& hi) const {
        const u32x4 v = *(const LAS u32x4*)p;
        lo = (f32x4){__uint_as_float(v.x << 16), __uint_as_float(v.x & 0xffff0000u), __uint_as_float(v.y << 16), __uint_as_float(v.y & 0xffff0000u)};
        hi = (f32x4){__uint_as_float(v.z << 16), __uint_as_float(v.z & 0xffff0000u), __uint_as_float(v.w << 16), __uint_as_float(v.w & 0xffff0000u)};
    }
    __device__ __forceinline__ void operator()(const f32x4 (&acc)[2][2][4][2], const Unit& u, int wr, int wc, int fr, int fq) const {
        const int pn = u.pn, col8 = wc * 32 + fq * 8;
        const size_t row0 = (size_t)u.pm * 256 + wr * 64 + fr;
        if (pn < 8) {
            f32x4 bq0, bq1, bf0, bf1; ld8(sbias + pn * 256 + col8, bq0, bq1); ld8(sbias + pn * 256 + 128 + col8, bf0, bf1);
            const f32x4 lb0 = *(const LAS f32x4*)(slb + pn * 128 + col8), lb1 = *(const LAS f32x4*)(slb + pn * 128 + col8 + 4);
            const int lane16 = (int)(threadIdx.x & 48) | 15;
#pragma unroll
            for (int ai = 0; ai < 2; ++ai) {
                const int chunk = u.pm * 4 + ai * 2 + wr;
                const bool first = (chunk % NCH) == 0;
                float carry[2][4];
#pragma unroll
                for (int n = 0; n < 2; ++n)
#pragma unroll
                    for (int j = 0; j < 4; ++j) carry[n][j] = 0.f;
#pragma unroll
                for (int m = 0; m < 4; ++m) {
                    const bool pad = first && (m * 16 + fr < PADR);
                    float qo[2][4], ko[2][4];
#pragma unroll
                    for (int n = 0; n < 2; ++n)
#pragma unroll
                        for (int j = 0; j < 4; ++j) {
                            const float qv = acc[ai][0][m][n][j] + (n ? bq1[j] : bq0[j]);
                            const float z = acc[ai][1][m][n][j] + (n ? bf1[j] : bf0[j]);
                            const float lbv = n ? lb1[j] : lb0[j];
                            const float f = lbv + (1.0f - lbv) * fast_sigmoid(z);
                            const float l2 = pad ? 0.f : __builtin_amdgcn_logf(f);
                            const float s = row16_incl_scan(l2) + carry[n][j];
                            carry[n][j] = __shfl(s, lane16);
                            qo[n][j] = qv * fast_sigmoid(qv) * __builtin_amdgcn_exp2f(s);
                            ko[n][j] = pad ? 0.f : (1.0f - f) * __builtin_amdgcn_exp2f(fminf(-s, 120.0f));
                        }
                    const size_t o = (row0 + ai * HALF + m * 16) * D + pn * 128 + col8;
                    u32x4 wq, wk;
                    wq.x = cvt_pk_bf16(qo[0][0], qo[0][1]); wq.y = cvt_pk_bf16(qo[0][2], qo[0][3]); wq.z = cvt_pk_bf16(qo[1][0], qo[1][1]); wq.w = cvt_pk_bf16(qo[1][2], qo[1][3]);
                    wk.x = cvt_pk_bf16(ko[0][0], ko[0][1]); wk.y = cvt_pk_bf16(ko[0][2], ko[0][3]); wk.z = cvt_pk_bf16(ko[1][0], ko[1][1]); wk.w = cvt_pk_bf16(ko[1][2], ko[1][3]);
                    *(u32x4*)(Qh + o) = wq; *(u32x4*)(Kh + o) = wk;
                }
                if (fr == 0) {
                    float* dp = Dk + (size_t)chunk * D + pn * 128 + col8;
                    *(f32x4*)dp = (f32x4){__builtin_amdgcn_exp2f(carry[0][0]), __builtin_amdgcn_exp2f(carry[0][1]), __builtin_amdgcn_exp2f(carry[0][2]), __builtin_amdgcn_exp2f(carry[0][3])};
                    *(f32x4*)(dp + 4) = (f32x4){__builtin_amdgcn_exp2f(carry[1][0]), __builtin_amdgcn_exp2f(carry[1][1]), __builtin_amdgcn_exp2f(carry[1][2]), __builtin_amdgcn_exp2f(carry[1][3])};
                }
            }
        } else if ((pn >= 8 && pn < 12) || (pn >= 20 && pn < 24)) {
            bf16_t* dst = pn < 12 ? Vv : LX; const int cb = (pn - (pn < 12 ? 8 : 20)) * 256;
#pragma unroll
            for (int bj = 0; bj < 2; ++bj) {
                f32x4 b0, b1; ld8(sbias + pn * 256 + bj * HALF + col8, b0, b1);
#pragma unroll
                for (int ai = 0; ai < 2; ++ai)
#pragma unroll
                    for (int m = 0; m < 4; ++m) {
                        const f32x4 v0 = acc[ai][bj][m][0] + b0, v1 = acc[ai][bj][m][1] + b1;
                        u32x4 w; w.x = cvt_pk_bf16(v0[0], v0[1]); w.y = cvt_pk_bf16(v0[2], v0[3]); w.z = cvt_pk_bf16(v1[0], v1[1]); w.w = cvt_pk_bf16(v1[2], v1[3]);
                        *(u32x4*)(dst + (row0 + ai * HALF + m * 16) * D + cb + bj * HALF + col8) = w;
                    }
            }
        } else {
            const bool is1 = pn < 20; bf16_t* dst = is1 ? G1 : G2; const int cb = (pn - (is1 ? 12 : 24)) * 128;
            f32x4 ba0, ba1, bg0, bg1; ld8(sbias + pn * 256 + col8, ba0, ba1); ld8(sbias + pn * 256 + 128 + col8, bg0, bg1);
#pragma unroll
            for (int ai = 0; ai < 2; ++ai)
#pragma unroll
                for (int m = 0; m < 4; ++m) {
                    float o[2][4];
#pragma unroll
                    for (int n = 0; n < 2; ++n)
#pragma unroll
                        for (int j = 0; j < 4; ++j) {
                            const float a = acc[ai][0][m][n][j] + (n ? ba1[j] : ba0[j]);
                            const float g = acc[ai][1][m][n][j] + (n ? bg1[j] : bg0[j]);
                            const float arg = is1 ? a : 1.5957691216057308f * (a + 0.044715f * a * a * a);
                            o[n][j] = a * fast_sigmoid(arg) * fast_sigmoid(g);
                        }
                    u32x4 w; w.x = cvt_pk_bf16(o[0][0], o[0][1]); w.y = cvt_pk_bf16(o[0][2], o[0][3]); w.z = cvt_pk_bf16(o[1][0], o[1][1]); w.w = cvt_pk_bf16(o[1][2], o[1][3]);
                    *(u32x4*)(dst + (row0 + ai * HALF + m * 16) * D + cb + col8) = w;
                }
        }
    }
};
__device__ __forceinline__ void phase1(const Params& p, LAS unsigned char* lds) {
    LAS bf16_t* sbias = (LAS bf16_t*)(lds + STAGE_BYTES); LAS float* slb = (LAS float*)(lds + STAGE_BYTES + 16384);
    for (int i = threadIdx.x; i < 8192; i += NTHR) sbias[i] = f2bf(p.bperm[i]);
    for (int i = threadIdx.x; i < 1024; i += NTHR) slb[i] = p.lb[i];
    __syncthreads();
    Sched1 S{(int)gridDim.x, (int)blockIdx.x}; Epi1 E{sbias, slb, p.Qh, p.Kh, p.Vv, p.G1, p.LX, p.G2, p.Dk};
    gemm_phase(lds, p.h0, p.Bt_in, D * 2, S, E);
}

__device__ __forceinline__ void phase4(const Params& p, LAS unsigned char* lds) {
    constexpr int ASTR = 2064;
    LAS unsigned char* Aimg = lds;
    LAS float* sc = (LAS float*)(lds + 64 * ASTR);
    LAS int* asg_e = (LAS int*)(lds + 64 * ASTR + 16384);
    LAS float* asg_w = (LAS float*)(asg_e + 384);
    LAS int* asg_r = (LAS int*)(asg_w + 384);
    LAS int* cntL = asg_r + 384;
    LAS int* baseL = cntL + 64;
    const int tid = tid_opaque(), wv = tid >> 6, lane = tid & 63;
    bf16x8 rwf[16];
#pragma unroll
    for (int ks = 0; ks < 16; ++ks) rwf[ks] = *(const bf16x8*)(p.Bt_r + (size_t)((wv & 3) * 16 + (lane & 15)) * D + 512 * (wv >> 2) + 32 * ks + 8 * (lane >> 4));
    f32x4 g1v[4], b1v[4];
#pragma unroll
    for (int j = 0; j < 4; ++j) { g1v[j] = *(const f32x4*)(p.ln1_g + j * 256 + lane * 4); b1v[j] = *(const f32x4*)(p.ln1_b + j * 256 + lane * 4); }
    for (int tile = blockIdx.x; tile < T / 64; tile += gridDim.x) {
        if (tid < 64) cntL[tid] = 0;
        *(LAS f32x4*)(sc + tid * 8) = (f32x4){0.f, 0.f, 0.f, 0.f}; *(LAS f32x4*)(sc + tid * 8 + 4) = (f32x4){0.f, 0.f, 0.f, 0.f};
        u32x2 vn[4];
#pragma unroll
        for (int j = 0; j < 4; ++j) vn[j] = *(const u32x2*)(p.pre1 + ((size_t)tile * 64 + wv * 8) * D + j * 256 + lane * 4);
        for (int i = 0; i < 8; ++i) {
            const int tl = wv * 8 + i; const size_t tok = (size_t)tile * 64 + tl;
            f32x4 v[4]; float s = 0.f;
#pragma unroll
            for (int j = 0; j < 4; ++j) { v[j] = (f32x4){__uint_as_float(vn[j].x << 16), __uint_as_float(vn[j].x & 0xffff0000u), __uint_as_float(vn[j].y << 16), __uint_as_float(vn[j].y & 0xffff0000u)}; s += (v[j][0] + v[j][1]) + (v[j][2] + v[j][3]); }
            { const size_t tokn = tok + (i < 7 ? 1 : 0);
#pragma unroll
              for (int j = 0; j < 4; ++j) vn[j] = *(const u32x2*)(p.pre1 + tokn * D + j * 256 + lane * 4); }
            const float mean = wave_sum(s) * (1.0f / D);
            float q = 0.f;
#pragma unroll
            for (int j = 0; j < 4; ++j) { const f32x4 d = v[j] - mean; q += (d[0] * d[0] + d[1] * d[1]) + (d[2] * d[2] + d[3] * d[3]); }
            const float rstd = rsqrtf(wave_sum(q) * (1.0f / D) + 1e-5f);
#pragma unroll
            for (int j = 0; j < 4; ++j) {
                const int c0 = j * 256 + lane * 4;
                const f32x4 o = (v[j] - mean) * rstd * g1v[j] + b1v[j];
                const u32x2 w = (u32x2){cvt_pk_bf16(o[0], o[1]), cvt_pk_bf16(o[2], o[3])};
                *(u32x2*)(p.h1 + tok * D + c0) = w;
                *(unsigned*)(p.h1q + tok * D + c0) = pk_fp8x4(o[0], o[1], o[2], o[3]);
                *(LAS u32x2*)(Aimg + tl * ASTR + c0 * 2) = w;
            }
        }
        __syncthreads();
        {
            const int fr = lane & 15, fq = lane >> 4, nt = wv & 3, kh = wv >> 2;
            f32x4 ac[4];
#pragma unroll
            for (int mt = 0; mt < 4; ++mt) ac[mt] = (f32x4){0.f, 0.f, 0.f, 0.f};
#pragma unroll
            for (int ks = 0; ks < 16; ++ks)
#pragma unroll
                for (int mt = 0; mt < 4; ++mt) {
                    const bf16x8 a = *(const LAS bf16x8*)(Aimg + (mt * 16 + fr) * ASTR + (512 * kh + 32 * ks + 8 * fq) * 2);
                    ac[mt] = __builtin_amdgcn_mfma_f32_16x16x32_bf16(a, rwf[ks], ac[mt], 0, 0, 0);
                }
#pragma unroll
            for (int mt = 0; mt < 4; ++mt)
#pragma unroll
                for (int r = 0; r < 4; ++r) __hip_atomic_fetch_add(sc + (mt * 16 + fq * 4 + r) * 64 + nt * 16 + fr, ac[mt][r], __ATOMIC_RELAXED, __HIP_MEMORY_SCOPE_WORKGROUP);
        }
        __syncthreads();
        const float rb = p.router_b[lane];
        for (int i = 0; i < 8; ++i) {
            const int tl = wv * 8 + i; const size_t tok = (size_t)tile * 64 + tl;
            const float sg = fast_sigmoid(sc[tl * 64 + lane]);
            float sel = sg + rb; float ssum = 0.f; int my_e = 0; float my_s = 0.f;
#pragma unroll
            for (int kk = 0; kk < TOPK; ++kk) {
                const int NEG = (int)0xff800000u;
                float v = sel;
                v = fmaxf(v, __int_as_float(__builtin_amdgcn_update_dpp(NEG, __float_as_int(v), 0x111, 0xF, 0xF, false)));
                v = fmaxf(v, __int_as_float(__builtin_amdgcn_update_dpp(NEG, __float_as_int(v), 0x112, 0xF, 0xF, false)));
                v = fmaxf(v, __int_as_float(__builtin_amdgcn_update_dpp(NEG, __float_as_int(v), 0x114, 0xF, 0xF, false)));
                v = fmaxf(v, __int_as_float(__builtin_amdgcn_update_dpp(NEG, __float_as_int(v), 0x118, 0xF, 0xF, false)));
                v = fmaxf(v, __int_as_float(__builtin_amdgcn_update_dpp(NEG, __float_as_int(v), 0x142, 0xA, 0xF, false)));
                v = fmaxf(v, __int_as_float(__builtin_amdgcn_update_dpp(NEG, __float_as_int(v), 0x143, 0xC, 0xF, false)));
                const float mx = __int_as_float(__builtin_amdgcn_readlane(__float_as_int(v), 63));
                const unsigned long long mk = __ballot(sel == mx);
                const int bi = __builtin_amdgcn_readfirstlane((int)__builtin_ctzll(mk));
                const float ws = __int_as_float(__builtin_amdgcn_readlane(__float_as_int(sg), bi)); ssum += ws;
                if (lane == kk) { my_e = bi; my_s = ws; }
                if (lane == bi) sel = -3.0e38f;
            }
            if (lane < TOPK) {
                const float w = my_s / ssum * 2.5f;
                asg_e[tl * TOPK + lane] = my_e; asg_w[tl * TOPK + lane] = w;
                p.ridx[tok * TOPK + lane] = my_e; p.rwts[tok * TOPK + lane] = w;
            }
        }
        __syncthreads();
        if (tid < 384) asg_r[tid] = __hip_atomic_fetch_add(cntL + asg_e[tid], 1, __ATOMIC_RELAXED, __HIP_MEMORY_SCOPE_WORKGROUP);
        __syncthreads();
        if (tid < 64) { const int c = cntL[tid]; baseL[tid] = c ? __hip_atomic_fetch_add(p.cnt + tid * 64, c, __ATOMIC_RELAXED, __HIP_MEMORY_SCOPE_AGENT) : 0; }
        __syncthreads();
        if (tid < 384) { const int e = asg_e[tid]; const int slot = baseL[e] + asg_r[tid]; p.list_tok[(size_t)e * T + slot] = tile * 384 + tid; p.list_w[(size_t)e * T + slot] = asg_w[tid]; }
        __syncthreads();
    }
}

constexpr int ACT_S_ROW0 = 832 * 256;
__device__ __forceinline__ void moe_table(const Params& p, LAS unsigned char* lds) {
    LAS int* tb = (LAS int*)(lds + STAGE_BYTES); LAS int* ce = tb + 80;
    const int tm = tid_opaque();
    if (tm < 64) {
        const int lane = tm; const int c = p.cnt[lane * 64]; const int tl = (c + 255) >> 8;
        int s = tl;
#pragma unroll
        for (int o = 1; o < 64; o <<= 1) { const int t = __shfl_up(s, o); if (lane >= o) s += t; }
        tb[lane] = s - tl; ce[lane] = c; if (lane == 63) tb[64] = s;
    }
    __syncthreads();
}
template <int NCU  >
struct SchedMoe {
    int G, c; const LAS int* tb; const LAS int* ce; const LAS int* mtok; long long sh_boff; long long e_stride; int KB;
    __device__ __forceinline__ bool next(int i, Unit& u) const {
        const int NT = __builtin_amdgcn_readfirstlane(tb[64]); const int L = i * G + c;
        if (L >= NCU * NT + NCU * 128) return false;
        if (L < NCU * NT) {
            int t, j; tile_order(L, NT, NCU, t, j);
            int lane = threadIdx.x & 63; asm volatile("" : "+v"(lane));
            const unsigned long long mk = __ballot(tb[lane] <= t);
            const int e = __builtin_amdgcn_readfirstlane((int)__popcll(mk) - 1);
            const int tbe = __builtin_amdgcn_readfirstlane(tb[e]);
            u.i = i; u.e = e; u.r = t - tbe; u.pm = t; u.pn = j; u.a0 = t * 256; u.boff = (long long)e * e_stride + (long long)j * 256 * KB;
        } else {
            int pm, j; tile_order(L - NCU * NT, 128, NCU, pm, j);
            u.i = i; u.e = -1; u.r = 0; u.pm = pm; u.pn = j; u.a0 = ACT_S_ROW0 + pm * 256; u.boff = sh_boff + (long long)j * 256 * KB;
        }
        return true;
    }
    __device__ __forceinline__ void a_off(const Unit& u, const int (&R)[2], const int (&C)[2], int K_, unsigned (&v0)[2], unsigned (&v1)[2]) const {
        if (NCU == 4) {
#pragma unroll
            for (int i = 0; i < 2; ++i) { v0[i] = (unsigned)((u.a0 + R[i]) * K_ + C[i] * 2); v1[i] = (unsigned)((u.a0 + HALF + R[i]) * K_ + C[i] * 2); }
        } else if (u.e < 0) {
#pragma unroll
            for (int i = 0; i < 2; ++i) { v0[i] = (unsigned)((u.pm * 256 + R[i]) * K_ + C[i] * 2); v1[i] = (unsigned)((u.pm * 256 + HALF + R[i]) * K_ + C[i] * 2); }
        } else {
            const LAS int* mt = mtok + u.i * 256;
#pragma unroll
            for (int i = 0; i < 2; ++i) {
                const int t0 = mt[R[i]], t1 = mt[R[i] + HALF];
                v0[i] = (unsigned)(t0 * K_ + C[i] * 2); v1[i] = (unsigned)(t1 * K_ + C[i] * 2);
            }
        }
    }
};
constexpr int MOE_META_OFF = STAGE_BYTES + 1024, MOE_MAXU = 16;
template <int NCU>
__device__ __forceinline__ void moe_meta(const Params& p, LAS unsigned char* lds, const SchedMoe<NCU>& S) {
    LAS int* mt = (LAS int*)(lds + MOE_META_OFF); LAS float* mw = (LAS float*)(mt + MOE_MAXU * 256);
    const int tid = tid_opaque(), row = tid & 255, h = tid >> 8;
    constexpr int NI = MOE_MAXU / 2;
    int tv[NI]; float wv[NI];
#pragma unroll
    for (int k = 0; k < NI; ++k) {
        const int i = 2 * k + h; Unit u; tv[k] = NCU == 2 ? 0 : -1; wv[k] = 0.f;
        if (S.next(i, u)) {
            if (u.e >= 0) {
                const int n = __builtin_amdgcn_readfirstlane(S.ce[u.e]); const int s = u.r * 256 + row;
                if (s < n) { const int a = p.list_tok[(size_t)u.e * T + s]; tv[k] = NCU == 2 ? a / TOPK : a; if (NCU == 2) wv[k] = p.list_w[(size_t)u.e * T + s]; }
            } else wv[k] = 1.0f;
        }
    }
#pragma unroll
    for (int k = 0; k < NI; ++k) { const int i = 2 * k + h; mt[i * 256 + row] = tv[k]; if (NCU == 2) mw[i * 256 + row] = wv[k]; }
    __syncthreads();
}
struct Epi5 {
    static constexpr int PERM = 1; static constexpr bool F8 = true;
    const LAS float* mw; unsigned char* __restrict__ act;
    __device__ __forceinline__ void operator()(const f32x4 (&acc)[2][2][4][2], const Unit& u, int wr, int wc, int fr, int fq) const {
        int col8 = wc * 32 + fq * 8, rit = wr * 64 + fr;
        asm volatile("" : "+v"(col8), "+v"(rit));
        float w[2][4];
#pragma unroll
        for (int ai = 0; ai < 2; ++ai)
#pragma unroll
            for (int m = 0; m < 4; ++m) w[ai][m] = mw[u.i * 256 + ai * HALF + m * 16 + rit] * (ASCALE8 / (WSCALE8 * WSCALE8));
        unsigned char* ob = act + ((size_t)u.a0 + rit) * DE + u.pn * 128 + col8;
#pragma unroll
        for (int ai = 0; ai < 2; ++ai)
#pragma unroll
            for (int m = 0; m < 4; ++m) {
                float o[2][4];
#pragma unroll
                for (int n = 0; n < 2; ++n)
#pragma unroll
                    for (int j = 0; j < 4; ++j) { const float g = acc[ai][0][m][n][j], uu = acc[ai][1][m][n][j]; o[n][j] = __builtin_amdgcn_fmed3f(g * __builtin_amdgcn_rcpf(1.0f + __builtin_amdgcn_exp2f(g * (-1.4426950408889634f / WSCALE8))) * uu * w[ai][m], -448.0f, 448.0f); }
                *(u32x2*)(ob + (size_t)(ai * HALF + m * 16) * DE) = (u32x2){pk_fp8x4(o[0][0], o[0][1], o[0][2], o[0][3]), pk_fp8x4(o[1][0], o[1][1], o[1][2], o[1][3])};
            }
    }
};
constexpr float YSCALE = 16.0f;
struct Epi6 {
    static constexpr int PERM = 2; static constexpr bool F8 = true;
    const LAS int* mtok; unsigned char* __restrict__ yrows; const bf16_t* __restrict__ h1; bf16_t* __restrict__ base;
    __device__ __forceinline__ void operator()(const f32x4 (&acc)[2][2][4][2], const Unit& u, int wr, int wc, int fr, int fq) const {
        int col16 = wc * 64 + fq * 16, rit = wr * 64 + fr;
        asm volatile("" : "+v"(col16), "+v"(rit));
        if (u.e >= 0) {
            int aid[2][4];
#pragma unroll
            for (int ai = 0; ai < 2; ++ai)
#pragma unroll
                for (int m = 0; m < 4; ++m) aid[ai][m] = mtok[u.i * 256 + ai * HALF + m * 16 + rit];
#pragma unroll
            for (int ai = 0; ai < 2; ++ai)
#pragma unroll
                for (int m = 0; m < 4; ++m) {
                    if (aid[ai][m] < 0) continue;
                    int wd[4];
#pragma unroll
                    for (int bj = 0; bj < 2; ++bj) {
                        const f32x4 v0 = acc[ai][bj][m][0] * (YSCALE / (ASCALE8 * WSCALE8)), v1 = acc[ai][bj][m][1] * (YSCALE / (ASCALE8 * WSCALE8));
                        int w0 = 0, w1 = 0;
                        w0 = __builtin_amdgcn_cvt_pk_fp8_f32(v0[0], v0[1], w0, false); w0 = __builtin_amdgcn_cvt_pk_fp8_f32(v0[2], v0[3], w0, true);
                        w1 = __builtin_amdgcn_cvt_pk_fp8_f32(v1[0], v1[1], w1, false); w1 = __builtin_amdgcn_cvt_pk_fp8_f32(v1[2], v1[3], w1, true);
                        wd[2 * bj] = w0; wd[2 * bj + 1] = w1;
                    }
                    *(u32x4*)(yrows + (size_t)aid[ai][m] * D + u.pn * 256 + col16) = (u32x4){(unsigned)wd[0], (unsigned)wd[1], (unsigned)wd[2], (unsigned)wd[3]};
                }
        } else {
            const size_t tok0 = (size_t)u.pm * 256 + rit;
            const int c0 = u.pn * 256 + col16;
#pragma unroll
            for (int ai = 0; ai < 2; ++ai) {
                u32x4 hv[4][2];
#pragma unroll
                for (int m = 0; m < 4; ++m)
#pragma unroll
                    for (int bj = 0; bj < 2; ++bj) hv[m][bj] = *(const u32x4*)(h1 + (tok0 + ai * HALF + m * 16) * D + c0 + bj * 8);
#pragma unroll
                for (int m = 0; m < 4; ++m)
#pragma unroll
                    for (int bj = 0; bj < 2; ++bj) {
                        const u32x4 h = hv[m][bj]; const f32x4 v0 = acc[ai][bj][m][0] * (1.0f / (ASCALE8 * WSCALE8)), v1 = acc[ai][bj][m][1] * (1.0f / (ASCALE8 * WSCALE8));
                        u32x4 w;
                        w.x = cvt_pk_bf16(v0[0] + ALPHA * __uint_as_float(h.x << 16), v0[1] + ALPHA * __uint_as_float(h.x & 0xffff0000u));
                        w.y = cvt_pk_bf16(v0[2] + ALPHA * __uint_as_float(h.y << 16), v0[3] + ALPHA * __uint_as_float(h.y & 0xffff0000u));
                        w.z = cvt_pk_bf16(v1[0] + ALPHA * __uint_as_float(h.z << 16), v1[1] + ALPHA * __uint_as_float(h.z & 0xffff0000u));
                        w.w = cvt_pk_bf16(v1[2] + ALPHA * __uint_as_float(h.w << 16), v1[3] + ALPHA * __uint_as_float(h.w & 0xffff0000u));
                        *(u32x4*)(base + (tok0 + ai * HALF + m * 16) * D + c0 + bj * 8) = w;
                    }
                asm volatile("" ::: "memory");
            }
        }
    }
};
__device__ __forceinline__ void phase5(const Params& p, LAS unsigned char* lds) {
    moe_table(p, lds);
    const LAS int* tb = (const LAS int*)(lds + STAGE_BYTES); const LAS int* ce = tb + 80;
    const LAS int* mtok = (const LAS int*)(lds + MOE_META_OFF);
    SchedMoe<2> S{(int)gridDim.x, (int)blockIdx.x, tb, ce, mtok, (long long)((const char*)p.Bt_sgu - (const char*)p.Bt_gu), (long long)512 * D, D};
    moe_meta<2>(p, lds, S);
    Epi5 E{(const LAS float*)(mtok + MOE_MAXU * 256), p.act};
    gemm_phase(lds, p.h1q, p.Bt_gu, D, S, E);
}
__device__ __forceinline__ void phase6(const Params& p, LAS unsigned char* lds) {
    moe_table(p, lds);
    const LAS int* tb = (const LAS int*)(lds + STAGE_BYTES); const LAS int* ce = tb + 80;
    const LAS int* mtok = (const LAS int*)(lds + MOE_META_OFF);
    SchedMoe<4> S{(int)gridDim.x, (int)blockIdx.x, tb, ce, mtok, (long long)((const char*)p.Bt_sd - (const char*)p.Bt_d), (long long)D * DE, DE};
    moe_meta<4>(p, lds, S);
    Epi6 E{mtok, p.yrows, p.h1, p.base};
    gemm_phase(lds, p.act, p.Bt_d, DE, S, E);
}
__device__ __forceinline__ void phase7(const Params& p) {
    const int tid7 = tid_opaque(); const int wv = tid7 >> 6, lane = tid7 & 63;
    const int c0 = lane * 16;
    f32x4 g[4], b[4];
#pragma unroll
    for (int q = 0; q < 4; ++q) { g[q] = *(const f32x4*)(p.ln2_g + c0 + q * 4); b[q] = *(const f32x4*)(p.ln2_b + c0 + q * 4); }
    u32x4 nb0, nb1, ny[TOPK];
    {
        const int tok = blockIdx.x * 8 + wv;
        nb0 = *(const u32x4*)(p.base + (size_t)tok * D + c0); nb1 = *(const u32x4*)(p.base + (size_t)tok * D + c0 + 8);
#pragma unroll
        for (int k = 0; k < TOPK; ++k) ny[k] = *(const u32x4*)(p.yrows + ((size_t)tok * TOPK + k) * D + c0);
    }
    for (int tok = blockIdx.x * 8 + wv; tok < T; tok += gridDim.x * 8) {
        const u32x4 b0 = nb0, b1 = nb1;
        u32x4 y[TOPK];
#pragma unroll
        for (int k = 0; k < TOPK; ++k) y[k] = ny[k];
        {
            const int tn = tok + (int)gridDim.x * 8 < T ? tok + (int)gridDim.x * 8 : tok;
            nb0 = *(const u32x4*)(p.base + (size_t)tn * D + c0); nb1 = *(const u32x4*)(p.base + (size_t)tn * D + c0 + 8);
#pragma unroll
            for (int k = 0; k < TOPK; ++k) ny[k] = *(const u32x4*)(p.yrows + ((size_t)tn * TOPK + k) * D + c0);
        }
        float r[16];
#pragma unroll
        for (int q = 0; q < 16; ++q) r[q] = 0.f;
#pragma unroll
        for (int k = 0; k < TOPK; ++k)
#pragma unroll
            for (int q = 0; q < 4; ++q) {
                const int wd = (int)y[k][q];
                const auto lo = __builtin_amdgcn_cvt_pk_f32_fp8(wd, false); const auto hi = __builtin_amdgcn_cvt_pk_f32_fp8(wd, true);
                r[q * 4 + 0] += lo[0]; r[q * 4 + 1] += lo[1]; r[q * 4 + 2] += hi[0]; r[q * 4 + 3] += hi[1];
            }
        float v[16];
#pragma unroll
        for (int q = 0; q < 4; ++q) {
            const unsigned w0 = q < 2 ? b0[q * 2] : b1[(q - 2) * 2], w1 = q < 2 ? b0[q * 2 + 1] : b1[(q - 2) * 2 + 1];
            v[q * 4 + 0] = __uint_as_float(w0 << 16) + r[q * 4 + 0] * (1.0f / YSCALE); v[q * 4 + 1] = __uint_as_float(w0 & 0xffff0000u) + r[q * 4 + 1] * (1.0f / YSCALE);
            v[q * 4 + 2] = __uint_as_float(w1 << 16) + r[q * 4 + 2] * (1.0f / YSCALE); v[q * 4 + 3] = __uint_as_float(w1 & 0xffff0000u) + r[q * 4 + 3] * (1.0f / YSCALE);
        }
        float s = 0.f;
#pragma unroll
        for (int q = 0; q < 16; ++q) s += v[q];
        const float mean = wave_sum(s) * (1.0f / D);
        float qq = 0.f;
#pragma unroll
        for (int q = 0; q < 16; ++q) { const float d = v[q] - mean; qq += d * d; }
        const float rstd = rsqrtf(wave_sum(qq) * (1.0f / D) + 1e-5f);
#pragma unroll
        for (int q = 0; q < 4; ++q) {
            f32x4 o;
#pragma unroll
            for (int j = 0; j < 4; ++j) o[j] = (v[q * 4 + j] - mean) * rstd * g[q][j] + b[q][j];
            *(f32x4*)(p.out + (size_t)tok * D + c0 + q * 4) = o;
        }
    }
}

typedef float f32x16 __attribute__((ext_vector_type(16)));
#define CROW(i, h) (((i) & 3) + 8 * ((i) >> 2) + 4 * (h))
__device__ __forceinline__ f32x16 mfma32(bf16x8 a, bf16x8 b, f32x16 c) { return __builtin_amdgcn_mfma_f32_32x32x16_bf16(a, b, c, 0, 0, 0); }
__device__ __forceinline__ bf16_t f2bf_fast(float f) { return (bf16_t)(cvt_pk_bf16(f, f) & 0xffffu); }
__device__ __forceinline__ void unpack8(const u32x4 v, float (&o)[8]) {
    o[0] = __uint_as_float(v.x << 16); o[1] = __uint_as_float(v.x & 0xffff0000u); o[2] = __uint_as_float(v.y << 16); o[3] = __uint_as_float(v.y & 0xffff0000u);
    o[4] = __uint_as_float(v.z << 16); o[5] = __uint_as_float(v.z & 0xffff0000u); o[6] = __uint_as_float(v.w << 16); o[7] = __uint_as_float(v.w & 0xffff0000u);
}
__device__ __forceinline__ void lru_chain(const Params& p, LAS unsigned char* lds, const int b, const int n, const bool dry = false) {
    constexpr int WSTR = 272, XSTR = 272;
    LAS unsigned char* WA = lds;
    LAS unsigned char* WX = lds + 128 * WSTR;
    LAS unsigned char* XC = lds + 2 * 128 * WSTR;
    LAS unsigned char* O2 = XC + 64 * XSTR;
    LAS float* CW = (LAS float*)(O2 + 64 * 256);
    LAS float* LSA = CW + 640;
    LAS float* LSU = LSA + 256;
    LAS float* CAR = LSU + 256;
    const int tid = threadIdx.x, w = __builtin_amdgcn_readfirstlane(tid >> 6), lane = tid & 63, r = lane & 31, h = lane >> 5, tau = w & 1, q4 = w >> 1;
    const int CB = n * 128;
    for (int i = tid; i < 128 * 16; i += NTHR) {
        const int row = i >> 4, pc = i & 15;
        *(LAS u32x4*)(WA + row * WSTR + pc * 16) = *(const u32x4*)(p.Bt_wa + ((size_t)n * 128 + row) * 128 + pc * 8);
        *(LAS u32x4*)(WX + row * WSTR + pc * 16) = *(const u32x4*)(p.Bt_wx + ((size_t)n * 128 + row) * 128 + pc * 8);
    }
    for (int i = tid; i < 640; i += NTHR) { const int j = i >> 7, c = i & 127; CW[i] = j < 4 ? p.conv_w[j * D + CB + c] : p.conv_b[CB + c]; }
    if (tid < 256) CAR[tid] = 0.f;
    const int dcol = CB + q4 * 32 + r;
    const float bav = p.lru_ba[dcol], bxv = p.lru_bx[dcol];
    const float c2 = -8.0f * log1pf(expf(-p.lru_lam[dcol])) * 1.4426950408889634f;
    const int cg = tid & 15, tg = tid >> 4, crow = tid >> 3, cseg = (tid & 7) * 16;
    u32x4 lx[5]; u32x4 g2[2];
    auto prefetch_lx = [&](int c) {
#pragma unroll
        for (int j = 0; j < 5; ++j) { int pos = c * 64 + 2 * tg - 3 + j; pos = pos < 0 ? 0 : pos; lx[j] = *(const u32x4*)(p.LX + ((size_t)b * LP + pos) * D + CB + cg * 8); }
    };
    auto prefetch_g2 = [&](int c) {
        const size_t R0 = (size_t)b * LP + c * 64;
        g2[0] = *(const u32x4*)(p.G2 + (R0 + crow) * D + CB + cseg); g2[1] = *(const u32x4*)(p.G2 + (R0 + crow) * D + CB + cseg + 8);
    };
    prefetch_lx(0); prefetch_g2(0);
    __syncthreads();
    for (int c = 0; c < NCH; ++c) {
        const size_t R0 = (size_t)b * LP + c * 64; const int par = c & 1;
        {
            float x[5][8];
#pragma unroll
            for (int j = 0; j < 5; ++j) { unpack8(lx[j], x[j]);
                if (c == 0 && 2 * tg - 3 + j < PADR) {
#pragma unroll
                    for (int e = 0; e < 8; ++e) x[j][e] = 0.f; } }
            float cw[5][8];
#pragma unroll
            for (int j = 0; j < 5; ++j) { const f32x4 a = *(const LAS f32x4*)(CW + j * 128 + cg * 8), bq = *(const LAS f32x4*)(CW + j * 128 + cg * 8 + 4);
                cw[j][0] = a[0]; cw[j][1] = a[1]; cw[j][2] = a[2]; cw[j][3] = a[3]; cw[j][4] = bq[0]; cw[j][5] = bq[1]; cw[j][6] = bq[2]; cw[j][7] = bq[3]; }
#pragma unroll
            for (int rr = 0; rr < 2; ++rr) {
                float y[8];
#pragma unroll
                for (int e = 0; e < 8; ++e) y[e] = __builtin_fmaf(cw[3][e], x[rr + 3][e], __builtin_fmaf(cw[2][e], x[rr + 2][e], __builtin_fmaf(cw[1][e], x[rr + 1][e], __builtin_fmaf(cw[0][e], x[rr][e], cw[4][e]))));
                u32x4 o; o.x = cvt_pk_bf16(y[0], y[1]); o.y = cvt_pk_bf16(y[2], y[3]); o.z = cvt_pk_bf16(y[4], y[5]); o.w = cvt_pk_bf16(y[6], y[7]);
                *(LAS u32x4*)(XC + (2 * tg + rr) * XSTR + cg * 16) = o;
            }
        }
        __syncthreads();
        prefetch_lx(c + 1 < NCH ? c + 1 : c);
        f32x16 Rg, Ig;
#pragma unroll
        for (int i = 0; i < 16; ++i) { Rg[i] = 0.f; Ig[i] = 0.f; }
#pragma unroll
        for (int ks = 0; ks < 8; ++ks) {
            const bf16x8 a = *(const LAS bf16x8*)(XC + (32 * tau + r) * XSTR + (16 * ks + 8 * h) * 2);
            const bf16x8 ba = *(const LAS bf16x8*)(WA + (32 * q4 + r) * WSTR + (16 * ks + 8 * h) * 2);
            const bf16x8 bx = *(const LAS bf16x8*)(WX + (32 * q4 + r) * WSTR + (16 * ks + 8 * h) * 2);
            Rg = mfma32(a, ba, Rg); Ig = mfma32(a, bx, Ig);
        }
        float av[16], uv[16];
#pragma unroll
        for (int i = 0; i < 16; ++i) {
            const int tl = 32 * tau + CROW(i, h);
            const float xcv = bf2f(*(const LAS bf16_t*)(XC + tl * XSTR + (32 * q4 + r) * 2));
            const float rr = fast_sigmoid(Rg[i] + bav), ii = fast_sigmoid(Ig[i] + bxv);
            float a = __builtin_amdgcn_exp2f(rr * c2);
            float u = __builtin_amdgcn_sqrtf(fmaxf(1.0f - a * a, 0.f)) * ii * xcv;
            if (c == 0 && tl < PADR) { a = 1.0f; u = 0.f; }
            av[i] = a; uv[i] = u;
        }
        float gA[4], gU[4];
#pragma unroll
        for (int g = 0; g < 4; ++g) {
            float cA = 1.0f, hl = 0.f;
#pragma unroll
            for (int j = 0; j < 4; ++j) { hl = av[4 * g + j] * hl + uv[4 * g + j]; cA *= av[4 * g + j]; av[4 * g + j] = cA; uv[4 * g + j] = hl; }
            gA[g] = cA; gU[g] = hl;
        }
        float rA = 1.0f, rU = 0.f;
#pragma unroll
        for (int g = 0; g < 4; ++g) {
            const float pA = __shfl_xor(gA[g], 32), pU = __shfl_xor(gU[g], 32);
            const float fA = h ? pA : gA[g], fU = h ? pU : gU[g];
            const float sA = h ? gA[g] : pA, sU = h ? gU[g] : pU;
            const float r1U = fA * rU + fU, r1A = fA * rA;
            const float stA = h ? r1A : rA, stU = h ? r1U : rU;
            rU = sA * r1U + sU; rA = sA * r1A;
#pragma unroll
            for (int j = 0; j < 4; ++j) { const float ca = av[4 * g + j]; uv[4 * g + j] = ca * stU + uv[4 * g + j]; av[4 * g + j] = ca * stA; }
        }
        if (tau == 0 && h == 0) { LSA[par * 128 + 32 * q4 + r] = rA; LSU[par * 128 + 32 * q4 + r] = rU; }
        __syncthreads();
        {
            const float cin = CAR[par * 128 + 32 * q4 + r];
            float hin = cin;
            if (tau == 1) { hin = LSA[par * 128 + 32 * q4 + r] * cin + LSU[par * 128 + 32 * q4 + r]; if (h == 0) CAR[(par ^ 1) * 128 + 32 * q4 + r] = rA * hin + rU; }
#pragma unroll
            for (int i = 0; i < 16; ++i) {
                const int tl = 32 * tau + CROW(i, h);
                *(LAS bf16_t*)(O2 + tl * 256 + (32 * q4 + r) * 2) = f2bf_fast(av[i] * hin + uv[i]);
            }
        }
        __syncthreads();
        {
            const u32x4 h0 = *(const LAS u32x4*)(O2 + crow * 256 + cseg * 2), h1 = *(const LAS u32x4*)(O2 + crow * 256 + cseg * 2 + 16);
            float hh[8], gg[8]; u32x4 o0, o1;
            unpack8(h0, hh); unpack8(g2[0], gg);
            o0.x = cvt_pk_bf16(hh[0] * gg[0], hh[1] * gg[1]); o0.y = cvt_pk_bf16(hh[2] * gg[2], hh[3] * gg[3]); o0.z = cvt_pk_bf16(hh[4] * gg[4], hh[5] * gg[5]); o0.w = cvt_pk_bf16(hh[6] * gg[6], hh[7] * gg[7]);
            unpack8(h1, hh); unpack8(g2[1], gg);
            o1.x = cvt_pk_bf16(hh[0] * gg[0], hh[1] * gg[1]); o1.y = cvt_pk_bf16(hh[2] * gg[2], hh[3] * gg[3]); o1.z = cvt_pk_bf16(hh[4] * gg[4], hh[5] * gg[5]); o1.w = cvt_pk_bf16(hh[6] * gg[6], hh[7] * gg[7]);
            if (!dry) { *(u32x4*)(p.G2 + (R0 + crow) * D + CB + cseg) = o0; *(u32x4*)(p.G2 + (R0 + crow) * D + CB + cseg + 8) = o1; }
            prefetch_g2(c + 1 < NCH ? c + 1 : 0);
        }
    }
    __syncthreads();
}
__device__ __forceinline__ void hgrn_chain(const Params& p, LAS unsigned char* lds, const int b, const int hd, const bool dry = false) {
    constexpr int QSTR = 272, TSTR = 144;
    LAS unsigned char* Qi = lds;
    LAS unsigned char* Ki = Qi + 64 * QSTR;
    LAS unsigned char* Kt = Ki + 64 * QSTR;
    LAS unsigned char* Vt = Kt + 128 * TSTR;
    LAS unsigned char* St = Vt + 128 * TSTR;
    LAS unsigned char* Pi = St + 128 * QSTR;
    LAS unsigned char* O1 = Pi + 64 * TSTR;
    LAS float* Df = (LAS float*)(O1 + 64 * 256);
    LAS float* ssL = Df + 128;
    const int tid = threadIdx.x, w = __builtin_amdgcn_readfirstlane(tid >> 6), lane = tid & 63, r = lane & 31, h = lane >> 5, tau = w & 1, q4 = w >> 1;
    const int CB = hd * 128;
    for (int i = tid; i < 128 * QSTR / 16; i += NTHR) *(LAS u32x4*)(St + i * 16) = (u32x4){0u, 0u, 0u, 0u};
    if (tid < 64) ssL[tid] = 0.f;
    f32x16 Sacc[2];
#pragma unroll
    for (int i2 = 0; i2 < 2; ++i2)
#pragma unroll
        for (int i = 0; i < 16; ++i) Sacc[i2][i] = 0.f;
    const float ngv = p.hg_ng[q4 * 32 + r];
    const int crow = tid >> 3, cseg = (tid & 7) * 16;
    const int trow = lane, tseg = w * 16;
    u32x4 pq[2], pk[2], pv[2], pg[2], pz[2]; float pd = 0.f;
    auto prefetch = [&](int c) {
        const size_t R0 = (size_t)b * LP + c * 64;
        pq[0] = *(const u32x4*)(p.Qh + (R0 + crow) * D + CB + cseg); pq[1] = *(const u32x4*)(p.Qh + (R0 + crow) * D + CB + cseg + 8);
        pk[0] = *(const u32x4*)(p.Kh + (R0 + trow) * D + CB + tseg); pk[1] = *(const u32x4*)(p.Kh + (R0 + trow) * D + CB + tseg + 8);
        pv[0] = *(const u32x4*)(p.Vv + (R0 + trow) * D + CB + tseg); pv[1] = *(const u32x4*)(p.Vv + (R0 + trow) * D + CB + tseg + 8);
        pd = p.Dk[((size_t)b * NCH + c) * D + CB + (tid & 127)];
    };
    auto prefetch_g = [&](int c) {
        const size_t R0 = (size_t)b * LP + c * 64;
        pg[0] = *(const u32x4*)(p.G1 + (R0 + crow) * D + CB + cseg); pg[1] = *(const u32x4*)(p.G1 + (R0 + crow) * D + CB + cseg + 8);
        pz[0] = *(const u32x4*)(p.G2 + (R0 + crow) * D + CB + cseg); pz[1] = *(const u32x4*)(p.G2 + (R0 + crow) * D + CB + cseg + 8);
    };
    prefetch(0); prefetch_g(0);
    __syncthreads();
    for (int c = 0; c < NCH; ++c) {
        const size_t R0 = (size_t)b * LP + c * 64;
        *(LAS u32x4*)(Qi + crow * QSTR + cseg * 2) = pq[0]; *(LAS u32x4*)(Qi + crow * QSTR + cseg * 2 + 16) = pq[1];
        *(LAS u32x4*)(Ki + trow * QSTR + tseg * 2) = pk[0]; *(LAS u32x4*)(Ki + trow * QSTR + tseg * 2 + 16) = pk[1];
        {
            const unsigned kw[8] = {pk[0].x, pk[0].y, pk[0].z, pk[0].w, pk[1].x, pk[1].y, pk[1].z, pk[1].w};
            const unsigned vw[8] = {pv[0].x, pv[0].y, pv[0].z, pv[0].w, pv[1].x, pv[1].y, pv[1].z, pv[1].w};
#pragma unroll
            for (int e = 0; e < 8; ++e) {
                *(LAS bf16_t*)(Kt + (tseg + 2 * e) * TSTR + trow * 2) = (bf16_t)(kw[e] & 0xffffu); *(LAS bf16_t*)(Kt + (tseg + 2 * e + 1) * TSTR + trow * 2) = (bf16_t)(kw[e] >> 16);
                *(LAS bf16_t*)(Vt + (tseg + 2 * e) * TSTR + trow * 2) = (bf16_t)(vw[e] & 0xffffu); *(LAS bf16_t*)(Vt + (tseg + 2 * e + 1) * TSTR + trow * 2) = (bf16_t)(vw[e] >> 16);
            }
        }
        if (tid < 128) Df[tid] = pd;
        __syncthreads();
        prefetch(c + 1 < NCH ? c + 1 : c);
        if (w < 3) {
            const int tx = w ? 1 : 0, sx = w == 2 ? 1 : 0;
            f32x16 X;
#pragma unroll
            for (int i = 0; i < 16; ++i) X[i] = 0.f;
#pragma unroll
            for (int ks = 0; ks < 8; ++ks) {
                const bf16x8 a = *(const LAS bf16x8*)(Qi + (32 * tx + r) * QSTR + (16 * ks + 8 * h) * 2);
                const bf16x8 bb = *(const LAS bf16x8*)(Ki + (32 * sx + r) * QSTR + (16 * ks + 8 * h) * 2);
                X = mfma32(a, bb, X);
            }
#pragma unroll
            for (int i = 0; i < 16; ++i) {
                const int tl = CROW(i, h);
                const float v = (tx == sx && r > tl) ? 0.f : X[i];
                *(LAS bf16_t*)(Pi + (32 * tx + tl) * TSTR + (32 * sx + r) * 2) = f2bf_fast(v);
            }
        }
        __syncthreads();
        f32x16 O;
#pragma unroll
        for (int i = 0; i < 16; ++i) O[i] = 0.f;
        for (int ks = 0; ks < 2 * (tau + 1); ++ks) {
            const bf16x8 a = *(const LAS bf16x8*)(Pi + (32 * tau + r) * TSTR + (16 * ks + 8 * h) * 2);
            const bf16x8 bb = *(const LAS bf16x8*)(Vt + (32 * q4 + r) * TSTR + (16 * ks + 8 * h) * 2);
            O = mfma32(a, bb, O);
        }
#pragma unroll
        for (int ks = 0; ks < 8; ++ks) {
            const bf16x8 a = *(const LAS bf16x8*)(Qi + (32 * tau + r) * QSTR + (16 * ks + 8 * h) * 2);
            const bf16x8 bb = *(const LAS bf16x8*)(St + (32 * q4 + r) * QSTR + (16 * ks + 8 * h) * 2);
            O = mfma32(a, bb, O);
        }
        {
            float x[16];
#pragma unroll
            for (int i = 0; i < 16; ++i) x[i] = O[i] * O[i];
#pragma unroll
            for (int i = 0; i < 8; ++i) { const float snd = (lane & 16) ? x[i] : x[i + 8]; const float rcv = __shfl_xor(snd, 16); x[i] = ((lane & 16) ? x[i + 8] : x[i]) + rcv; }
#pragma unroll
            for (int i = 0; i < 4; ++i) { const float snd = (lane & 8) ? x[i] : x[i + 4]; const float rcv = __shfl_xor(snd, 8); x[i] = ((lane & 8) ? x[i + 4] : x[i]) + rcv; }
#pragma unroll
            for (int i = 0; i < 2; ++i) { const float snd = (lane & 4) ? x[i] : x[i + 2]; const float rcv = __shfl_xor(snd, 4); x[i] = ((lane & 4) ? x[i + 2] : x[i]) + rcv; }
            { const float snd = (lane & 2) ? x[0] : x[1]; const float rcv = __shfl_xor(snd, 2); x[0] = ((lane & 2) ? x[1] : x[0]) + rcv; }
            x[0] += __shfl_xor(x[0], 1);
            const int idx = ((lane >> 4) & 1) * 8 + ((lane >> 3) & 1) * 4 + ((lane >> 2) & 1) * 2 + ((lane >> 1) & 1);
            if ((lane & 1) == 0) __hip_atomic_fetch_add(ssL + 32 * tau + CROW(idx, h), x[0], __ATOMIC_RELAXED, __HIP_MEMORY_SCOPE_WORKGROUP);
        }
        __syncthreads();
#pragma unroll
        for (int g = 0; g < 4; ++g) {
            const f32x4 s4 = *(const LAS f32x4*)(ssL + 32 * tau + 8 * g + 4 * h);
#pragma unroll
            for (int j = 0; j < 4; ++j) {
                const float rt = rsqrtf(s4[j] * (1.0f / 128.0f) + 1e-6f);
                *(LAS bf16_t*)(O1 + (32 * tau + 8 * g + 4 * h + j) * 256 + (32 * q4 + r) * 2) = f2bf_fast(O[4 * g + j] * rt * ngv);
            }
        }
#pragma unroll
        for (int i2 = 0; i2 < 2; ++i2) {
            const int kap = 2 * tau + i2;
#pragma unroll
            for (int ks = 0; ks < 4; ++ks) {
                const bf16x8 a = *(const LAS bf16x8*)(Kt + (32 * kap + r) * TSTR + (16 * ks + 8 * h) * 2);
                const bf16x8 bb = *(const LAS bf16x8*)(Vt + (32 * q4 + r) * TSTR + (16 * ks + 8 * h) * 2);
                Sacc[i2] = mfma32(a, bb, Sacc[i2]);
            }
#pragma unroll
            for (int g = 0; g < 4; ++g) {
                const f32x4 d4 = *(const LAS f32x4*)(Df + 32 * kap + 8 * g + 4 * h);
#pragma unroll
                for (int j = 0; j < 4; ++j) Sacc[i2][4 * g + j] *= d4[j];
                *(LAS u32x2*)(St + (32 * q4 + r) * QSTR + (32 * kap + 8 * g + 4 * h) * 2) =
                    (u32x2){cvt_pk_bf16(Sacc[i2][4 * g], Sacc[i2][4 * g + 1]), cvt_pk_bf16(Sacc[i2][4 * g + 2], Sacc[i2][4 * g + 3])};
            }
        }
        __syncthreads();
        {
            if (tid < 64) ssL[tid] = 0.f;
            const u32x4 z0 = *(const LAS u32x4*)(O1 + crow * 256 + cseg * 2), z1 = *(const LAS u32x4*)(O1 + crow * 256 + cseg * 2 + 16);
            float oo[8], gg[8], zz[8]; u32x4 o0, o1;
            unpack8(z0, oo); unpack8(pg[0], gg); unpack8(pz[0], zz);
            o0.x = cvt_pk_bf16(oo[0] * gg[0] + zz[0], oo[1] * gg[1] + zz[1]); o0.y = cvt_pk_bf16(oo[2] * gg[2] + zz[2], oo[3] * gg[3] + zz[3]);
            o0.z = cvt_pk_bf16(oo[4] * gg[4] + zz[4], oo[5] * gg[5] + zz[5]); o0.w = cvt_pk_bf16(oo[6] * gg[6] + zz[6], oo[7] * gg[7] + zz[7]);
            unpack8(z1, oo); unpack8(pg[1], gg); unpack8(pz[1], zz);
            o1.x = cvt_pk_bf16(oo[0] * gg[0] + zz[0], oo[1] * gg[1] + zz[1]); o1.y = cvt_pk_bf16(oo[2] * gg[2] + zz[2], oo[3] * gg[3] + zz[3]);
            o1.z = cvt_pk_bf16(oo[4] * gg[4] + zz[4], oo[5] * gg[5] + zz[5]); o1.w = cvt_pk_bf16(oo[6] * gg[6] + zz[6], oo[7] * gg[7] + zz[7]);
            if (!dry) { *(u32x4*)(p.G1 + (R0 + crow) * D + CB + cseg) = o0; *(u32x4*)(p.G1 + (R0 + crow) * D + CB + cseg + 8) = o1; }
            prefetch_g(c + 1 < NCH ? c + 1 : 0);
        }
    }
    __syncthreads();
}
__device__ __forceinline__ f32x4 mfma16(bf16x8 a, bf16x8 b, f32x4 c) { return __builtin_amdgcn_mfma_f32_16x16x32_bf16(a, b, c, 0, 0, 0); }
__device__ __forceinline__ void unpack4(const u32x2 v, float (&o)[4]) {
    o[0] = __uint_as_float(v.x << 16); o[1] = __uint_as_float(v.x & 0xffff0000u); o[2] = __uint_as_float(v.y << 16); o[3] = __uint_as_float(v.y & 0xffff0000u);
}
typedef short v4i16 __attribute__((ext_vector_type(4)));
struct XStrip { const float* src; unsigned char* dst; int sld, dld, k0, n0, mode; };
__device__ __forceinline__ XStrip xstrip_decode(const Params& p, int sid) {
    XStrip s; const int j = sid >> 10, t = sid & 1023, e = t >> 4;
    if (j < 2) { s.src = (j ? p.we_up : p.we_gate) + (size_t)e * D * DE; s.sld = DE; s.k0 = (t & 15) * 64; s.n0 = 0; s.dst = p.Bt_gu + (size_t)e * 512 * D; s.dld = D; s.mode = j; }
    else { const int r = t & 15; s.src = p.we_down + (size_t)e * DE * D; s.sld = D; s.k0 = (r >> 2) * 64; s.n0 = (r & 3) * 256; s.dst = p.Bt_d + (size_t)e * D * DE; s.dld = DE; s.mode = 2; }
    return s;
}
__device__ __forceinline__ int xstrip_drow(int mode, int n) { return mode == 2 ? n : (n >> 7) * 256 + mode * 128 + (n & 127); }
__device__ __forceinline__ void bcast_rows(float x, float (&v)[4]) {
    const auto r = __builtin_amdgcn_permlane32_swap(__float_as_uint(x), __float_as_uint(x), false, false);
    const auto a = __builtin_amdgcn_permlane16_swap(r[0], r[0], false, false);
    const auto b = __builtin_amdgcn_permlane16_swap(r[1], r[1], false, false);
    v[0] = __uint_as_float(a[0]); v[1] = __uint_as_float(a[1]); v[2] = __uint_as_float(b[0]); v[3] = __uint_as_float(b[1]);
}
__device__ __forceinline__ void lru_chain_q(const Params& p, LAS unsigned char* lds, const int b, const int n, const int q, const bool dry = false, const bool do_strips = false) {
    constexpr int XSTR = 272;
    LAS unsigned char* XC = lds;
    LAS unsigned char* O2 = XC + 64 * XSTR;
    LAS float* CW = (LAS float*)(O2 + 64 * 64);
    LAS float* LSA = CW + 640;
    LAS float* LSU = LSA + 256;
    LAS float* CAR = LSU + 256;
    const int tid = tid_opaque(), w = __builtin_amdgcn_readfirstlane(tid >> 6), lane = tid & 63, c16 = lane & 15, qd = lane >> 4, tt = w >> 1, dh = w & 1;
    const int CB = n * 128;
    const int dl = 16 * dh + c16;
    const int dcol = CB + 32 * q + dl;
    for (int i = tid; i < 640; i += NTHR) { const int j = i >> 7, c = i & 127; CW[i] = j < 4 ? p.conv_w[j * D + CB + c] : p.conv_b[CB + c]; }
    if (tid < 64) CAR[tid] = 0.f;
    bf16x8 waf[4], wxf[4];
#pragma unroll
    for (int ks = 0; ks < 4; ++ks) {
        waf[ks] = *(const bf16x8*)(p.Bt_wa + ((size_t)n * 128 + 32 * q + dl) * 128 + 32 * ks + 8 * qd);
        wxf[ks] = *(const bf16x8*)(p.Bt_wx + ((size_t)n * 128 + 32 * q + dl) * 128 + 32 * ks + 8 * qd);
    }
    const float bav = p.lru_ba[dcol], bxv = p.lru_bx[dcol];
    const float c2 = -8.0f * log1pf(expf(-p.lru_lam[dcol])) * 1.4426950408889634f;
    const int cg = tid & 15, tg = tid >> 4, crow = tid >> 3, c4 = (tid & 7) * 4;
    u32x4 lx[5]; u32x2 g2;
    LAS float* TR = (LAS float*)(lds + 32768);
    f32x4 xa[4], xb[4];
#pragma unroll
    for (int t = 0; t < 4; ++t) { xa[t] = (f32x4){0.f, 0.f, 0.f, 0.f}; xb[t] = xa[t]; }
    auto prefetch_lx = [&](int c) {
#pragma unroll
        for (int j = 0; j < 5; ++j) { int pos = c * 64 + 2 * tg - 3 + j; pos = pos < 0 ? 0 : pos; lx[j] = *(const u32x4*)(p.LX + ((size_t)b * LP + pos) * D + CB + cg * 8); }
    };
    auto prefetch_g2 = [&](int c) { g2 = *(const u32x2*)(p.G2 + ((size_t)b * LP + c * 64 + crow) * D + CB + 32 * q + c4); };
    prefetch_lx(0); prefetch_g2(0);
    __syncthreads();
    float cw[5][8];
#pragma unroll
    for (int j = 0; j < 5; ++j) { const f32x4 a = *(const LAS f32x4*)(CW + j * 128 + cg * 8), bq = *(const LAS f32x4*)(CW + j * 128 + cg * 8 + 4);
        cw[j][0] = a[0]; cw[j][1] = a[1]; cw[j][2] = a[2]; cw[j][3] = a[3]; cw[j][4] = bq[0]; cw[j][5] = bq[1]; cw[j][6] = bq[2]; cw[j][7] = bq[3]; }
    for (int c = 0; c < NCH; ++c) {
        const size_t R0 = (size_t)b * LP + c * 64; const int par = c & 1;
        {
            float x[5][8];
#pragma unroll
            for (int j = 0; j < 5; ++j) { unpack8(lx[j], x[j]);
                if (c == 0 && 2 * tg - 3 + j < PADR) {
#pragma unroll
                    for (int e = 0; e < 8; ++e) x[j][e] = 0.f; } }
#pragma unroll
            for (int rr = 0; rr < 2; ++rr) {
                float y[8];
#pragma unroll
                for (int e = 0; e < 8; ++e) y[e] = __builtin_fmaf(cw[3][e], x[rr + 3][e], __builtin_fmaf(cw[2][e], x[rr + 2][e], __builtin_fmaf(cw[1][e], x[rr + 1][e], __builtin_fmaf(cw[0][e], x[rr][e], cw[4][e]))));
                u32x4 o; o.x = cvt_pk_bf16(y[0], y[1]); o.y = cvt_pk_bf16(y[2], y[3]); o.z = cvt_pk_bf16(y[4], y[5]); o.w = cvt_pk_bf16(y[6], y[7]);
                *(LAS u32x4*)(XC + (2 * tg + rr) * XSTR + cg * 16) = o;
            }
        }
        __syncthreads();
        prefetch_lx(c + 1 < NCH ? c + 1 : c);
        if (do_strips && c < 60) {
            const int ph = c % 5; const int sid = (int)blockIdx.x + 256 * (c / 5);
            if (ph == 0) {
                const XStrip s = xstrip_decode(p, sid); const int kr = tid >> 3, c8 = (tid & 7) * 8;
#pragma unroll
                for (int t = 0; t < 4; ++t) { const float* sp = s.src + (size_t)(s.k0 + kr) * s.sld + s.n0 + t * 64 + c8; xa[t] = *(const f32x4*)sp; xb[t] = *(const f32x4*)(sp + 4); }
            } else if (ph == 1) {
                const int kr = tid >> 3, c8 = (tid & 7) * 8;
#pragma unroll
                for (int t = 0; t < 4; ++t) { LAS float* wp = TR + t * (64 * 65) + kr * 65 + c8;
                    wp[0] = xa[t][0]; wp[1] = xa[t][1]; wp[2] = xa[t][2]; wp[3] = xa[t][3]; wp[4] = xb[t][0]; wp[5] = xb[t][1]; wp[6] = xb[t][2]; wp[7] = xb[t][3]; }
            } else if (ph == 2) {
                const XStrip s = xstrip_decode(p, sid); const int nr = tid >> 3, k8 = (tid & 7) * 8;
#pragma unroll
                for (int t = 0; t < 4; ++t) {
                    float v[8];
#pragma unroll
                    for (int i = 0; i < 8; ++i) v[i] = TR[t * (64 * 65) + (k8 + i) * 65 + nr];
                    *(u32x2*)(s.dst + (size_t)xstrip_drow(s.mode, s.n0 + t * 64 + nr) * s.dld + s.k0 + k8) =
                        (u32x2){pk_fp8x4(v[0] * WSCALE8, v[1] * WSCALE8, v[2] * WSCALE8, v[3] * WSCALE8), pk_fp8x4(v[4] * WSCALE8, v[5] * WSCALE8, v[6] * WSCALE8, v[7] * WSCALE8)};
                }
            }
        }
        f32x4 Rg = (f32x4){0.f, 0.f, 0.f, 0.f}, Ig = Rg;
#pragma unroll
        for (int ks = 0; ks < 4; ++ks) {
            const bf16x8 a = *(const LAS bf16x8*)(XC + (16 * tt + c16) * XSTR + (32 * ks + 8 * qd) * 2);
            Rg = mfma16(a, waf[ks], Rg); Ig = mfma16(a, wxf[ks], Ig);
        }
        float av[4], uv[4];
        float gA = 1.0f, gU = 0.f;
        const v4i16 xc4 = __builtin_amdgcn_ds_read_tr16_b64_v4i16((LAS v4i16*)(XC + (16 * tt + 4 * qd + (c16 >> 2)) * XSTR + (32 * q + 16 * dh + 4 * (c16 & 3)) * 2));
#pragma unroll
        for (int i = 0; i < 4; ++i) {
            const int tl = 16 * tt + 4 * qd + i;
            const float xcv = bf2f((bf16_t)xc4[i]);
            const float rr = fast_sigmoid(Rg[i] + bav), ii = fast_sigmoid(Ig[i] + bxv);
            float a = __builtin_amdgcn_exp2f(rr * c2);
            float u = __builtin_amdgcn_sqrtf(fmaxf(1.0f - a * a, 0.f)) * ii * xcv;
            if (c == 0 && tl < PADR) { a = 1.0f; u = 0.f; }
            gU = a * gU + u; gA *= a; av[i] = gA; uv[i] = gU;
        }
        float rA = 1.0f, rU = 0.f, stA = 1.0f, stU = 0.f;
        float Aq[4], Uq[4]; bcast_rows(gA, Aq); bcast_rows(gU, Uq);
#pragma unroll
        for (int j = 0; j < 4; ++j) {
            if (j == qd) { stA = rA; stU = rU; }
            rU = Aq[j] * rU + Uq[j]; rA = Aq[j] * rA;
        }
#pragma unroll
        for (int i = 0; i < 4; ++i) { const float ca = av[i]; uv[i] = ca * stU + uv[i]; av[i] = ca * stA; }
        if (qd == 0) { LSA[(par * 4 + tt) * 32 + dl] = rA; LSU[(par * 4 + tt) * 32 + dl] = rU; }
        __syncthreads();
        {
            float hin = CAR[par * 32 + dl];
#pragma unroll
            for (int t2 = 0; t2 < 3; ++t2) if (t2 < tt) hin = LSA[(par * 4 + t2) * 32 + dl] * hin + LSU[(par * 4 + t2) * 32 + dl];
            if (tt == 3 && qd == 0) CAR[(par ^ 1) * 32 + dl] = rA * hin + rU;
#pragma unroll
            for (int i = 0; i < 4; ++i) *(LAS bf16_t*)(O2 + (16 * tt + 4 * qd + i) * 64 + dl * 2) = f2bf_fast(av[i] * hin + uv[i]);
        }
        __syncthreads();
        {
            const u32x2 hh2 = *(const LAS u32x2*)(O2 + crow * 64 + c4 * 2);
            float hh[4], gg[4]; unpack4(hh2, hh); unpack4(g2, gg);
            if (!dry) *(u32x2*)(p.G2 + (R0 + crow) * D + CB + 32 * q + c4) = (u32x2){cvt_pk_bf16(hh[0] * gg[0], hh[1] * gg[1]), cvt_pk_bf16(hh[2] * gg[2], hh[3] * gg[3])};
            prefetch_g2(c + 1 < NCH ? c + 1 : 0);
        }
    }
    __syncthreads();
}
__device__ __forceinline__ bf16x8 tr_frag(const LAS unsigned char* img, const int stride, const int s0, const int col0, const int c16) {
    const LAS unsigned char* p0 = img + (s0 + (c16 >> 2)) * stride + (col0 + 4 * (c16 & 3)) * 2;
    const v4i16 lo = __builtin_amdgcn_ds_read_tr16_b64_v4i16((LAS v4i16*)p0);
    const v4i16 hi = __builtin_amdgcn_ds_read_tr16_b64_v4i16((LAS v4i16*)(p0 + 4 * stride));
    return __builtin_shufflevector(lo, hi, 0, 1, 2, 3, 4, 5, 6, 7);
}
__device__ __forceinline__ void hgrn_chain_q(const Params& p, LAS unsigned char* lds, const int b, const int hd, const int q, const bool dry = false, const unsigned tagbase = 0u, const int xflags = 0) {
    constexpr int QSTR = 272, TSTR = 144;
    LAS unsigned char* Qi = lds;
    LAS unsigned char* Ki = Qi + 64 * QSTR;
    constexpr int VSTR = 80;
    LAS unsigned char* Vi = Ki + 64 * QSTR;
    LAS unsigned char* St = Vi + 64 * VSTR;
    LAS unsigned char* Pi = St + 32 * QSTR;
    LAS unsigned char* O1 = Pi + 64 * TSTR;
    LAS float* Df = (LAS float*)(O1 + 2 * 64 * 64);
    LAS float* ssL = Df + 128;
    LAS float* ssO = ssL + 64;
    LAS float* rT = ssO + 128;
    const int tid = tid_opaque(), w = __builtin_amdgcn_readfirstlane(tid >> 6), lane = tid & 63, c16 = lane & 15, qd = lane >> 4, tt = w >> 1, vh = w & 1;
    const int CB = hd * 128, VB = CB + 32 * q;
    unsigned long long* xg = (unsigned long long*)p.xg + (size_t)(b * 8 + hd) * (4 * 4 * 64);
    for (int i = tid; i < 32 * QSTR / 16; i += NTHR) *(LAS u32x4*)(St + i * 16) = (u32x4){0u, 0u, 0u, 0u};
    for (int i = tid; i < 64 * TSTR / 16; i += NTHR) *(LAS u32x4*)(Pi + i * 16) = (u32x4){0u, 0u, 0u, 0u};
    if (tid < 64) ssL[tid] = 0.f;
    f32x4 Sacc[2];
    Sacc[0] = (f32x4){0.f, 0.f, 0.f, 0.f}; Sacc[1] = Sacc[0];
    const float ngv = p.hg_ng[32 * q + 16 * vh + c16];
    const int crow = tid >> 3, cseg = (tid & 7) * 16, c4 = (tid & 7) * 4;
    u32x4 pq[2], pk[2]; u32x2 pv, pg, pz; float pd = 0.f;
    auto prefetch = [&](int c) {
        const size_t R0 = (size_t)b * LP + c * 64;
        pq[0] = *(const u32x4*)(p.Qh + (R0 + crow) * D + CB + cseg); pq[1] = *(const u32x4*)(p.Qh + (R0 + crow) * D + CB + cseg + 8);
        pk[0] = *(const u32x4*)(p.Kh + (R0 + crow) * D + CB + cseg); pk[1] = *(const u32x4*)(p.Kh + (R0 + crow) * D + CB + cseg + 8);
        pv = *(const u32x2*)(p.Vv + (R0 + crow) * D + VB + c4);
        pd = p.Dk[((size_t)b * NCH + c) * D + CB + (tid & 127)];
    };
    auto fin_store = [&](int cf) {
        const size_t R = (size_t)b * LP + cf * 64 + crow;
        const u32x2 o2 = *(const LAS u32x2*)(O1 + ((cf & 1) * 64 + crow) * 64 + c4 * 2);
        float oo[4], gg[4], zz[4]; unpack4(o2, oo); unpack4(pg, gg); unpack4(pz, zz);
        const float rt = rT[crow];
        if (!dry) *(u32x2*)(p.G1 + R * D + VB + c4) = (u32x2){cvt_pk_bf16(oo[0] * rt * gg[0] + zz[0], oo[1] * rt * gg[1] + zz[1]), cvt_pk_bf16(oo[2] * rt * gg[2] + zz[2], oo[3] * rt * gg[3] + zz[3])};
    };
    auto fin_factors = [&](int cf, unsigned long long g0, unsigned long long g1, unsigned long long g2) {
        const unsigned tag = (unsigned)(cf + 1) + tagbase;
        unsigned spins = 0;
        while (!__all((unsigned)(g0 >> 32) == tag && (unsigned)(g1 >> 32) == tag && (unsigned)(g2 >> 32) == tag)) {
            if (++spins > (1u << 20)) break;
            __builtin_amdgcn_s_sleep(2);
            g0 = __hip_atomic_load(xg + (((q + 1) & 3) * 4 + (cf & 3)) * 64 + lane, __ATOMIC_RELAXED, __HIP_MEMORY_SCOPE_AGENT);
            g1 = __hip_atomic_load(xg + (((q + 2) & 3) * 4 + (cf & 3)) * 64 + lane, __ATOMIC_RELAXED, __HIP_MEMORY_SCOPE_AGENT);
            g2 = __hip_atomic_load(xg + (((q + 3) & 3) * 4 + (cf & 3)) * 64 + lane, __ATOMIC_RELAXED, __HIP_MEMORY_SCOPE_AGENT);
        }
        const float tot = ssO[(cf & 1) * 64 + lane] + __uint_as_float((unsigned)g0) + __uint_as_float((unsigned)g1) + __uint_as_float((unsigned)g2);
        rT[lane] = rsqrtf(tot * (1.0f / 128.0f) + 1e-6f);
    };
    prefetch(0);
    __syncthreads();
    for (int c = 0; c < NCH; ++c) {
        *(LAS u32x4*)(Qi + crow * QSTR + cseg * 2) = pq[0]; *(LAS u32x4*)(Qi + crow * QSTR + cseg * 2 + 16) = pq[1];
        *(LAS u32x4*)(Ki + crow * QSTR + cseg * 2) = pk[0]; *(LAS u32x4*)(Ki + crow * QSTR + cseg * 2 + 16) = pk[1];
        *(LAS u32x2*)(Vi + crow * VSTR + c4 * 2) = pv;
        if (tid < 128) Df[tid] = pd;
        __syncthreads();
        prefetch(c + 1 < NCH ? c + 1 : c);
        const int cf = c > 0 ? c - 1 : 0;
        {
            const size_t R = (size_t)b * LP + cf * 64 + crow;
            pg = *(const u32x2*)(p.G1 + R * D + VB + c4); pz = *(const u32x2*)(p.G2 + R * D + VB + c4);
        }
        unsigned long long g0 = 0ull, g1 = 0ull, g2 = 0ull;
        if (w == 7) {
            g0 = __hip_atomic_load(xg + (((q + 1) & 3) * 4 + (cf & 3)) * 64 + lane, __ATOMIC_RELAXED, __HIP_MEMORY_SCOPE_AGENT);
            g1 = __hip_atomic_load(xg + (((q + 2) & 3) * 4 + (cf & 3)) * 64 + lane, __ATOMIC_RELAXED, __HIP_MEMORY_SCOPE_AGENT);
            g2 = __hip_atomic_load(xg + (((q + 3) & 3) * 4 + (cf & 3)) * 64 + lane, __ATOMIC_RELAXED, __HIP_MEMORY_SCOPE_AGENT);
        }
        for (int ti = w; ti < 10; ti += 8) {
            const int pt = ti < 1 ? 0 : ti < 3 ? 1 : ti < 6 ? 2 : 3, ps = ti - (pt * (pt + 1)) / 2;
            f32x4 X = (f32x4){0.f, 0.f, 0.f, 0.f};
#pragma unroll
            for (int ks = 0; ks < 4; ++ks) {
                const bf16x8 a = *(const LAS bf16x8*)(Qi + (16 * pt + c16) * QSTR + (32 * ks + 8 * qd) * 2);
                const bf16x8 bb = *(const LAS bf16x8*)(Ki + (16 * ps + c16) * QSTR + (32 * ks + 8 * qd) * 2);
                X = mfma16(a, bb, X);
            }
            float xv[4];
#pragma unroll
            for (int i = 0; i < 4; ++i) xv[i] = (pt == ps && c16 > 4 * qd + i) ? 0.f : X[i];
            *(LAS u32x2*)(Pi + (16 * ps + c16) * TSTR + (16 * pt + 4 * qd) * 2) = (u32x2){cvt_pk_bf16(xv[0], xv[1]), cvt_pk_bf16(xv[2], xv[3])};
        }
        __syncthreads();
        {
            f32x4 O = (f32x4){0.f, 0.f, 0.f, 0.f};
            for (int ks = 0; ks < (tt + 2) / 2; ++ks) {
                const bf16x8 a = tr_frag(Pi, TSTR, 32 * ks + 8 * qd, 16 * tt, c16);
                const bf16x8 bb = tr_frag(Vi, VSTR, 32 * ks + 8 * qd, 16 * vh, c16);
                O = mfma16(a, bb, O);
            }
#pragma unroll
            for (int ks = 0; ks < 4; ++ks) {
                const bf16x8 a = *(const LAS bf16x8*)(Qi + (16 * tt + c16) * QSTR + (32 * ks + 8 * qd) * 2);
                const bf16x8 bb = *(const LAS bf16x8*)(St + (16 * vh + c16) * QSTR + (32 * ks + 8 * qd) * 2);
                O = mfma16(a, bb, O);
            }
#pragma unroll
            for (int i = 0; i < 4; ++i) {
                const float s = row16_incl_scan(O[i] * O[i]);
                if (c16 == 15) __hip_atomic_fetch_add(ssL + 16 * tt + 4 * qd + i, s, __ATOMIC_RELAXED, __HIP_MEMORY_SCOPE_WORKGROUP);
                *(LAS bf16_t*)(O1 + ((c & 1) * 64 + 16 * tt + 4 * qd + i) * 64 + (16 * vh + c16) * 2) = f2bf_fast(O[i] * ngv);
            }
            if (w == 7 && c > 0) fin_factors(cf, g0, g1, g2);
        }
        __syncthreads();
        if (w == 0) {
            const float s = ssL[lane];
            ssO[(c & 1) * 64 + lane] = s;
            __hip_atomic_store(xg + ((q * 4) + (c & 3)) * 64 + lane, ((unsigned long long)((unsigned)(c + 1) + tagbase) << 32) | (unsigned long long)__float_as_uint(s), __ATOMIC_RELAXED, __HIP_MEMORY_SCOPE_AGENT);
        }
#pragma unroll
        for (int i2 = 0; i2 < 2; ++i2) {
            const int kk = 2 * tt + i2;
#pragma unroll
            for (int ks = 0; ks < 2; ++ks) {
                const bf16x8 a = tr_frag(Ki, QSTR, 32 * ks + 8 * qd, 16 * kk, c16);
                const bf16x8 bb = tr_frag(Vi, VSTR, 32 * ks + 8 * qd, 16 * vh, c16);
                Sacc[i2] = mfma16(a, bb, Sacc[i2]);
            }
            const f32x4 d4 = *(const LAS f32x4*)(Df + 16 * kk + 4 * qd);
            Sacc[i2] = Sacc[i2] * d4;
            *(LAS u32x2*)(St + (16 * vh + c16) * QSTR + (16 * kk + 4 * qd) * 2) = (u32x2){cvt_pk_bf16(Sacc[i2][0], Sacc[i2][1]), cvt_pk_bf16(Sacc[i2][2], Sacc[i2][3])};
        }
        __syncthreads();
        if (tid < 64) ssL[tid] = 0.f;
        if (c > 0) fin_store(cf);
    }
    {
        const int cf = NCH - 1;
        const size_t R = (size_t)b * LP + cf * 64 + crow;
        pg = *(const u32x2*)(p.G1 + R * D + VB + c4); pz = *(const u32x2*)(p.G2 + R * D + VB + c4);
        __syncthreads();
        if (w == 7) {
            const unsigned long long g0 = __hip_atomic_load(xg + (((q + 1) & 3) * 4 + (cf & 3)) * 64 + lane, __ATOMIC_RELAXED, __HIP_MEMORY_SCOPE_AGENT);
            const unsigned long long g1 = __hip_atomic_load(xg + (((q + 2) & 3) * 4 + (cf & 3)) * 64 + lane, __ATOMIC_RELAXED, __HIP_MEMORY_SCOPE_AGENT);
            const unsigned long long g2 = __hip_atomic_load(xg + (((q + 3) & 3) * 4 + (cf & 3)) * 64 + lane, __ATOMIC_RELAXED, __HIP_MEMORY_SCOPE_AGENT);
            fin_factors(cf, g0, g1, g2);
        }
        __syncthreads();
        fin_store(cf);
    }
    __syncthreads();
}
__device__ __forceinline__ void phase2q(const Params& p, LAS unsigned char* lds) {
    const int bh = blockIdx.x & 63, q = blockIdx.x >> 6, b = bh >> 3, hd = bh & 7;
    const int nl = 1 + (p.flags & 15), nh = 1 + ((p.flags >> 4) & 15);
    for (int rep = 0; rep < nl; ++rep) lru_chain_q(p, lds, b, hd, q, rep > 0, rep == 0);
    asm volatile("s_waitcnt vmcnt(0)" ::: "memory");
    __syncthreads();
    if (threadIdx.x == 0) { __builtin_amdgcn_fence(__ATOMIC_ACQUIRE, "agent"); asm volatile("s_waitcnt vmcnt(0)" ::: "memory"); }
    __syncthreads();
    for (int rep = 0; rep < nh; ++rep) hgrn_chain_q(p, lds, b, hd, q, rep > 0, 1000u * rep, rep > 0 ? (p.flags >> 8) : 0);
}

__device__ __forceinline__ void phase2(const Params& p, LAS unsigned char* lds, const bool dry = false) {
    if (blockIdx.x >= NB * 8) return;
    const int b = blockIdx.x >> 3, hd = blockIdx.x & 7;
    lru_chain(p, lds, b, hd, dry);
    asm volatile("s_waitcnt vmcnt(0)" ::: "memory");
    __syncthreads();
    if (threadIdx.x == 0) { __builtin_amdgcn_fence(__ATOMIC_ACQUIRE, "agent"); asm volatile("s_waitcnt vmcnt(0)" ::: "memory"); }
    __syncthreads();
    hgrn_chain(p, lds, b, hd, dry);
}

__global__ __launch_bounds__(NTHR, 2) void k_mega(Params p) {
    extern __shared__ __attribute__((aligned(16))) unsigned char shm[];
    LAS unsigned char* lds = (LAS unsigned char*)shm;
    volatile LAS unsigned* xst = (volatile LAS unsigned*)(lds + LDS_BYTES - 16);
    if (threadIdx.x == 0) { xst[0] = 0u; xst[1] = 0u; }
    __syncthreads();
    (void)xcd_barrier_post(p.bar, xst);
#define XB_NOW() do { XcdBarrier xb_; xb_.bar = p.bar; xb_.x = xb_xcc_id(); xb_.st = (volatile LAS unsigned*)(lds + LDS_BYTES - 16); xcd_barrier(xb_); } while (0)
    phase_prep(p, lds);
    XB_NOW();
#if REPEAT_PHASE == 0
    phase_prep(p, lds); XB_NOW();
#endif
#if REPEAT_PHASE == 99
    XB_NOW(); XB_NOW(); XB_NOW(); XB_NOW();
#endif
    phase1(p, lds);
    XB_NOW();
#if REPEAT_PHASE == 1
    phase1(p, lds); XB_NOW();
#endif
    if (gridDim.x == 256) phase2q(p, lds); else phase2(p, lds);
    XB_NOW();
#if REPEAT_PHASE == 2
    phase2(p, lds, true); XB_NOW();
#endif
    phase3(p, lds);
    XB_NOW();
#if REPEAT_PHASE == 3
    phase3(p, lds); XB_NOW();
#endif
    phase4(p, lds);
    XB_NOW();
#if REPEAT_PHASE == 4
    if (blockIdx.x == 0 && threadIdx.x < 64) p.cnt[threadIdx.x * 64] = 0;
    XB_NOW(); phase4(p, lds); XB_NOW();
#endif
    phase5(p, lds);
    XB_NOW();
#if REPEAT_PHASE == 5
    phase5(p, lds); XB_NOW();
#endif
    phase6(p, lds);
    XB_NOW();
#if REPEAT_PHASE == 6
    phase6(p, lds); XB_NOW();
#endif
    phase7(p);
#if REPEAT_PHASE == 7
    XB_NOW(); phase7(p);
#endif
}

template <int PH> __global__ __launch_bounds__(NTHR, 2) void k_phase(Params p) {
    extern __shared__ __attribute__((aligned(16))) unsigned char shm[];
    LAS unsigned char* lds = (LAS unsigned char*)shm;
    if (PH == 0) phase_prep(p, lds);
    if (PH == 1) phase1(p, lds);
    if (PH == 3) phase3(p, lds);
    if (PH == 4) phase4(p, lds);
    if (PH == 5) phase5(p, lds);
    if (PH == 6) phase6(p, lds);
    if (PH == 7) phase7(p);
}

extern "C" void kernel_launch(void* const* d_in, const int* in_sizes, int n_in, void* d_out, int out_size, void* d_ws, size_t ws_size, hipStream_t stream) {
    Params p{};
#ifdef EXP_FLAGS
    p.flags = EXP_FLAGS;
#endif
    p.x = (const float*)d_in[0]; p.meta = (const float*)d_in[1]; p.ln_in_g = (const float*)d_in[2]; p.ln_in_b = (const float*)d_in[3];
    p.w_in = (const float*)d_in[4]; p.b_in = (const float*)d_in[5]; p.lbl = (const float*)d_in[6]; p.hg_ng = (const float*)d_in[7];
    p.conv_w = (const float*)d_in[8]; p.conv_b = (const float*)d_in[9]; p.lru_wa = (const float*)d_in[10]; p.lru_ba = (const float*)d_in[11];
    p.lru_wx = (const float*)d_in[12]; p.lru_bx = (const float*)d_in[13]; p.lru_lam = (const float*)d_in[14]; p.w_out = (const float*)d_in[15];
    p.ln1_g = (const float*)d_in[16]; p.ln1_b = (const float*)d_in[17]; p.router_w = (const float*)d_in[18]; p.router_b = (const float*)d_in[19];
    p.we_gate = (const float*)d_in[20]; p.we_up = (const float*)d_in[21]; p.we_down = (const float*)d_in[22];
    p.ws_gate = (const float*)d_in[23]; p.ws_up = (const float*)d_in[24]; p.ws_down = (const float*)d_in[25];
    p.ln2_g = (const float*)d_in[26]; p.ln2_b = (const float*)d_in[27];
    p.out = (float*)d_out;
    char* ws = (char*)d_ws;
    p.h0 = (bf16_t*)(ws + 0 * U); p.Qh = (bf16_t*)(ws + 1 * U); p.Kh = (bf16_t*)(ws + 2 * U); p.Vv = (bf16_t*)(ws + 3 * U);
    p.G1 = (bf16_t*)(ws + 4 * U); p.LX = (bf16_t*)(ws + 5 * U); p.G2 = (bf16_t*)(ws + 6 * U);
    char* misc = ws + 7 * U;
    const size_t MB = 1024 * 1024;
    p.Dk = (float*)misc;
    p.ridx = (int*)(misc + 9 * MB / 4);
    p.rwts = (float*)(misc + 13 * MB / 4);
    p.Bt_in = (bf16_t*)(misc + 17 * MB / 4);
    p.Bt_out = (bf16_t*)(misc + 81 * MB / 4);
    p.Bt_sgu = (unsigned char*)(misc + 89 * MB / 4);
    p.Bt_sd = (unsigned char*)(misc + 93 * MB / 4);
    p.Bt_wa = (bf16_t*)(misc + 95 * MB / 4);
    p.Bt_wx = (bf16_t*)(misc + 96 * MB / 4);
    p.Bt_r = (bf16_t*)(misc + 97 * MB / 4);
    p.bperm = (float*)(misc + 97 * MB / 4 + MB / 8);
    p.lb = (float*)(misc + 97 * MB / 4 + MB / 8 + 32768);
    p.act = (unsigned char*)ws; p.base = (bf16_t*)(ws + 2 * U); p.yrows = (unsigned char*)(ws + 4 * U);
    p.bar = (unsigned*)(misc + 43 * MB); p.xg = (unsigned long long*)(misc + 44 * MB);
    p.cnt = (int*)(misc + 25 * MB); p.list_tok = (int*)(misc + 26 * MB); p.list_w = (float*)(misc + 34 * MB);
    p.pre1 = (bf16_t*)(ws + 1 * U);
    p.h1 = (bf16_t*)(ws + 3 * U);
    p.Bt_gu = (unsigned char*)d_out;
    p.Bt_d = (unsigned char*)d_out + (size_t)NE * 512 * D;
    p.h1q = (unsigned char*)d_out + (size_t)NE * 512 * D + (size_t)NE * D * DE;

    static int grid_blocks = 0;
    if (!grid_blocks) {
        (void)hipFuncSetAttribute((const void*)k_mega, hipFuncAttributeMaxDynamicSharedMemorySize, LDS_BYTES);
        int dev = 0, cus = 0, per_cu = 0;
        (void)hipGetDevice(&dev);
        (void)hipDeviceGetAttribute(&cus, hipDeviceAttributeMultiprocessorCount, dev);
        (void)hipOccupancyMaxActiveBlocksPerMultiprocessor(&per_cu, (const void*)k_mega, NTHR, LDS_BYTES);
        if (per_cu > 1) per_cu = 1;
        grid_blocks = cus * per_cu;
    }
    (void)hipMemsetAsync(p.bar, 0, XCD_BAR_WORDS * 4, stream);
    void* args[] = {&p};
    hipError_t e = hipLaunchCooperativeKernel((const void*)k_mega, dim3(grid_blocks), dim3(NTHR), args, LDS_BYTES, stream);
    if (e != hipSuccess) fprintf(stderr, "cooperative launch failed: %s (grid %d)\n", hipGetErrorString(e), grid_blocks);
}
```

```cpp
#include <hip/hip_runtime.h>
#include <hip/hip_cooperative_groups.h>
#include <stdint.h>
#include <cstdio>
namespace cg = cooperative_groups;

typedef unsigned short bf16_t;
#ifndef REPEAT_PHASE
#define REPEAT_PHASE -1
#endif

constexpr int D = 1024;
constexpr int NB = 8;
constexpr int SEQ = 4096;
constexpr int LP = 4160;
constexpr int PADR = 48;
constexpr int TP = NB * LP;
constexpr int T = NB * SEQ;
constexpr int NCH = LP / 64;
constexpr int NE = 64, TOPK = 6, DE = 256;
constexpr float ALPHA = 1.189207115002721f;
constexpr size_t U = (size_t)TP * D * 2;

__device__ __forceinline__ float bf2f(bf16_t b) { return __uint_as_float(((unsigned)b) << 16); }
__device__ __forceinline__ bf16_t f2bf(float f) { unsigned u = __float_as_uint(f); u += 0x7FFFu + ((u >> 16) & 1u); return (bf16_t)(u >> 16); }
__device__ __forceinline__ float sigmoidf_(float x) { return 1.0f / (1.0f + __expf(-x)); }
__device__ __forceinline__ float siluf_(float x) { return x * sigmoidf_(x); }
__device__ __forceinline__ float gelu_tanh_(float x) { const float c = 0.7978845608028654f; float t = tanhf(c * (x + 0.044715f * x * x * x)); return 0.5f * x * (1.0f + t); }
__device__ __forceinline__ float wave_sum(float v) {
    v += __int_as_float(__builtin_amdgcn_update_dpp(0, __float_as_int(v), 0x111, 0xF, 0xF, false));
    v += __int_as_float(__builtin_amdgcn_update_dpp(0, __float_as_int(v), 0x112, 0xF, 0xF, false));
    v += __int_as_float(__builtin_amdgcn_update_dpp(0, __float_as_int(v), 0x114, 0xF, 0xF, false));
    v += __int_as_float(__builtin_amdgcn_update_dpp(0, __float_as_int(v), 0x118, 0xF, 0xF, false));
    v += __int_as_float(__builtin_amdgcn_update_dpp(0, __float_as_int(v), 0x142, 0xA, 0xF, false));
    v += __int_as_float(__builtin_amdgcn_update_dpp(0, __float_as_int(v), 0x143, 0xC, 0xF, false));
    return __int_as_float(__builtin_amdgcn_readlane(__float_as_int(v), 63));
}

#define LAS __attribute__((address_space(3)))
typedef short bf16x8 __attribute__((ext_vector_type(8)));
typedef float f32x4 __attribute__((ext_vector_type(4)));
typedef unsigned u32x4 __attribute__((ext_vector_type(4)));
typedef unsigned u32x2 __attribute__((ext_vector_type(2)));
typedef int v4i __attribute__((ext_vector_type(4)));
typedef int v8i __attribute__((ext_vector_type(8)));
typedef float f32x32 __attribute__((ext_vector_type(32)));
constexpr float WSCALE8 = 32.0f, ASCALE8 = 8.0f;
__device__ __forceinline__ v8i cat8(const short __attribute__((ext_vector_type(8))) lo, const short __attribute__((ext_vector_type(8))) hi) {
    const v4i a = __builtin_bit_cast(v4i, lo), b = __builtin_bit_cast(v4i, hi); return __builtin_shufflevector(a, b, 0, 1, 2, 3, 4, 5, 6, 7);
}
__device__ __forceinline__ unsigned pk_fp8x4(float a, float b, float c, float d) { int w = 0; w = __builtin_amdgcn_cvt_pk_fp8_f32(a, b, w, false); w = __builtin_amdgcn_cvt_pk_fp8_f32(c, d, w, true); return (unsigned)w; }
constexpr int BM = 256, BK = 64, HALF = 128, HTB = HALF * BK * 2, STAGE_BYTES = 8 * HTB, NXCD = 8, WGM = 16;
constexpr int NTHR = 512;
constexpr int LDS_BYTES = 160 * 1024;

struct Params {
    const float *x, *meta, *ln_in_g, *ln_in_b, *w_in, *b_in, *lbl, *hg_ng, *conv_w, *conv_b, *lru_wa, *lru_ba, *lru_wx, *lru_bx, *lru_lam, *w_out, *ln1_g, *ln1_b, *router_w, *router_b,
        *we_gate, *we_up, *we_down, *ws_gate, *ws_up, *ws_down, *ln2_g, *ln2_b;
    float* out;
    bf16_t *h0, *Qh, *Kh, *Vv, *G1, *LX, *G2;
    float* Dk; int* ridx; float* rwts;
    bf16_t* pre1; bf16_t* h1;
    bf16_t *Bt_in, *Bt_out, *Bt_wa, *Bt_wx, *Bt_r;
    unsigned char *Bt_gu, *Bt_d, *Bt_sgu, *Bt_sd, *h1q;
    float* bperm; float* lb;
    int* cnt; int* list_tok; float* list_w;
    unsigned char* act; bf16_t* base; unsigned char* yrows;
    unsigned* bar; unsigned long long* xg;
    int flags; int pad_;
};

__device__ __forceinline__ int lds_byte(int r, int c) { const int st = (r >> 4) * 2 + (c >> 5), rr = r & 15, cc = c & 31, ob = rr * 64 + cc * 2; return st * 1024 + (ob ^ (((ob >> 9) & 1) << 5)); }
__device__ __forceinline__ void stage_rc(int b, int& R, int& C) { const int st = b / 1024, sb = b % 1024, swz = sb ^ (((sb >> 9) & 1) << 5); R = (st >> 1) * 16 + swz / 64; C = (st & 1) * 32 + (swz % 64) / 2; }
__device__ __forceinline__ int perm32(int rho) { const int n = rho >> 4, i = rho & 15; return 8 * (i >> 2) + 4 * n + (i & 3); }
__device__ __forceinline__ unsigned cvt_pk_bf16(float lo, float hi) { unsigned r; asm volatile("v_cvt_pk_bf16_f32 %0, %1, %2" : "=v"(r) : "v"(lo), "v"(hi)); return r; }

__device__ __forceinline__ int tid_opaque() { int t = threadIdx.x; asm volatile("" : "+v"(t)); return t; }
struct Unit { int a0; long long boff; int pm; int pn; int e; int r; int i; };
__device__ __forceinline__ void tile_order(int L, int nM, int nN, int& pm, int& pn) {
    const int nwg = nM * nN; int wgid = L;
    { const int q = nwg / NXCD, r = nwg % NXCD, xcd = wgid % NXCD, off = wgid / NXCD; wgid = (xcd < r ? xcd * (q + 1) : r * (q + 1) + (xcd - r) * q) + off; }
    const int nig = WGM * nN, gid = wgid / nig, fm = gid * WGM, gsz = (nM - fm) < WGM ? (nM - fm) : WGM;
    pm = fm + ((wgid % nig) % gsz); pn = (wgid % nig) / gsz;
}

#define XB_TMO      128
#define XB_XCNT(j)  (256  + 64 * (j))
#define XB_XSUB(j)  (1280 + 64 * (j))
#define XB_XGEN(j)  (2304 + 64 * (j))
#define XB_TOP      3328
#define XB_TOPGEN   3392
#define XCD_BAR_WORDS 3456
#define XB_SPIN_CAP (1u << 22)
__device__ __forceinline__ unsigned xb_ld(unsigned* p) { return __hip_atomic_load(p, __ATOMIC_RELAXED, __HIP_MEMORY_SCOPE_AGENT); }
__device__ __forceinline__ unsigned xb_add(unsigned* p, unsigned v) { return __hip_atomic_fetch_add(p, v, __ATOMIC_RELAXED, __HIP_MEMORY_SCOPE_AGENT); }
__device__ __forceinline__ unsigned xb_xcc_id() { return (unsigned)__builtin_amdgcn_s_getreg((3 << 11) | 20) & 0xFu; }
#define XB_SPIN(cond, bar) do { unsigned _sp = 0; while (cond) { __builtin_amdgcn_s_sleep(1); \
    if ((++_sp & 255u) == 0u) { if (xb_ld(&(bar)[XB_TMO])) break; if (_sp > XB_SPIN_CAP) { atomicAdd(&(bar)[XB_TMO], 1u); break; } } } } while (0)
struct XcdBarrier { unsigned* bar; unsigned x; volatile LAS unsigned* st; };
__device__ __forceinline__ XcdBarrier xcd_barrier_post(unsigned* bar, volatile LAS unsigned* st) {
    XcdBarrier b; b.bar = bar; b.x = xb_xcc_id(); b.st = st;
    if (threadIdx.x == 0) (void)xb_add(&bar[XB_XCNT(b.x)], 1u);
    return b;
}
__device__ __forceinline__ void xcd_barrier_complete(unsigned* bar, unsigned x, unsigned& nloc, unsigned& nx) {
    const unsigned G = gridDim.x * gridDim.y * gridDim.z;
    unsigned sum, cnt, mine, sp = 0u;
    for (;;) {
        sum = 0u; cnt = 0u; mine = 0u;
#pragma unroll
        for (unsigned j = 0; j < 16; ++j) { const unsigned c = xb_ld(&bar[XB_XCNT(j)]); sum += c; cnt += (c > 0u) ? 1u : 0u; mine = (j == x) ? c : mine; }
        if (sum == G) break;
        __builtin_amdgcn_s_sleep(1);
        if ((++sp & 255u) == 0u) { if (xb_ld(&bar[XB_TMO])) break; if (sp > XB_SPIN_CAP) { atomicAdd(&bar[XB_TMO], 1u); break; } }
    }
    nloc = mine > 0u ? mine : 1u; nx = cnt > 0u ? cnt : 1u;
}
__device__ __forceinline__ void xcd_barrier(const XcdBarrier& b) {
    asm volatile("s_waitcnt vmcnt(0)" ::: "memory");
    __syncthreads();
    if (threadIdx.x == 0) {
        unsigned* bar = b.bar;
        __builtin_amdgcn_s_waitcnt(0);
        unsigned nloc = b.st[0], nx = b.st[1];
        if (nloc == 0u) { xcd_barrier_complete(bar, b.x, nloc, nx); b.st[0] = nloc; b.st[1] = nx; }
        const unsigned old = xb_add(&bar[XB_XSUB(b.x)], 1u);
        const unsigned gen = old / nloc;
        if (old + 1u == (gen + 1u) * nloc) {
            __builtin_amdgcn_fence(__ATOMIC_RELEASE, "agent");
            asm volatile("s_waitcnt vmcnt(0)" ::: "memory");
            const unsigned og = xb_add(&bar[XB_TOP], 1u);
            const unsigned tg = og / nx;
            if (og + 1u == (tg + 1u) * nx) xb_add(&bar[XB_TOPGEN], 1u);
            else XB_SPIN(xb_ld(&bar[XB_TOPGEN]) == tg, bar);
            __builtin_amdgcn_fence(__ATOMIC_ACQUIRE, "agent");
            xb_add(&bar[XB_XGEN(b.x)], 1u);
            asm volatile("s_waitcnt vmcnt(0)" ::: "memory");
        } else {
            XB_SPIN(xb_ld(&bar[XB_XGEN(b.x)]) == gen, bar);
            __builtin_amdgcn_fence(__ATOMIC_ACQUIRE, "agent");
            asm volatile("s_waitcnt vmcnt(0)" ::: "memory");
        }
    }
    __syncthreads();
}

template <class Epi, class Sched>
__device__ __forceinline__ void gemm_phase(LAS unsigned char* lds, const void* Abase, const void* Btbase, const int KB  , const Sched& S, const Epi& E) {
    const int tid = tid_opaque(), wid = __builtin_amdgcn_readfirstlane(tid >> 6), lane = tid & 63, wr = wid >> 2, wc = wid & 3, fr = lane & 15, fq = lane >> 4;
    const int nt = KB / (BK * 2);
    int Rr[2], Cc[2]; unsigned voffB0;
    { int R, C; stage_rc(tid * 16, R, C); Rr[0] = R; Rr[1] = R + 64; Cc[0] = C; Cc[1] = C;
        if (Epi::PERM == 2) {
            const int rb = 64 * (R >> 5) + 16 * ((R & 15) >> 2) + 4 * ((R >> 4) & 1) + (R & 3);
            voffB0 = (unsigned)(rb * KB + C * 2);
        } else {
            const int Rb = Epi::PERM ? ((R & ~31) + perm32(R & 31)) : R; voffB0 = (unsigned)(Rb * KB + C * 2);
        } }
    const size_t dBi = (size_t)(Epi::PERM == 2 ? 128 : 64) * KB, dBh = (size_t)(Epi::PERM == 2 ? 8 : HALF) * KB;
    const size_t kstep = (size_t)(BK * 2);
    const unsigned ldsw = (unsigned)wid * 1024u;
    const int aoff = lds_byte(wr * 64 + fr, fq * 8), boff = lds_byte(wc * 32 + fr, fq * 8);
#define G_SA(b, h) (((b) * 2 + (h)) * HTB)
#define G_SB(b, h) ((4 + (b) * 2 + (h)) * HTB)
#define G_STAGE(bufoff, gbase, voff) do { _Pragma("unroll") for (int _i = 0; _i < 2; ++_i) { unsigned _o = (voff)[_i]; asm volatile("" : "+v"(_o));     \
        __builtin_amdgcn_global_load_lds((const unsigned*)((const char*)(gbase) + _o), (LAS unsigned*)(lds + (bufoff) + ldsw + _i * 8192), 16, 0, 0); } } while (0)
#define G_STAGE_B(bufoff, gbase, h) do { _Pragma("unroll") for (int _i = 0; _i < 2; ++_i) { unsigned _o = voffB0; asm volatile("" : "+v"(_o)); \
        __builtin_amdgcn_global_load_lds((const unsigned*)((const char*)(gbase) + ((h) ? dBh : 0) + (_i ? dBi : 0) + _o), (LAS unsigned*)(lds + (bufoff) + ldsw + _i * 8192), 16, 0, 0); } } while (0)
#define G_LDA(dst, b, h) do { _Pragma("unroll") for (int m = 0; m < 4; ++m) _Pragma("unroll") for (int k = 0; k < 2; ++k) dst[m][k] = *(const LAS bf16x8*)(lds + G_SA(b, h) + aoff + m * 2048 + k * 1024); } while (0)
#define G_LDB(dst, b, h) do { _Pragma("unroll") for (int n = 0; n < 2; ++n) _Pragma("unroll") for (int k = 0; k < 2; ++k) dst[n][k] = *(const LAS bf16x8*)(lds + G_SB(b, h) + boff + n * 2048 + k * 1024); } while (0)
#define G_MMA(ai, bj, At, Bt) do { __builtin_amdgcn_s_setprio(1); _Pragma("unroll") for (int m = 0; m < 4; ++m) _Pragma("unroll") for (int n = 0; n < 2; ++n) { \
        if constexpr (Epi::F8) { f32x4 c_; _Pragma("unroll") for (int j = 0; j < 4; ++j) c_[j] = accv[ai][bj][(m * 2 + n) * 4 + j]; \
            c_ = __builtin_amdgcn_mfma_scale_f32_16x16x128_f8f6f4(cat8(Bt[n][0], Bt[n][1]), cat8(At[m][0], At[m][1]), c_, 0, 0, 0, 0, 0, 0); \
            _Pragma("unroll") for (int j = 0; j < 4; ++j) accv[ai][bj][(m * 2 + n) * 4 + j] = c_[j]; } \
        else { _Pragma("unroll") for (int k = 0; k < 2; ++k) acc[ai][bj][m][n] = __builtin_amdgcn_mfma_f32_16x16x32_bf16(Bt[n][k], At[m][k], acc[ai][bj][m][n], 0, 0, 0); } } \
        __builtin_amdgcn_s_setprio(0); } while (0)
#define G_WAIT_V(n) asm volatile("s_waitcnt vmcnt(" #n ")" ::: "memory")
#define G_WAIT_L(n) asm volatile("s_waitcnt lgkmcnt(" #n ")" ::: "memory")
#define G_BAR __builtin_amdgcn_s_barrier()
#define G_SCHED __builtin_amdgcn_sched_barrier(0)
    Unit cur, nxt; int ui = 0;
    if (!S.next(0, cur)) return;
    f32x4 acc[2][2][4][2];
    f32x32 accv[2][2];
#pragma unroll
    for (int a = 0; a < 2; ++a)
#pragma unroll
        for (int b = 0; b < 2; ++b)
#pragma unroll
            for (int j = 0; j < 32; ++j) accv[a][b][j] = 0.f;
#pragma unroll
    for (int a = 0; a < 2; ++a)
#pragma unroll
        for (int b = 0; b < 2; ++b)
#pragma unroll
            for (int m = 0; m < 4; ++m)
#pragma unroll
                for (int n = 0; n < 2; ++n) acc[a][b][m][n] = (f32x4){0.f, 0.f, 0.f, 0.f};
    bf16x8 At[4][2], B0[2][2], B1[2][2];
    unsigned vA0[2], vA1[2], vN0[2], vN1[2];
    S.a_off(cur, Rr, Cc, KB, vA0, vA1);
    const char* const cA = (const char*)Abase;
    const char* cB = (const char*)Btbase + cur.boff;
    G_STAGE_B(G_SB(0, 0), cB, 0); G_STAGE(G_SA(0, 0), cA, vA0); G_STAGE_B(G_SB(0, 1), cB, 1); G_STAGE(G_SA(0, 1), cA, vA1);
    if (wr == 1) G_BAR;
    G_WAIT_V(4); G_BAR;
    G_STAGE_B(G_SB(1, 0), cB + kstep, 0); G_STAGE(G_SA(1, 0), cA + kstep, vA0); G_STAGE_B(G_SB(1, 1), cB + kstep, 1);
    G_WAIT_V(6); G_BAR;
    for (;;) {
        const bool has_next = S.next(ui + 1, nxt);
        if (has_next) { S.a_off(nxt, Rr, Cc, KB, vN0, vN1); asm volatile("" : "+v"(vN0[0]), "+v"(vN0[1]), "+v"(vN1[0]), "+v"(vN1[1])); } else { vN0[0] = vA0[0]; vN0[1] = vA0[1]; vN1[0] = vA1[0]; vN1[1] = vA1[1]; }
        const char* nB = has_next ? (const char*)Btbase + nxt.boff : cB;
#pragma nounroll
        for (int t = 0; t < nt; t += 2) {
            const bool last = (t == nt - 2);
            const char* a1 = cA + (size_t)(t + 1) * kstep;
            const char* a2 = last ? cA : cA + (size_t)(t + 2) * kstep; const char* b2 = last ? nB : cB + (size_t)(t + 2) * kstep;
            const char* a3 = a2 + kstep; const char* b3 = b2 + kstep;
            unsigned w0[2], w1[2];
            w0[0] = last ? vN0[0] : vA0[0]; w0[1] = last ? vN0[1] : vA0[1]; w1[0] = last ? vN1[0] : vA1[0]; w1[1] = last ? vN1[1] : vA1[1];
            G_LDB(B0, 0, 0); G_SCHED; G_LDA(At, 0, 0); G_STAGE(G_SA(1, 1), a1, vA1);
            G_WAIT_L(8); G_BAR; G_WAIT_L(0); G_MMA(0, 0, At, B0); G_BAR; G_SCHED;
            G_LDB(B1, 0, 1); G_STAGE_B(G_SB(0, 0), b2, 0);
            G_BAR; G_WAIT_L(0); G_MMA(0, 1, At, B1); G_BAR;
            G_LDA(At, 0, 1); G_STAGE(G_SA(0, 0), a2, w0);
            G_BAR; G_WAIT_L(0); G_MMA(1, 0, At, B0); G_BAR; G_SCHED;
            G_STAGE_B(G_SB(0, 1), b2, 1);
            G_WAIT_V(6); G_BAR; G_MMA(1, 1, At, B1); G_BAR;
            G_LDB(B0, 1, 0); G_SCHED; G_LDA(At, 1, 0); G_STAGE(G_SA(0, 1), a2, w1);
            G_WAIT_L(8); G_BAR; G_WAIT_L(0); G_MMA(0, 0, At, B0); G_BAR; G_SCHED;
            G_LDB(B1, 1, 1); G_STAGE_B(G_SB(1, 0), b3, 0);
            G_BAR; G_WAIT_L(0); G_MMA(0, 1, At, B1); G_BAR;
            G_LDA(At, 1, 1); G_STAGE(G_SA(1, 0), a3, w0);
            G_BAR; G_WAIT_L(0); G_MMA(1, 0, At, B0); G_BAR; G_SCHED;
            G_STAGE_B(G_SB(1, 1), b3, 1);
            G_WAIT_V(6); G_BAR; G_MMA(1, 1, At, B1); G_BAR;
        }
        if constexpr (Epi::F8) {
#pragma unroll
            for (int a = 0; a < 2; ++a)
#pragma unroll
                for (int b = 0; b < 2; ++b)
#pragma unroll
                    for (int m = 0; m < 4; ++m)
#pragma unroll
                        for (int n = 0; n < 2; ++n)
#pragma unroll
                            for (int j = 0; j < 4; ++j) acc[a][b][m][n][j] = accv[a][b][(m * 2 + n) * 4 + j];
        }
        E(acc, cur, wr, wc, fr, fq);
        if (!has_next) break;
        if constexpr (Epi::F8) {
#pragma unroll
            for (int a = 0; a < 2; ++a)
#pragma unroll
                for (int b = 0; b < 2; ++b)
#pragma unroll
                    for (int j = 0; j < 32; ++j) accv[a][b][j] = 0.f;
        }
#pragma unroll
        for (int a = 0; a < 2; ++a)
#pragma unroll
            for (int b = 0; b < 2; ++b)
#pragma unroll
                for (int m = 0; m < 4; ++m)
#pragma unroll
                    for (int n = 0; n < 2; ++n) acc[a][b][m][n] = (f32x4){0.f, 0.f, 0.f, 0.f};
        cur = nxt; cB = nB; vA0[0] = vN0[0]; vA0[1] = vN0[1]; vA1[0] = vN1[0]; vA1[1] = vN1[1]; ++ui;
    }
    G_WAIT_V(0);
    if (wr == 0) G_BAR;
    G_BAR;
#undef G_SA
#undef G_SB
#undef G_STAGE
#undef G_STAGE_B
#undef G_LDA
#undef G_LDB
#undef G_MMA
#undef G_WAIT_V
#undef G_WAIT_L
#undef G_BAR
#undef G_SCHED
}

template <int NT, bool F8, class F>
__device__ __forceinline__ void transpose_strip(const float* __restrict__ src, int sld, int k0, int n0, void* __restrict__ dstv, int dld, F drow, LAS float* sm) {
    const int tid = threadIdx.x, kr = tid >> 3, c8 = (tid & 7) * 8;
    f32x4 a[NT], b[NT];
#pragma unroll
    for (int t = 0; t < NT; ++t) { a[t] = *(const f32x4*)(src + (size_t)(k0 + kr) * sld + n0 + t * 64 + c8); b[t] = *(const f32x4*)(src + (size_t)(k0 + kr) * sld + n0 + t * 64 + c8 + 4); }
#pragma unroll
    for (int t = 0; t < NT; ++t) {
        LAS float* w = sm + t * (64 * 65) + kr * 65 + c8;
        w[0] = a[t][0]; w[1] = a[t][1]; w[2] = a[t][2]; w[3] = a[t][3]; w[4] = b[t][0]; w[5] = b[t][1]; w[6] = b[t][2]; w[7] = b[t][3];
    }
    __syncthreads();
    const int nr = tid >> 3, k8 = (tid & 7) * 8;
#pragma unroll
    for (int t = 0; t < NT; ++t) {
        float v[8];
#pragma unroll
        for (int i = 0; i < 8; ++i) v[i] = sm[t * (64 * 65) + (k8 + i) * 65 + nr];
        if constexpr (F8) {
            *(u32x2*)((unsigned char*)dstv + (size_t)drow(n0 + t * 64 + nr) * dld + k0 + k8) =
                (u32x2){pk_fp8x4(v[0] * WSCALE8, v[1] * WSCALE8, v[2] * WSCALE8, v[3] * WSCALE8), pk_fp8x4(v[4] * WSCALE8, v[5] * WSCALE8, v[6] * WSCALE8, v[7] * WSCALE8)};
        } else {
            u32x4 o; o.x = cvt_pk_bf16(v[0], v[1]); o.y = cvt_pk_bf16(v[2], v[3]); o.z = cvt_pk_bf16(v[4], v[5]); o.w = cvt_pk_bf16(v[6], v[7]);
            *(u32x4*)((bf16_t*)dstv + (size_t)drow(n0 + t * 64 + nr) * dld + k0 + k8) = o;
        }
    }
    __syncthreads();
}
__device__ __forceinline__ int drow_in(int s) {
    const int sec = s >> 10, i = s & 1023, h = i >> 7, j = i & 127;
    switch (sec) {
        case 0: return h * 256 + j;
        case 1: return h * 256 + 128 + j;
        case 2: return (8 + (i >> 8)) * 256 + (i & 255);
        case 3: return (12 + h) * 256 + j;
        case 4: return (20 + (i >> 8)) * 256 + (i & 255);
        case 5: return (24 + h) * 256 + j;
        case 6: return (12 + h) * 256 + 128 + j;
        default: return (24 + h) * 256 + 128 + j;
    }
}
__device__ __forceinline__ void phase_prep(const Params& p, LAS unsigned char* lds) {
    LAS float* sm = (LAS float*)lds;
    const int nwg = gridDim.x, wg = blockIdx.x;
    constexpr int NT_TOTAL = 512 + 64 + 1024 * 3 + 16 * 3 + 16 * 2 + 16;
    const bool experts_here = gridDim.x != 256;
    for (int it = wg; it < NT_TOTAL; it += nwg) {
        int t = it;
        if (!experts_here && t >= 576 && t < 576 + 3072) continue;
        if (t < 512) { const int kt = t >> 5, ns = t & 31; transpose_strip<4, false>(p.w_in, 8192, kt * 64, ns * 256, p.Bt_in, 1024, [](int n) { return drow_in(n); }, sm); continue; }
        t -= 512;
        if (t < 64) { const int kt = t >> 2, ns = t & 3; transpose_strip<4, false>(p.w_out, 1024, kt * 64, ns * 256, p.Bt_out, 1024, [](int n) { return n; }, sm); continue; }
        t -= 64;
        if (t < 1024) { const int e = t >> 4, kt = t & 15; transpose_strip<4, true>(p.we_gate + (size_t)e * D * DE, DE, kt * 64, 0, p.Bt_gu + (size_t)e * 512 * D, D, [](int n) { return (n >> 7) * 256 + (n & 127); }, sm); continue; }
        t -= 1024;
        if (t < 1024) { const int e = t >> 4, kt = t & 15; transpose_strip<4, true>(p.we_up + (size_t)e * D * DE, DE, kt * 64, 0, p.Bt_gu + (size_t)e * 512 * D, D, [](int n) { return (n >> 7) * 256 + 128 + (n & 127); }, sm); continue; }
        t -= 1024;
        if (t < 1024) { const int e = t >> 4, r = t & 15, kt = r >> 2, ns = r & 3; transpose_strip<4, true>(p.we_down + (size_t)e * DE * D, D, kt * 64, ns * 256, p.Bt_d + (size_t)e * D * DE, DE, [](int n) { return n; }, sm); continue; }
        t -= 1024;
        if (t < 16) { transpose_strip<4, true>(p.ws_gate, DE, t * 64, 0, p.Bt_sgu, D, [](int n) { return (n >> 7) * 256 + (n & 127); }, sm); continue; }
        t -= 16;
        if (t < 16) { transpose_strip<4, true>(p.ws_up, DE, t * 64, 0, p.Bt_sgu, D, [](int n) { return (n >> 7) * 256 + 128 + (n & 127); }, sm); continue; }
        t -= 16;
        if (t < 16) { const int kt = t >> 2, ns = t & 3; transpose_strip<4, true>(p.ws_down, D, kt * 64, ns * 256, p.Bt_sd, DE, [](int n) { return n; }, sm); continue; }
        t -= 16;
        if (t < 16) { const int e = t >> 1, kt = t & 1; transpose_strip<2, false>(p.lru_wa + (size_t)e * 16384, 128, kt * 64, 0, p.Bt_wa + (size_t)e * 16384, 128, [](int n) { return n; }, sm); continue; }
        t -= 16;
        if (t < 16) { const int e = t >> 1, kt = t & 1; transpose_strip<2, false>(p.lru_wx + (size_t)e * 16384, 128, kt * 64, 0, p.Bt_wx + (size_t)e * 16384, 128, [](int n) { return n; }, sm); continue; }
        t -= 16;
        { transpose_strip<1, false>(p.router_w, NE, t * 64, 0, p.Bt_r, D, [](int n) { return n; }, sm); }
    }
    {
        const int wv = threadIdx.x >> 6, lane = threadIdx.x & 63;
        f32x4 g0v[4], b0v[4];
#pragma unroll
        for (int j = 0; j < 4; ++j) { g0v[j] = *(const f32x4*)(p.ln_in_g + j * 256 + lane * 4); b0v[j] = *(const f32x4*)(p.ln_in_b + j * 256 + lane * 4); }
        for (int it = wg; it < TP / 8; it += nwg) {
            const int row = it * 8 + wv;
            const int bb = row / LP, pos = row % LP;
            bf16_t* dst = p.h0 + (size_t)row * D;
            if (pos < PADR) {
#pragma unroll
                for (int j = 0; j < 4; ++j) *(u32x2*)(dst + j * 256 + lane * 4) = (u32x2){0u, 0u};
                continue;
            }
            const float* src = pos < 64 ? p.meta + (size_t)(pos - PADR) * D : p.x + ((size_t)bb * SEQ + (pos - 64)) * D;
            f32x4 v[4]; float s = 0.f;
#pragma unroll
            for (int j = 0; j < 4; ++j) { v[j] = *(const f32x4*)(src + j * 256 + lane * 4); s += (v[j][0] + v[j][1]) + (v[j][2] + v[j][3]); }
            const float mean = wave_sum(s) * (1.0f / D);
            float q = 0.f;
#pragma unroll
            for (int j = 0; j < 4; ++j) { const f32x4 d = v[j] - mean; q += (d[0] * d[0] + d[1] * d[1]) + (d[2] * d[2] + d[3] * d[3]); }
            const float rstd = rsqrtf(wave_sum(q) * (1.0f / D) + 1e-5f);
#pragma unroll
            for (int j = 0; j < 4; ++j) {
                const int c0 = j * 256 + lane * 4;
                const f32x4 o = (v[j] - mean) * rstd * g0v[j] + b0v[j];
                *(u32x2*)(dst + c0) = (u32x2){cvt_pk_bf16(o[0], o[1]), cvt_pk_bf16(o[2], o[3])};
            }
        }
    }
    { const int t0 = tid_opaque(); if (wg == 0 && t0 < 64) p.cnt[t0 * 64] = 0; }
    for (int i = wg * NTHR + threadIdx.x; i < 64 * 4 * 4 * 64; i += nwg * NTHR) p.xg[i] = 0ull;
    for (int s = wg * NTHR + threadIdx.x; s < 1024; s += nwg * NTHR) p.lb[s] = 1.0f / (1.0f + expf(p.lbl[D + s] - p.lbl[s]));
    for (int s = wg * NTHR + threadIdx.x; s < 8192; s += nwg * NTHR) p.bperm[drow_in(s)] = p.b_in[s];
}

struct Sched3 {
    int G, c;
    __device__ __forceinline__ bool next(int i, Unit& u) const {
        const int L = i * G + c; if (L >= 128 * 4) return false;
        int pm, pn; tile_order(L, 128, 4, pm, pn);
        u.pm = pm; u.pn = pn; u.a0 = (pm >> 4) * LP + 64 + (pm & 15) * 256; u.boff = (long long)pn * 256 * D * 2; u.e = 0; u.r = 0; u.i = i; return true;
    }
    __device__ __forceinline__ void a_off(const Unit& u, const int (&R)[2], const int (&C)[2], int KB, unsigned (&v0)[2], unsigned (&v1)[2]) const {
#pragma unroll
        for (int i = 0; i < 2; ++i) { v0[i] = (unsigned)((u.a0 + R[i]) * KB + C[i] * 2); v1[i] = (unsigned)((u.a0 + HALF + R[i]) * KB + C[i] * 2); }
    }
};
struct Epi3 {
    static constexpr int PERM = 1; static constexpr bool F8 = false;
    const bf16_t* __restrict__ h0; bf16_t* __restrict__ pre1;
    __device__ __forceinline__ void operator()(const f32x4 (&acc)[2][2][4][2], const Unit& u, int wr, int wc, int fr, int fq) const {
        int c0 = u.pn * 256 + wc * 32 + 8 * fq, rit = wr * 64 + fr;
        asm volatile("" : "+v"(c0), "+v"(rit));
        const bf16_t* hb = h0 + ((size_t)u.a0 + rit) * D + c0;
        bf16_t* pb = pre1 + ((size_t)u.pm * 256 + rit) * D + c0;
#pragma unroll
        for (int ai = 0; ai < 2; ++ai) {
            u32x4 hv[4][2];
#pragma unroll
            for (int m = 0; m < 4; ++m)
#pragma unroll
                for (int bj = 0; bj < 2; ++bj) hv[m][bj] = *(const u32x4*)(hb + (size_t)(ai * HALF + m * 16) * D + bj * HALF);
#pragma unroll
            for (int m = 0; m < 4; ++m)
#pragma unroll
                for (int bj = 0; bj < 2; ++bj) {
                    const u32x4 h = hv[m][bj]; const f32x4 v0 = acc[ai][bj][m][0], v1 = acc[ai][bj][m][1];
                    u32x4 w;
                    w.x = cvt_pk_bf16(v0[0] + ALPHA * __uint_as_float(h.x << 16), v0[1] + ALPHA * __uint_as_float(h.x & 0xffff0000u));
                    w.y = cvt_pk_bf16(v0[2] + ALPHA * __uint_as_float(h.y << 16), v0[3] + ALPHA * __uint_as_float(h.y & 0xffff0000u));
                    w.z = cvt_pk_bf16(v1[0] + ALPHA * __uint_as_float(h.z << 16), v1[1] + ALPHA * __uint_as_float(h.z & 0xffff0000u));
                    w.w = cvt_pk_bf16(v1[2] + ALPHA * __uint_as_float(h.w << 16), v1[3] + ALPHA * __uint_as_float(h.w & 0xffff0000u));
                    *(u32x4*)(pb + (size_t)(ai * HALF + m * 16) * D + bj * HALF) = w;
                }
            asm volatile("" ::: "memory");
        }
    }
};
__device__ __forceinline__ void phase3(const Params& p, LAS unsigned char* lds) {
    Sched3 S{(int)gridDim.x, (int)blockIdx.x}; Epi3 E{p.h0, p.pre1};
    gemm_phase(lds, p.G1, p.Bt_out, D * 2, S, E);
}

__device__ __forceinline__ float fast_sigmoid(float z) { return __builtin_amdgcn_rcpf(1.0f + __builtin_amdgcn_exp2f(-1.4426950408889634f * z)); }
template <int N> __device__ __forceinline__ float dpp_row_shr(float v) { return __int_as_float(__builtin_amdgcn_update_dpp(0, __float_as_int(v), 0x110 + N, 0xF, 0xF, false)); }
__device__ __forceinline__ float row16_incl_scan(float v) { v += dpp_row_shr<1>(v); v += dpp_row_shr<2>(v); v += dpp_row_shr<4>(v); v += dpp_row_shr<8>(v); return v; }
struct Sched1 {
    int G, c;
    __device__ __forceinline__ bool next(int i, Unit& u) const {
        const int L = i * G + c; if (L >= 130 * 32) return false;
        int pm, pn; tile_order(L, 130, 32, pm, pn);
        u.pm = pm; u.pn = pn; u.a0 = pm * 256; u.boff = (long long)pn * 256 * D * 2; u.e = 0; u.r = 0; u.i = i; return true;
    }
    __device__ __forceinline__ void a_off(const Unit& u, const int (&R)[2], const int (&C)[2], int KB, unsigned (&v0)[2], unsigned (&v1)[2]) const {
#pragma unroll
        for (int i = 0; i < 2; ++i) { v0[i] = (unsigned)((u.a0 + R[i]) * KB + C[i] * 2); v1[i] = (unsigned)((u.a0 + HALF + R[i]) * KB + C[i] * 2); }
    }
};
struct Epi1 {
    static constexpr int PERM = 1; static constexpr bool F8 = false;
    const LAS bf16_t* sbias; const LAS float* slb;
    bf16_t* __restrict__ Qh; bf16_t* __restrict__ Kh; bf16_t* __restrict__ Vv; bf16_t* __restrict__ G1; bf16_t* __restrict__ LX; bf16_t* __restrict__ G2; float* __restrict__ Dk;
    __device__ __forceinline__ void ld8(const LAS bf16_t* p, f32x4& lo, f32x4& hi) const {
        const u32x4 v = *(const LAS u32x4*)p;
        lo = (f32x4){__uint_as_float(v.x << 16), __uint_as_float(v.x & 0xffff0000u), __uint_as_float(v.y << 16), __uint_as_float(v.y & 0xffff0000u)};
        hi = (f32x4){__uint_as_float(v.z << 16), __uint_as_float(v.z & 0xffff0000u), __uint_as_float(v.w << 16), __uint_as_float(v.w & 0xffff0000u)};
    }
    __device__ __forceinline__ void operator()(const f32x4 (&acc)[2][2][4][2], const Unit& u, int wr, int wc, int fr, int fq) const {
        const int pn = u.pn, col8 = wc * 32 + fq * 8;
        const size_t row0 = (size_t)u.pm * 256 + wr * 64 + fr;
        if (pn < 8) {
            f32x4 bq0, bq1, bf0, bf1; ld8(sbias + pn * 256 + col8, bq0, bq1); ld8(sbias + pn * 256 + 128 + col8, bf0, bf1);
            const f32x4 lb0 = *(const LAS f32x4*)(slb + pn * 128 + col8), lb1 = *(const LAS f32x4*)(slb + pn * 128 + col8 + 4);
#pragma unroll
            for (int ai = 0; ai < 2; ++ai) {
                const int chunk = u.pm * 4 + ai * 2 + wr;
                const bool first = (chunk % NCH) == 0;
                float carry[2][4];
#pragma unroll
                for (int n = 0; n < 2; ++n)
#pragma unroll
                    for (int j = 0; j < 4; ++j) carry[n][j] = 0.f;
#pragma unroll
                for (int m = 0; m < 4; ++m) {
                    const bool pad = first && (m * 16 + fr < PADR);
                    float qo[2][4], ko[2][4];
#pragma unroll
                    for (int n = 0; n < 2; ++n)
#pragma unroll
                        for (int j = 0; j < 4; ++j) {
                            const float qv = acc[ai][0][m][n][j] + (n ? bq1[j] : bq0[j]);
                            const float z = acc[ai][1][m][n][j] + (n ? bf1[j] : bf0[j]);
                            const float lbv = n ? lb1[j] : lb0[j];
                            const float ez = 1.0f + __builtin_amdgcn_exp2f(-1.4426950408889634f * z), eq = 1.0f + __builtin_amdgcn_exp2f(-1.4426950408889634f * qv);
                            const float r = __builtin_amdgcn_rcpf(ez * eq);
                            const float f = lbv + (1.0f - lbv) * (r * eq);
                            const float l2 = (pad ? 0.f : __builtin_amdgcn_logf(f)) + (fr == 0 ? carry[n][j] : 0.f);
                            const float s = row16_incl_scan(l2);
                            carry[n][j] = __int_as_float(__builtin_amdgcn_update_dpp(0, __float_as_int(s), 0x121  , 0xF, 0xF, false));
                            qo[n][j] = qv * (r * ez) * __builtin_amdgcn_exp2f(s);
                            ko[n][j] = pad ? 0.f : (1.0f - f) * __builtin_amdgcn_exp2f(fminf(-s, 120.0f));
                        }
                    const size_t o = (row0 + ai * HALF + m * 16) * D + pn * 128 + col8;
                    u32x4 wq, wk;
                    wq.x = cvt_pk_bf16(qo[0][0], qo[0][1]); wq.y = cvt_pk_bf16(qo[0][2], qo[0][3]); wq.z = cvt_pk_bf16(qo[1][0], qo[1][1]); wq.w = cvt_pk_bf16(qo[1][2], qo[1][3]);
                    wk.x = cvt_pk_bf16(ko[0][0], ko[0][1]); wk.y = cvt_pk_bf16(ko[0][2], ko[0][3]); wk.z = cvt_pk_bf16(ko[1][0], ko[1][1]); wk.w = cvt_pk_bf16(ko[1][2], ko[1][3]);
                    *(u32x4*)(Qh + o) = wq; *(u32x4*)(Kh + o) = wk;
                }
                if (fr == 0) {
                    float* dp = Dk + (size_t)chunk * D + pn * 128 + col8;
                    *(f32x4*)dp = (f32x4){__builtin_amdgcn_exp2f(carry[0][0]), __builtin_amdgcn_exp2f(carry[0][1]), __builtin_amdgcn_exp2f(carry[0][2]), __builtin_amdgcn_exp2f(carry[0][3])};
                    *(f32x4*)(dp + 4) = (f32x4){__builtin_amdgcn_exp2f(carry[1][0]), __builtin_amdgcn_exp2f(carry[1][1]), __builtin_amdgcn_exp2f(carry[1][2]), __builtin_amdgcn_exp2f(carry[1][3])};
                }
            }
        } else if ((pn >= 8 && pn < 12) || (pn >= 20 && pn < 24)) {
            bf16_t* dst = pn < 12 ? Vv : LX; const int cb = (pn - (pn < 12 ? 8 : 20)) * 256;
#pragma unroll
            for (int bj = 0; bj < 2; ++bj) {
                f32x4 b0, b1; ld8(sbias + pn * 256 + bj * HALF + col8, b0, b1);
#pragma unroll
                for (int ai = 0; ai < 2; ++ai)
#pragma unroll
                    for (int m = 0; m < 4; ++m) {
                        const f32x4 v0 = acc[ai][bj][m][0] + b0, v1 = acc[ai][bj][m][1] + b1;
                        u32x4 w; w.x = cvt_pk_bf16(v0[0], v0[1]); w.y = cvt_pk_bf16(v0[2], v0[3]); w.z = cvt_pk_bf16(v1[0], v1[1]); w.w = cvt_pk_bf16(v1[2], v1[3]);
                        *(u32x4*)(dst + (row0 + ai * HALF + m * 16) * D + cb + bj * HALF + col8) = w;
                    }
            }
        } else {
            const bool is1 = pn < 20; bf16_t* dst = is1 ? G1 : G2; const int cb = (pn - (is1 ? 12 : 24)) * 128;
            f32x4 ba0, ba1, bg0, bg1; ld8(sbias + pn * 256 + col8, ba0, ba1); ld8(sbias + pn * 256 + 128 + col8, bg0, bg1);
#pragma unroll
            for (int ai = 0; ai < 2; ++ai)
#pragma unroll
                for (int m = 0; m < 4; ++m) {
                    float o[2][4];
#pragma unroll
                    for (int n = 0; n < 2; ++n)
#pragma unroll
                        for (int j = 0; j < 4; ++j) {
                            const float a = acc[ai][0][m][n][j] + (n ? ba1[j] : ba0[j]);
                            const float g = acc[ai][1][m][n][j] + (n ? bg1[j] : bg0[j]);
                            const float arg = is1 ? a : 1.5957691216057308f * (a + 0.044715f * a * a * a);
                            o[n][j] = a * __builtin_amdgcn_rcpf((1.0f + __builtin_amdgcn_exp2f(-1.4426950408889634f * arg)) * (1.0f + __builtin_amdgcn_exp2f(-1.4426950408889634f * g)));
                        }
                    u32x4 w; w.x = cvt_pk_bf16(o[0][0], o[0][1]); w.y = cvt_pk_bf16(o[0][2], o[0][3]); w.z = cvt_pk_bf16(o[1][0], o[1][1]); w.w = cvt_pk_bf16(o[1][2], o[1][3]);
                    *(u32x4*)(dst + (row0 + ai * HALF + m * 16) * D + cb + col8) = w;
                }
        }
    }
};
__device__ __forceinline__ void phase1(const Params& p, LAS unsigned char* lds) {
    LAS bf16_t* sbias = (LAS bf16_t*)(lds + STAGE_BYTES); LAS float* slb = (LAS float*)(lds + STAGE_BYTES + 16384);
    for (int i = threadIdx.x; i < 8192; i += NTHR) sbias[i] = f2bf(p.bperm[i]);
    for (int i = threadIdx.x; i < 1024; i += NTHR) slb[i] = p.lb[i];
    __syncthreads();
    Sched1 S{(int)gridDim.x, (int)blockIdx.x}; Epi1 E{sbias, slb, p.Qh, p.Kh, p.Vv, p.G1, p.LX, p.G2, p.Dk};
    gemm_phase(lds, p.h0, p.Bt_in, D * 2, S, E);
}

__device__ __forceinline__ void phase4(const Params& p, LAS unsigned char* lds) {
    constexpr int ASTR = 2064;
    LAS unsigned char* Aimg = lds;
    LAS float* sc = (LAS float*)(lds + 64 * ASTR);
    LAS int* asg_e = (LAS int*)(lds + 64 * ASTR + 16384);
    LAS float* asg_w = (LAS float*)(asg_e + 384);
    LAS int* asg_r = (LAS int*)(asg_w + 384);
    LAS int* cntL = asg_r + 384;
    LAS int* baseL = cntL + 64;
    const int tid = tid_opaque(), wv = tid >> 6, lane = tid & 63;
    bf16x8 rwf[16];
#pragma unroll
    for (int ks = 0; ks < 16; ++ks) rwf[ks] = *(const bf16x8*)(p.Bt_r + (size_t)((wv & 3) * 16 + (lane & 15)) * D + 512 * (wv >> 2) + 32 * ks + 8 * (lane >> 4));
    f32x4 g1v[4], b1v[4];
#pragma unroll
    for (int j = 0; j < 4; ++j) { g1v[j] = *(const f32x4*)(p.ln1_g + j * 256 + lane * 4); b1v[j] = *(const f32x4*)(p.ln1_b + j * 256 + lane * 4); }
    for (int tile = blockIdx.x; tile < T / 64; tile += gridDim.x) {
        if (tid < 64) cntL[tid] = 0;
        *(LAS f32x4*)(sc + tid * 8) = (f32x4){0.f, 0.f, 0.f, 0.f}; *(LAS f32x4*)(sc + tid * 8 + 4) = (f32x4){0.f, 0.f, 0.f, 0.f};
        u32x2 vn[4][4];
#pragma unroll
        for (int s = 0; s < 3; ++s)
#pragma unroll
            for (int j = 0; j < 4; ++j) vn[s][j] = *(const u32x2*)(p.pre1 + ((size_t)tile * 64 + wv * 8 + s) * D + j * 256 + lane * 4);
#pragma unroll
        for (int i = 0; i < 8; ++i) {
            const int tl = wv * 8 + i; const size_t tok = (size_t)tile * 64 + tl;
            f32x4 v[4]; float s = 0.f;
#pragma unroll
            for (int j = 0; j < 4; ++j) { const u32x2 x = vn[i & 3][j]; v[j] = (f32x4){__uint_as_float(x.x << 16), __uint_as_float(x.x & 0xffff0000u), __uint_as_float(x.y << 16), __uint_as_float(x.y & 0xffff0000u)}; s += (v[j][0] + v[j][1]) + (v[j][2] + v[j][3]); }
            if (i + 3 < 8) {
#pragma unroll
                for (int j = 0; j < 4; ++j) vn[(i + 3) & 3][j] = *(const u32x2*)(p.pre1 + (tok + 3) * D + j * 256 + lane * 4); }
            const float mean = wave_sum(s) * (1.0f / D);
            float q = 0.f;
#pragma unroll
            for (int j = 0; j < 4; ++j) { const f32x4 d = v[j] - mean; q += (d[0] * d[0] + d[1] * d[1]) + (d[2] * d[2] + d[3] * d[3]); }
            const float rstd = rsqrtf(wave_sum(q) * (1.0f / D) + 1e-5f);
#pragma unroll
            for (int j = 0; j < 4; ++j) {
                const int c0 = j * 256 + lane * 4;
                const f32x4 o = (v[j] - mean) * rstd * g1v[j] + b1v[j];
                const u32x2 w = (u32x2){cvt_pk_bf16(o[0], o[1]), cvt_pk_bf16(o[2], o[3])};
                *(u32x2*)(p.h1 + tok * D + c0) = w;
                *(unsigned*)(p.h1q + tok * D + c0) = pk_fp8x4(o[0], o[1], o[2], o[3]);
                *(LAS u32x2*)(Aimg + tl * ASTR + c0 * 2) = w;
            }
        }
        __syncthreads();
        {
            const int fr = lane & 15, fq = lane >> 4, nt = wv & 3, kh = wv >> 2;
            f32x4 ac[4];
#pragma unroll
            for (int mt = 0; mt < 4; ++mt) ac[mt] = (f32x4){0.f, 0.f, 0.f, 0.f};
#pragma unroll
            for (int ks = 0; ks < 16; ++ks)
#pragma unroll
                for (int mt = 0; mt < 4; ++mt) {
                    const bf16x8 a = *(const LAS bf16x8*)(Aimg + (mt * 16 + fr) * ASTR + (512 * kh + 32 * ks + 8 * fq) * 2);
                    ac[mt] = __builtin_amdgcn_mfma_f32_16x16x32_bf16(a, rwf[ks], ac[mt], 0, 0, 0);
                }
#pragma unroll
            for (int mt = 0; mt < 4; ++mt)
#pragma unroll
                for (int r = 0; r < 4; ++r) __hip_atomic_fetch_add(sc + (mt * 16 + fq * 4 + r) * 64 + nt * 16 + fr, ac[mt][r], __ATOMIC_RELAXED, __HIP_MEMORY_SCOPE_WORKGROUP);
        }
        __syncthreads();
        const float rb = p.router_b[lane];
        for (int i = 0; i < 8; ++i) {
            const int tl = wv * 8 + i; const size_t tok = (size_t)tile * 64 + tl;
            const float sg = fast_sigmoid(sc[tl * 64 + lane]);
            float sel = sg + rb; float ssum = 0.f; int my_e = 0; float my_s = 0.f;
#pragma unroll
            for (int kk = 0; kk < TOPK; ++kk) {
                const int NEG = (int)0xff800000u;
                float v = sel;
                v = fmaxf(v, __int_as_float(__builtin_amdgcn_update_dpp(NEG, __float_as_int(v), 0x111, 0xF, 0xF, false)));
                v = fmaxf(v, __int_as_float(__builtin_amdgcn_update_dpp(NEG, __float_as_int(v), 0x112, 0xF, 0xF, false)));
                v = fmaxf(v, __int_as_float(__builtin_amdgcn_update_dpp(NEG, __float_as_int(v), 0x114, 0xF, 0xF, false)));
                v = fmaxf(v, __int_as_float(__builtin_amdgcn_update_dpp(NEG, __float_as_int(v), 0x118, 0xF, 0xF, false)));
                v = fmaxf(v, __int_as_float(__builtin_amdgcn_update_dpp(NEG, __float_as_int(v), 0x142, 0xA, 0xF, false)));
                v = fmaxf(v, __int_as_float(__builtin_amdgcn_update_dpp(NEG, __float_as_int(v), 0x143, 0xC, 0xF, false)));
                const float mx = __int_as_float(__builtin_amdgcn_readlane(__float_as_int(v), 63));
                const unsigned long long mk = __ballot(sel == mx);
                const int bi = __builtin_amdgcn_readfirstlane((int)__builtin_ctzll(mk));
                const float ws = __int_as_float(__builtin_amdgcn_readlane(__float_as_int(sg), bi)); ssum += ws;
                if (lane == kk) { my_e = bi; my_s = ws; }
                if (lane == bi) sel = -3.0e38f;
            }
            if (lane < TOPK) {
                const float w = my_s / ssum * 2.5f;
                asg_e[tl * TOPK + lane] = my_e; asg_w[tl * TOPK + lane] = w;
                p.ridx[tok * TOPK + lane] = my_e; p.rwts[tok * TOPK + lane] = w;
            }
        }
        __syncthreads();
        if (tid < 384) asg_r[tid] = __hip_atomic_fetch_add(cntL + asg_e[tid], 1, __ATOMIC_RELAXED, __HIP_MEMORY_SCOPE_WORKGROUP);
        __syncthreads();
        if (tid < 64) { const int c = cntL[tid]; baseL[tid] = c ? __hip_atomic_fetch_add(p.cnt + tid * 64, c, __ATOMIC_RELAXED, __HIP_MEMORY_SCOPE_AGENT) : 0; }
        __syncthreads();
        if (tid < 384) { const int e = asg_e[tid]; const int slot = baseL[e] + asg_r[tid]; p.list_tok[(size_t)e * T + slot] = tile * 384 + tid; p.list_w[(size_t)e * T + slot] = asg_w[tid]; }
        __syncthreads();
    }
}

constexpr int ACT_S_ROW0 = 832 * 256;
__device__ __forceinline__ void moe_table(const Params& p, LAS unsigned char* lds) {
    LAS int* tb = (LAS int*)(lds + STAGE_BYTES); LAS int* ce = tb + 80;
    const int tm = tid_opaque();
    if (tm < 64) {
        const int lane = tm; const int c = p.cnt[lane * 64]; const int tl = (c + 255) >> 8;
        int s = tl;
#pragma unroll
        for (int o = 1; o < 64; o <<= 1) { const int t = __shfl_up(s, o); if (lane >= o) s += t; }
        tb[lane] = s - tl; ce[lane] = c; if (lane == 63) tb[64] = s;
    }
    __syncthreads();
}
template <int NCU  >
struct SchedMoe {
    int G, c; const LAS int* tb; const LAS int* ce; const LAS int* mtok; long long sh_boff; long long e_stride; int KB;
    __device__ __forceinline__ bool next(int i, Unit& u) const {
        const int NT = __builtin_amdgcn_readfirstlane(tb[64]); const int L = i * G + c;
        if (L >= NCU * NT + NCU * 128) return false;
        if (L < NCU * NT) {
            int t, j; tile_order(L, NT, NCU, t, j);
            int lane = threadIdx.x & 63; asm volatile("" : "+v"(lane));
            const unsigned long long mk = __ballot(tb[lane] <= t);
            const int e = __builtin_amdgcn_readfirstlane((int)__popcll(mk) - 1);
            const int tbe = __builtin_amdgcn_readfirstlane(tb[e]);
            u.i = i; u.e = e; u.r = t - tbe; u.pm = t; u.pn = j; u.a0 = t * 256; u.boff = (long long)e * e_stride + (long long)j * 256 * KB;
        } else {
            int pm, j; tile_order(L - NCU * NT, 128, NCU, pm, j);
            u.i = i; u.e = -1; u.r = 0; u.pm = pm; u.pn = j; u.a0 = ACT_S_ROW0 + pm * 256; u.boff = sh_boff + (long long)j * 256 * KB;
        }
        return true;
    }
    __device__ __forceinline__ void a_off(const Unit& u, const int (&R)[2], const int (&C)[2], int K_, unsigned (&v0)[2], unsigned (&v1)[2]) const {
        if (NCU == 4) {
#pragma unroll
            for (int i = 0; i < 2; ++i) { v0[i] = (unsigned)((u.a0 + R[i]) * K_ + C[i] * 2); v1[i] = (unsigned)((u.a0 + HALF + R[i]) * K_ + C[i] * 2); }
        } else if (u.e < 0) {
#pragma unroll
            for (int i = 0; i < 2; ++i) { v0[i] = (unsigned)((u.pm * 256 + R[i]) * K_ + C[i] * 2); v1[i] = (unsigned)((u.pm * 256 + HALF + R[i]) * K_ + C[i] * 2); }
        } else {
            const LAS int* mt = mtok + u.i * 256;
#pragma unroll
            for (int i = 0; i < 2; ++i) {
                const int t0 = mt[R[i]], t1 = mt[R[i] + HALF];
                v0[i] = (unsigned)(t0 * K_ + C[i] * 2); v1[i] = (unsigned)(t1 * K_ + C[i] * 2);
            }
        }
    }
};
constexpr int MOE_META_OFF = STAGE_BYTES + 1024, MOE_MAXU = 16;
template <int NCU>
__device__ __forceinline__ void moe_meta(const Params& p, LAS unsigned char* lds, const SchedMoe<NCU>& S) {
    LAS int* mt = (LAS int*)(lds + MOE_META_OFF); LAS float* mw = (LAS float*)(mt + MOE_MAXU * 256);
    const int tid = tid_opaque(), row = tid & 255, h = tid >> 8;
    constexpr int NI = MOE_MAXU / 2;
    int tv[NI]; float wv[NI];
#pragma unroll
    for (int k = 0; k < NI; ++k) {
        const int i = 2 * k + h; Unit u; tv[k] = NCU == 2 ? 0 : -1; wv[k] = 0.f;
        if (S.next(i, u)) {
            if (u.e >= 0) {
                const int n = __builtin_amdgcn_readfirstlane(S.ce[u.e]); const int s = u.r * 256 + row;
                if (s < n) { const int a = p.list_tok[(size_t)u.e * T + s]; tv[k] = NCU == 2 ? a / TOPK : a; if (NCU == 2) wv[k] = p.list_w[(size_t)u.e * T + s]; }
            } else wv[k] = 1.0f;
        }
    }
#pragma unroll
    for (int k = 0; k < NI; ++k) { const int i = 2 * k + h; mt[i * 256 + row] = tv[k]; if (NCU == 2) mw[i * 256 + row] = wv[k]; }
    __syncthreads();
}
struct Epi5 {
    static constexpr int PERM = 1; static constexpr bool F8 = true;
    const LAS float* mw; unsigned char* __restrict__ act;
    __device__ __forceinline__ void operator()(const f32x4 (&acc)[2][2][4][2], const Unit& u, int wr, int wc, int fr, int fq) const {
        int col8 = wc * 32 + fq * 8, rit = wr * 64 + fr;
        asm volatile("" : "+v"(col8), "+v"(rit));
        float w[2][4];
#pragma unroll
        for (int ai = 0; ai < 2; ++ai)
#pragma unroll
            for (int m = 0; m < 4; ++m) w[ai][m] = mw[u.i * 256 + ai * HALF + m * 16 + rit] * (ASCALE8 / (WSCALE8 * WSCALE8));
        unsigned char* ob = act + ((size_t)u.a0 + rit) * DE + u.pn * 128 + col8;
#pragma unroll
        for (int ai = 0; ai < 2; ++ai)
#pragma unroll
            for (int m = 0; m < 4; ++m) {
                float o[2][4];
#pragma unroll
                for (int n = 0; n < 2; ++n)
#pragma unroll
                    for (int j = 0; j < 4; ++j) { const float g = acc[ai][0][m][n][j], uu = acc[ai][1][m][n][j]; o[n][j] = __builtin_amdgcn_fmed3f(g * __builtin_amdgcn_rcpf(1.0f + __builtin_amdgcn_exp2f(g * (-1.4426950408889634f / WSCALE8))) * uu * w[ai][m], -448.0f, 448.0f); }
                *(u32x2*)(ob + (size_t)(ai * HALF + m * 16) * DE) = (u32x2){pk_fp8x4(o[0][0], o[0][1], o[0][2], o[0][3]), pk_fp8x4(o[1][0], o[1][1], o[1][2], o[1][3])};
            }
    }
};
constexpr float YSCALE = 16.0f;
struct Epi6 {
    static constexpr int PERM = 2; static constexpr bool F8 = true;
    const LAS int* mtok; unsigned char* __restrict__ yrows; const bf16_t* __restrict__ h1; bf16_t* __restrict__ base;
    __device__ __forceinline__ void operator()(const f32x4 (&acc)[2][2][4][2], const Unit& u, int wr, int wc, int fr, int fq) const {
        int col16 = wc * 64 + fq * 16, rit = wr * 64 + fr;
        asm volatile("" : "+v"(col16), "+v"(rit));
        if (u.e >= 0) {
            int aid[2][4];
#pragma unroll
            for (int ai = 0; ai < 2; ++ai)
#pragma unroll
                for (int m = 0; m < 4; ++m) aid[ai][m] = mtok[u.i * 256 + ai * HALF + m * 16 + rit];
#pragma unroll
            for (int ai = 0; ai < 2; ++ai)
#pragma unroll
                for (int m = 0; m < 4; ++m) {
                    if (aid[ai][m] < 0) continue;
                    int wd[4];
#pragma unroll
                    for (int bj = 0; bj < 2; ++bj) {
                        const f32x4 v0 = acc[ai][bj][m][0] * (YSCALE / (ASCALE8 * WSCALE8)), v1 = acc[ai][bj][m][1] * (YSCALE / (ASCALE8 * WSCALE8));
                        int w0 = 0, w1 = 0;
                        w0 = __builtin_amdgcn_cvt_pk_fp8_f32(v0[0], v0[1], w0, false); w0 = __builtin_amdgcn_cvt_pk_fp8_f32(v0[2], v0[3], w0, true);
                        w1 = __builtin_amdgcn_cvt_pk_fp8_f32(v1[0], v1[1], w1, false); w1 = __builtin_amdgcn_cvt_pk_fp8_f32(v1[2], v1[3], w1, true);
                        wd[2 * bj] = w0; wd[2 * bj + 1] = w1;
                    }
                    *(u32x4*)(yrows + (size_t)aid[ai][m] * D + u.pn * 256 + col16) = (u32x4){(unsigned)wd[0], (unsigned)wd[1], (unsigned)wd[2], (unsigned)wd[3]};
                }
        } else {
            const size_t tok0 = (size_t)u.pm * 256 + rit;
            const int c0 = u.pn * 256 + col16;
#pragma unroll
            for (int ai = 0; ai < 2; ++ai) {
                u32x4 hv[4][2];
#pragma unroll
                for (int m = 0; m < 4; ++m)
#pragma unroll
                    for (int bj = 0; bj < 2; ++bj) hv[m][bj] = *(const u32x4*)(h1 + (tok0 + ai * HALF + m * 16) * D + c0 + bj * 8);
#pragma unroll
                for (int m = 0; m < 4; ++m)
#pragma unroll
                    for (int bj = 0; bj < 2; ++bj) {
                        const u32x4 h = hv[m][bj]; const f32x4 v0 = acc[ai][bj][m][0] * (1.0f / (ASCALE8 * WSCALE8)), v1 = acc[ai][bj][m][1] * (1.0f / (ASCALE8 * WSCALE8));
                        u32x4 w;
                        w.x = cvt_pk_bf16(v0[0] + ALPHA * __uint_as_float(h.x << 16), v0[1] + ALPHA * __uint_as_float(h.x & 0xffff0000u));
                        w.y = cvt_pk_bf16(v0[2] + ALPHA * __uint_as_float(h.y << 16), v0[3] + ALPHA * __uint_as_float(h.y & 0xffff0000u));
                        w.z = cvt_pk_bf16(v1[0] + ALPHA * __uint_as_float(h.z << 16), v1[1] + ALPHA * __uint_as_float(h.z & 0xffff0000u));
                        w.w = cvt_pk_bf16(v1[2] + ALPHA * __uint_as_float(h.w << 16), v1[3] + ALPHA * __uint_as_float(h.w & 0xffff0000u));
                        *(u32x4*)(base + (tok0 + ai * HALF + m * 16) * D + c0 + bj * 8) = w;
                    }
                asm volatile("" ::: "memory");
            }
        }
    }
};
__device__ __forceinline__ void phase5(const Params& p, LAS unsigned char* lds) {
    moe_table(p, lds);
    const LAS int* tb = (const LAS int*)(lds + STAGE_BYTES); const LAS int* ce = tb + 80;
    const LAS int* mtok = (const LAS int*)(lds + MOE_META_OFF);
    SchedMoe<2> S{(int)gridDim.x, (int)blockIdx.x, tb, ce, mtok, (long long)((const char*)p.Bt_sgu - (const char*)p.Bt_gu), (long long)512 * D, D};
    moe_meta<2>(p, lds, S);
    Epi5 E{(const LAS float*)(mtok + MOE_MAXU * 256), p.act};
    gemm_phase(lds, p.h1q, p.Bt_gu, D, S, E);
}
__device__ __forceinline__ void phase6(const Params& p, LAS unsigned char* lds) {
    moe_table(p, lds);
    const LAS int* tb = (const LAS int*)(lds + STAGE_BYTES); const LAS int* ce = tb + 80;
    const LAS int* mtok = (const LAS int*)(lds + MOE_META_OFF);
    SchedMoe<4> S{(int)gridDim.x, (int)blockIdx.x, tb, ce, mtok, (long long)((const char*)p.Bt_sd - (const char*)p.Bt_d), (long long)D * DE, DE};
    moe_meta<4>(p, lds, S);
    Epi6 E{mtok, p.yrows, p.h1, p.base};
    gemm_phase(lds, p.act, p.Bt_d, DE, S, E);
}
__device__ __forceinline__ void phase7(const Params& p) {
    const int tid7 = tid_opaque(); const int wv = tid7 >> 6, lane = tid7 & 63;
    const int c0 = lane * 16;
    f32x4 g[4], b[4];
#pragma unroll
    for (int q = 0; q < 4; ++q) { g[q] = *(const f32x4*)(p.ln2_g + c0 + q * 4); b[q] = *(const f32x4*)(p.ln2_b + c0 + q * 4); }
    u32x4 nb0, nb1, ny[TOPK];
    {
        const int tok = blockIdx.x * 8 + wv;
        nb0 = *(const u32x4*)(p.base + (size_t)tok * D + c0); nb1 = *(const u32x4*)(p.base + (size_t)tok * D + c0 + 8);
#pragma unroll
        for (int k = 0; k < TOPK; ++k) ny[k] = *(const u32x4*)(p.yrows + ((size_t)tok * TOPK + k) * D + c0);
    }
    for (int tok = blockIdx.x * 8 + wv; tok < T; tok += gridDim.x * 8) {
        const u32x4 b0 = nb0, b1 = nb1;
        u32x4 y[TOPK];
#pragma unroll
        for (int k = 0; k < TOPK; ++k) y[k] = ny[k];
        {
            const int tn = tok + (int)gridDim.x * 8 < T ? tok + (int)gridDim.x * 8 : tok;
            nb0 = *(const u32x4*)(p.base + (size_t)tn * D + c0); nb1 = *(const u32x4*)(p.base + (size_t)tn * D + c0 + 8);
#pragma unroll
            for (int k = 0; k < TOPK; ++k) ny[k] = *(const u32x4*)(p.yrows + ((size_t)tn * TOPK + k) * D + c0);
        }
        float r[16];
#pragma unroll
        for (int q = 0; q < 16; ++q) r[q] = 0.f;
#pragma unroll
        for (int k = 0; k < TOPK; ++k)
#pragma unroll
            for (int q = 0; q < 4; ++q) {
                const int wd = (int)y[k][q];
                const auto lo = __builtin_amdgcn_cvt_pk_f32_fp8(wd, false); const auto hi = __builtin_amdgcn_cvt_pk_f32_fp8(wd, true);
                r[q * 4 + 0] += lo[0]; r[q * 4 + 1] += lo[1]; r[q * 4 + 2] += hi[0]; r[q * 4 + 3] += hi[1];
            }
        float v[16];
#pragma unroll
        for (int q = 0; q < 4; ++q) {
            const unsigned w0 = q < 2 ? b0[q * 2] : b1[(q - 2) * 2], w1 = q < 2 ? b0[q * 2 + 1] : b1[(q - 2) * 2 + 1];
            v[q * 4 + 0] = __uint_as_float(w0 << 16) + r[q * 4 + 0] * (1.0f / YSCALE); v[q * 4 + 1] = __uint_as_float(w0 & 0xffff0000u) + r[q * 4 + 1] * (1.0f / YSCALE);
            v[q * 4 + 2] = __uint_as_float(w1 << 16) + r[q * 4 + 2] * (1.0f / YSCALE); v[q * 4 + 3] = __uint_as_float(w1 & 0xffff0000u) + r[q * 4 + 3] * (1.0f / YSCALE);
        }
        float s = 0.f;
#pragma unroll
        for (int q = 0; q < 16; ++q) s += v[q];
        const float mean = wave_sum(s) * (1.0f / D);
        float qq = 0.f;
#pragma unroll
        for (int q = 0; q < 16; ++q) { const float d = v[q] - mean; qq += d * d; }
        const float rstd = rsqrtf(wave_sum(qq) * (1.0f / D) + 1e-5f);
#pragma unroll
        for (int q = 0; q < 4; ++q) {
            f32x4 o;
#pragma unroll
            for (int j = 0; j < 4; ++j) o[j] = (v[q * 4 + j] - mean) * rstd * g[q][j] + b[q][j];
            *(f32x4*)(p.out + (size_t)tok * D + c0 + q * 4) = o;
        }
    }
}

typedef float f32x16 __attribute__((ext_vector_type(16)));
#define CROW(i, h) (((i) & 3) + 8 * ((i) >> 2) + 4 * (h))
__device__ __forceinline__ f32x16 mfma32(bf16x8 a, bf16x8 b, f32x16 c) { return __builtin_amdgcn_mfma_f32_32x32x16_bf16(a, b, c, 0, 0, 0); }
__device__ __forceinline__ bf16_t f2bf_fast(float f) { return (bf16_t)(cvt_pk_bf16(f, f) & 0xffffu); }
__device__ __forceinline__ void unpack8(const u32x4 v, float (&o)[8]) {
    o[0] = __uint_as_float(v.x << 16); o[1] = __uint_as_float(v.x & 0xffff0000u); o[2] = __uint_as_float(v.y << 16); o[3] = __uint_as_float(v.y & 0xffff0000u);
    o[4] = __uint_as_float(v.z << 16); o[5] = __uint_as_float(v.z & 0xffff0000u); o[6] = __uint_as_float(v.w << 16); o[7] = __uint_as_float(v.w & 0xffff0000u);
}
__device__ __forceinline__ void lru_chain(const Params& p, LAS unsigned char* lds, const int b, const int n, const bool dry = false) {
    constexpr int WSTR = 272, XSTR = 272;
    LAS unsigned char* WA = lds;
    LAS unsigned char* WX = lds + 128 * WSTR;
    LAS unsigned char* XC = lds + 2 * 128 * WSTR;
    LAS unsigned char* O2 = XC + 64 * XSTR;
    LAS float* CW = (LAS float*)(O2 + 64 * 256);
    LAS float* LSA = CW + 640;
    LAS float* LSU = LSA + 256;
    LAS float* CAR = LSU + 256;
    const int tid = threadIdx.x, w = __builtin_amdgcn_readfirstlane(tid >> 6), lane = tid & 63, r = lane & 31, h = lane >> 5, tau = w & 1, q4 = w >> 1;
    const int CB = n * 128;
    for (int i = tid; i < 128 * 16; i += NTHR) {
        const int row = i >> 4, pc = i & 15;
        *(LAS u32x4*)(WA + row * WSTR + pc * 16) = *(const u32x4*)(p.Bt_wa + ((size_t)n * 128 + row) * 128 + pc * 8);
        *(LAS u32x4*)(WX + row * WSTR + pc * 16) = *(const u32x4*)(p.Bt_wx + ((size_t)n * 128 + row) * 128 + pc * 8);
    }
    for (int i = tid; i < 640; i += NTHR) { const int j = i >> 7, c = i & 127; CW[i] = j < 4 ? p.conv_w[j * D + CB + c] : p.conv_b[CB + c]; }
    if (tid < 256) CAR[tid] = 0.f;
    const int dcol = CB + q4 * 32 + r;
    const float bav = p.lru_ba[dcol], bxv = p.lru_bx[dcol];
    const float c2 = -8.0f * log1pf(expf(-p.lru_lam[dcol])) * 1.4426950408889634f;
    const int cg = tid & 15, tg = tid >> 4, crow = tid >> 3, cseg = (tid & 7) * 16;
    u32x4 lx[5]; u32x4 g2[2];
    auto prefetch_lx = [&](int c) {
#pragma unroll
        for (int j = 0; j < 5; ++j) { int pos = c * 64 + 2 * tg - 3 + j; pos = pos < 0 ? 0 : pos; lx[j] = *(const u32x4*)(p.LX + ((size_t)b * LP + pos) * D + CB + cg * 8); }
    };
    auto prefetch_g2 = [&](int c) {
        const size_t R0 = (size_t)b * LP + c * 64;
        g2[0] = *(const u32x4*)(p.G2 + (R0 + crow) * D + CB + cseg); g2[1] = *(const u32x4*)(p.G2 + (R0 + crow) * D + CB + cseg + 8);
    };
    prefetch_lx(0); prefetch_g2(0);
    __syncthreads();
    for (int c = 0; c < NCH; ++c) {
        const size_t R0 = (size_t)b * LP + c * 64; const int par = c & 1;
        {
            float x[5][8];
#pragma unroll
            for (int j = 0; j < 5; ++j) { unpack8(lx[j], x[j]);
                if (c == 0 && 2 * tg - 3 + j < PADR) {
#pragma unroll
                    for (int e = 0; e < 8; ++e) x[j][e] = 0.f; } }
            float cw[5][8];
#pragma unroll
            for (int j = 0; j < 5; ++j) { const f32x4 a = *(const LAS f32x4*)(CW + j * 128 + cg * 8), bq = *(const LAS f32x4*)(CW + j * 128 + cg * 8 + 4);
                cw[j][0] = a[0]; cw[j][1] = a[1]; cw[j][2] = a[2]; cw[j][3] = a[3]; cw[j][4] = bq[0]; cw[j][5] = bq[1]; cw[j][6] = bq[2]; cw[j][7] = bq[3]; }
#pragma unroll
            for (int rr = 0; rr < 2; ++rr) {
                float y[8];
#pragma unroll
                for (int e = 0; e < 8; ++e) y[e] = __builtin_fmaf(cw[3][e], x[rr + 3][e], __builtin_fmaf(cw[2][e], x[rr + 2][e], __builtin_fmaf(cw[1][e], x[rr + 1][e], __builtin_fmaf(cw[0][e], x[rr][e], cw[4][e]))));
                u32x4 o; o.x = cvt_pk_bf16(y[0], y[1]); o.y = cvt_pk_bf16(y[2], y[3]); o.z = cvt_pk_bf16(y[4], y[5]); o.w = cvt_pk_bf16(y[6], y[7]);
                *(LAS u32x4*)(XC + (2 * tg + rr) * XSTR + cg * 16) = o;
            }
        }
        __syncthreads();
        prefetch_lx(c + 1 < NCH ? c + 1 : c);
        f32x16 Rg, Ig;
#pragma unroll
        for (int i = 0; i < 16; ++i) { Rg[i] = 0.f; Ig[i] = 0.f; }
#pragma unroll
        for (int ks = 0; ks < 8; ++ks) {
            const bf16x8 a = *(const LAS bf16x8*)(XC + (32 * tau + r) * XSTR + (16 * ks + 8 * h) * 2);
            const bf16x8 ba = *(const LAS bf16x8*)(WA + (32 * q4 + r) * WSTR + (16 * ks + 8 * h) * 2);
            const bf16x8 bx = *(const LAS bf16x8*)(WX + (32 * q4 + r) * WSTR + (16 * ks + 8 * h) * 2);
            Rg = mfma32(a, ba, Rg); Ig = mfma32(a, bx, Ig);
        }
        float av[16], uv[16];
#pragma unroll
        for (int i = 0; i < 16; ++i) {
            const int tl = 32 * tau + CROW(i, h);
            const float xcv = bf2f(*(const LAS bf16_t*)(XC + tl * XSTR + (32 * q4 + r) * 2));
            const float rr = fast_sigmoid(Rg[i] + bav), ii = fast_sigmoid(Ig[i] + bxv);
            float a = __builtin_amdgcn_exp2f(rr * c2);
            float u = __builtin_amdgcn_sqrtf(fmaxf(1.0f - a * a, 0.f)) * ii * xcv;
            if (c == 0 && tl < PADR) { a = 1.0f; u = 0.f; }
            av[i] = a; uv[i] = u;
        }
        float gA[4], gU[4];
#pragma unroll
        for (int g = 0; g < 4; ++g) {
            float cA = 1.0f, hl = 0.f;
#pragma unroll
            for (int j = 0; j < 4; ++j) { hl = av[4 * g + j] * hl + uv[4 * g + j]; cA *= av[4 * g + j]; av[4 * g + j] = cA; uv[4 * g + j] = hl; }
            gA[g] = cA; gU[g] = hl;
        }
        float rA = 1.0f, rU = 0.f;
#pragma unroll
        for (int g = 0; g < 4; ++g) {
            const float pA = __shfl_xor(gA[g], 32), pU = __shfl_xor(gU[g], 32);
            const float fA = h ? pA : gA[g], fU = h ? pU : gU[g];
            const float sA = h ? gA[g] : pA, sU = h ? gU[g] : pU;
            const float r1U = fA * rU + fU, r1A = fA * rA;
            const float stA = h ? r1A : rA, stU = h ? r1U : rU;
            rU = sA * r1U + sU; rA = sA * r1A;
#pragma unroll
            for (int j = 0; j < 4; ++j) { const float ca = av[4 * g + j]; uv[4 * g + j] = ca * stU + uv[4 * g + j]; av[4 * g + j] = ca * stA; }
        }
        if (tau == 0 && h == 0) { LSA[par * 128 + 32 * q4 + r] = rA; LSU[par * 128 + 32 * q4 + r] = rU; }
        __syncthreads();
        {
            const float cin = CAR[par * 128 + 32 * q4 + r];
            float hin = cin;
            if (tau == 1) { hin = LSA[par * 128 + 32 * q4 + r] * cin + LSU[par * 128 + 32 * q4 + r]; if (h == 0) CAR[(par ^ 1) * 128 + 32 * q4 + r] = rA * hin + rU; }
#pragma unroll
            for (int i = 0; i < 16; ++i) {
                const int tl = 32 * tau + CROW(i, h);
                *(LAS bf16_t*)(O2 + tl * 256 + (32 * q4 + r) * 2) = f2bf_fast(av[i] * hin + uv[i]);
            }
        }
        __syncthreads();
        {
            const u32x4 h0 = *(const LAS u32x4*)(O2 + crow * 256 + cseg * 2), h1 = *(const LAS u32x4*)(O2 + crow * 256 + cseg * 2 + 16);
            float hh[8], gg[8]; u32x4 o0, o1;
            unpack8(h0, hh); unpack8(g2[0], gg);
            o0.x = cvt_pk_bf16(hh[0] * gg[0], hh[1] * gg[1]); o0.y = cvt_pk_bf16(hh[2] * gg[2], hh[3] * gg[3]); o0.z = cvt_pk_bf16(hh[4] * gg[4], hh[5] * gg[5]); o0.w = cvt_pk_bf16(hh[6] * gg[6], hh[7] * gg[7]);
            unpack8(h1, hh); unpack8(g2[1], gg);
            o1.x = cvt_pk_bf16(hh[0] * gg[0], hh[1] * gg[1]); o1.y = cvt_pk_bf16(hh[2] * gg[2], hh[3] * gg[3]); o1.z = cvt_pk_bf16(hh[4] * gg[4], hh[5] * gg[5]); o1.w = cvt_pk_bf16(hh[6] * gg[6], hh[7] * gg[7]);
            if (!dry) { *(u32x4*)(p.G2 + (R0 + crow) * D + CB + cseg) = o0; *(u32x4*)(p.G2 + (R0 + crow) * D + CB + cseg + 8) = o1; }
            prefetch_g2(c + 1 < NCH ? c + 1 : 0);
        }
    }
    __syncthreads();
}
__device__ __forceinline__ void hgrn_chain(const Params& p, LAS unsigned char* lds, const int b, const int hd, const bool dry = false) {
    constexpr int QSTR = 272, TSTR = 144;
    LAS unsigned char* Qi = lds;
    LAS unsigned char* Ki = Qi + 64 * QSTR;
    LAS unsigned char* Kt = Ki + 64 * QSTR;
    LAS unsigned char* Vt = Kt + 128 * TSTR;
    LAS unsigned char* St = Vt + 128 * TSTR;
    LAS unsigned char* Pi = St + 128 * QSTR;
    LAS unsigned char* O1 = Pi + 64 * TSTR;
    LAS float* Df = (LAS float*)(O1 + 64 * 256);
    LAS float* ssL = Df + 128;
    const int tid = threadIdx.x, w = __builtin_amdgcn_readfirstlane(tid >> 6), lane = tid & 63, r = lane & 31, h = lane >> 5, tau = w & 1, q4 = w >> 1;
    const int CB = hd * 128;
    for (int i = tid; i < 128 * QSTR / 16; i += NTHR) *(LAS u32x4*)(St + i * 16) = (u32x4){0u, 0u, 0u, 0u};
    if (tid < 64) ssL[tid] = 0.f;
    f32x16 Sacc[2];
#pragma unroll
    for (int i2 = 0; i2 < 2; ++i2)
#pragma unroll
        for (int i = 0; i < 16; ++i) Sacc[i2][i] = 0.f;
    const float ngv = p.hg_ng[q4 * 32 + r];
    const int crow = tid >> 3, cseg = (tid & 7) * 16;
    const int trow = lane, tseg = w * 16;
    u32x4 pq[2], pk[2], pv[2], pg[2], pz[2]; float pd = 0.f;
    auto prefetch = [&](int c) {
        const size_t R0 = (size_t)b * LP + c * 64;
        pq[0] = *(const u32x4*)(p.Qh + (R0 + crow) * D + CB + cseg); pq[1] = *(const u32x4*)(p.Qh + (R0 + crow) * D + CB + cseg + 8);
        pk[0] = *(const u32x4*)(p.Kh + (R0 + trow) * D + CB + tseg); pk[1] = *(const u32x4*)(p.Kh + (R0 + trow) * D + CB + tseg + 8);
        pv[0] = *(const u32x4*)(p.Vv + (R0 + trow) * D + CB + tseg); pv[1] = *(const u32x4*)(p.Vv + (R0 + trow) * D + CB + tseg + 8);
        pd = p.Dk[((size_t)b * NCH + c) * D + CB + (tid & 127)];
    };
    auto prefetch_g = [&](int c) {
        const size_t R0 = (size_t)b * LP + c * 64;
        pg[0] = *(const u32x4*)(p.G1 + (R0 + crow) * D + CB + cseg); pg[1] = *(const u32x4*)(p.G1 + (R0 + crow) * D + CB + cseg + 8);
        pz[0] = *(const u32x4*)(p.G2 + (R0 + crow) * D + CB + cseg); pz[1] = *(const u32x4*)(p.G2 + (R0 + crow) * D + CB + cseg + 8);
    };
    prefetch(0); prefetch_g(0);
    __syncthreads();
    for (int c = 0; c < NCH; ++c) {
        const size_t R0 = (size_t)b * LP + c * 64;
        *(LAS u32x4*)(Qi + crow * QSTR + cseg * 2) = pq[0]; *(LAS u32x4*)(Qi + crow * QSTR + cseg * 2 + 16) = pq[1];
        *(LAS u32x4*)(Ki + trow * QSTR + tseg * 2) = pk[0]; *(LAS u32x4*)(Ki + trow * QSTR + tseg * 2 + 16) = pk[1];
        {
            const unsigned kw[8] = {pk[0].x, pk[0].y, pk[0].z, pk[0].w, pk[1].x, pk[1].y, pk[1].z, pk[1].w};
            const unsigned vw[8] = {pv[0].x, pv[0].y, pv[0].z, pv[0].w, pv[1].x, pv[1].y, pv[1].z, pv[1].w};
#pragma unroll
            for (int e = 0; e < 8; ++e) {
                *(LAS bf16_t*)(Kt + (tseg + 2 * e) * TSTR + trow * 2) = (bf16_t)(kw[e] & 0xffffu); *(LAS bf16_t*)(Kt + (tseg + 2 * e + 1) * TSTR + trow * 2) = (bf16_t)(kw[e] >> 16);
                *(LAS bf16_t*)(Vt + (tseg + 2 * e) * TSTR + trow * 2) = (bf16_t)(vw[e] & 0xffffu); *(LAS bf16_t*)(Vt + (tseg + 2 * e + 1) * TSTR + trow * 2) = (bf16_t)(vw[e] >> 16);
            }
        }
        if (tid < 128) Df[tid] = pd;
        __syncthreads();
        prefetch(c + 1 < NCH ? c + 1 : c);
        if (w < 3) {
            const int tx = w ? 1 : 0, sx = w == 2 ? 1 : 0;
            f32x16 X;
#pragma unroll
            for (int i = 0; i < 16; ++i) X[i] = 0.f;
#pragma unroll
            for (int ks = 0; ks < 8; ++ks) {
                const bf16x8 a = *(const LAS bf16x8*)(Qi + (32 * tx + r) * QSTR + (16 * ks + 8 * h) * 2);
                const bf16x8 bb = *(const LAS bf16x8*)(Ki + (32 * sx + r) * QSTR + (16 * ks + 8 * h) * 2);
                X = mfma32(a, bb, X);
            }
#pragma unroll
            for (int i = 0; i < 16; ++i) {
                const int tl = CROW(i, h);
                const float v = (tx == sx && r > tl) ? 0.f : X[i];
                *(LAS bf16_t*)(Pi + (32 * tx + tl) * TSTR + (32 * sx + r) * 2) = f2bf_fast(v);
            }
        }
        __syncthreads();
        f32x16 O;
#pragma unroll
        for (int i = 0; i < 16; ++i) O[i] = 0.f;
        for (int ks = 0; ks < 2 * (tau + 1); ++ks) {
            const bf16x8 a = *(const LAS bf16x8*)(Pi + (32 * tau + r) * TSTR + (16 * ks + 8 * h) * 2);
            const bf16x8 bb = *(const LAS bf16x8*)(Vt + (32 * q4 + r) * TSTR + (16 * ks + 8 * h) * 2);
            O = mfma32(a, bb, O);
        }
#pragma unroll
        for (int ks = 0; ks < 8; ++ks) {
            const bf16x8 a = *(const LAS bf16x8*)(Qi + (32 * tau + r) * QSTR + (16 * ks + 8 * h) * 2);
            const bf16x8 bb = *(const LAS bf16x8*)(St + (32 * q4 + r) * QSTR + (16 * ks + 8 * h) * 2);
            O = mfma32(a, bb, O);
        }
        {
            float x[16];
#pragma unroll
            for (int i = 0; i < 16; ++i) x[i] = O[i] * O[i];
#pragma unroll
            for (int i = 0; i < 8; ++i) { const float snd = (lane & 16) ? x[i] : x[i + 8]; const float rcv = __shfl_xor(snd, 16); x[i] = ((lane & 16) ? x[i + 8] : x[i]) + rcv; }
#pragma unroll
            for (int i = 0; i < 4; ++i) { const float snd = (lane & 8) ? x[i] : x[i + 4]; const float rcv = __shfl_xor(snd, 8); x[i] = ((lane & 8) ? x[i + 4] : x[i]) + rcv; }
#pragma unroll
            for (int i = 0; i < 2; ++i) { const float snd = (lane & 4) ? x[i] : x[i + 2]; const float rcv = __shfl_xor(snd, 4); x[i] = ((lane & 4) ? x[i + 2] : x[i]) + rcv; }
            { const float snd = (lane & 2) ? x[0] : x[1]; const float rcv = __shfl_xor(snd, 2); x[0] = ((lane & 2) ? x[1] : x[0]) + rcv; }
            x[0] += __shfl_xor(x[0], 1);
            const int idx = ((lane >> 4) & 1) * 8 + ((lane >> 3) & 1) * 4 + ((lane >> 2) & 1) * 2 + ((lane >> 1) & 1);
            if ((lane & 1) == 0) __hip_atomic_fetch_add(ssL + 32 * tau + CROW(idx, h), x[0], __ATOMIC_RELAXED, __HIP_MEMORY_SCOPE_WORKGROUP);
        }
        __syncthreads();
#pragma unroll
        for (int g = 0; g < 4; ++g) {
            const f32x4 s4 = *(const LAS f32x4*)(ssL + 32 * tau + 8 * g + 4 * h);
#pragma unroll
            for (int j = 0; j < 4; ++j) {
                const float rt = rsqrtf(s4[j] * (1.0f / 128.0f) + 1e-6f);
                *(LAS bf16_t*)(O1 + (32 * tau + 8 * g + 4 * h + j) * 256 + (32 * q4 + r) * 2) = f2bf_fast(O[4 * g + j] * rt * ngv);
            }
        }
#pragma unroll
        for (int i2 = 0; i2 < 2; ++i2) {
            const int kap = 2 * tau + i2;
#pragma unroll
            for (int ks = 0; ks < 4; ++ks) {
                const bf16x8 a = *(const LAS bf16x8*)(Kt + (32 * kap + r) * TSTR + (16 * ks + 8 * h) * 2);
                const bf16x8 bb = *(const LAS bf16x8*)(Vt + (32 * q4 + r) * TSTR + (16 * ks + 8 * h) * 2);
                Sacc[i2] = mfma32(a, bb, Sacc[i2]);
            }
#pragma unroll
            for (int g = 0; g < 4; ++g) {
                const f32x4 d4 = *(const LAS f32x4*)(Df + 32 * kap + 8 * g + 4 * h);
#pragma unroll
                for (int j = 0; j < 4; ++j) Sacc[i2][4 * g + j] *= d4[j];
                *(LAS u32x2*)(St + (32 * q4 + r) * QSTR + (32 * kap + 8 * g + 4 * h) * 2) =
                    (u32x2){cvt_pk_bf16(Sacc[i2][4 * g], Sacc[i2][4 * g + 1]), cvt_pk_bf16(Sacc[i2][4 * g + 2], Sacc[i2][4 * g + 3])};
            }
        }
        __syncthreads();
        {
            if (tid < 64) ssL[tid] = 0.f;
            const u32x4 z0 = *(const LAS u32x4*)(O1 + crow * 256 + cseg * 2), z1 = *(const LAS u32x4*)(O1 + crow * 256 + cseg * 2 + 16);
            float oo[8], gg[8], zz[8]; u32x4 o0, o1;
            unpack8(z0, oo); unpack8(pg[0], gg); unpack8(pz[0], zz);
            o0.x = cvt_pk_bf16(oo[0] * gg[0] + zz[0], oo[1] * gg[1] + zz[1]); o0.y = cvt_pk_bf16(oo[2] * gg[2] + zz[2], oo[3] * gg[3] + zz[3]);
            o0.z = cvt_pk_bf16(oo[4] * gg[4] + zz[4], oo[5] * gg[5] + zz[5]); o0.w = cvt_pk_bf16(oo[6] * gg[6] + zz[6], oo[7] * gg[7] + zz[7]);
            unpack8(z1, oo); unpack8(pg[1], gg); unpack8(pz[1], zz);
            o1.x = cvt_pk_bf16(oo[0] * gg[0] + zz[0], oo[1] * gg[1] + zz[1]); o1.y = cvt_pk_bf16(oo[2] * gg[2] + zz[2], oo[3] * gg[3] + zz[3]);
            o1.z = cvt_pk_bf16(oo[4] * gg[4] + zz[4], oo[5] * gg[5] + zz[5]); o1.w = cvt_pk_bf16(oo[6] * gg[6] + zz[6], oo[7] * gg[7] + zz[7]);
            if (!dry) { *(u32x4*)(p.G1 + (R0 + crow) * D + CB + cseg) = o0; *(u32x4*)(p.G1 + (R0 + crow) * D + CB + cseg + 8) = o1; }
            prefetch_g(c + 1 < NCH ? c + 1 : 0);
        }
    }
    __syncthreads();
}
__device__ __forceinline__ f32x4 mfma16(bf16x8 a, bf16x8 b, f32x4 c) { return __builtin_amdgcn_mfma_f32_16x16x32_bf16(a, b, c, 0, 0, 0); }
__device__ __forceinline__ void unpack4(const u32x2 v, float (&o)[4]) {
    o[0] = __uint_as_float(v.x << 16); o[1] = __uint_as_float(v.x & 0xffff0000u); o[2] = __uint_as_float(v.y << 16); o[3] = __uint_as_float(v.y & 0xffff0000u);
}
typedef short v4i16 __attribute__((ext_vector_type(4)));
struct XStrip { const float* src; unsigned char* dst; int sld, dld, k0, n0, mode; };
__device__ __forceinline__ XStrip xstrip_decode(const Params& p, int sid) {
    XStrip s; const int j = sid >> 10, t = sid & 1023, e = t >> 4;
    if (j < 2) { s.src = (j ? p.we_up : p.we_gate) + (size_t)e * D * DE; s.sld = DE; s.k0 = (t & 15) * 64; s.n0 = 0; s.dst = p.Bt_gu + (size_t)e * 512 * D; s.dld = D; s.mode = j; }
    else { const int r = t & 15; s.src = p.we_down + (size_t)e * DE * D; s.sld = D; s.k0 = (r >> 2) * 64; s.n0 = (r & 3) * 256; s.dst = p.Bt_d + (size_t)e * D * DE; s.dld = DE; s.mode = 2; }
    return s;
}
__device__ __forceinline__ int xstrip_drow(int mode, int n) { return mode == 2 ? n : (n >> 7) * 256 + mode * 128 + (n & 127); }
__device__ __forceinline__ void bcast_rows(float x, float (&v)[4]) {
    const auto r = __builtin_amdgcn_permlane32_swap(__float_as_uint(x), __float_as_uint(x), false, false);
    const auto a = __builtin_amdgcn_permlane16_swap(r[0], r[0], false, false);
    const auto b = __builtin_amdgcn_permlane16_swap(r[1], r[1], false, false);
    v[0] = __uint_as_float(a[0]); v[1] = __uint_as_float(a[1]); v[2] = __uint_as_float(b[0]); v[3] = __uint_as_float(b[1]);
}
__device__ __forceinline__ void lru_chain_q(const Params& p, LAS unsigned char* lds, const int b, const int n, const int q, const bool dry = false, const bool do_strips = false) {
    constexpr int XSTR = 272;
    LAS unsigned char* XC = lds;
    LAS unsigned char* O2 = XC + 64 * XSTR;
    LAS float* CW = (LAS float*)(O2 + 64 * 64);
    LAS float* LSA = CW + 640;
    LAS float* LSU = LSA + 256;
    LAS float* CAR = LSU + 256;
    const int tid = tid_opaque(), w = __builtin_amdgcn_readfirstlane(tid >> 6), lane = tid & 63, c16 = lane & 15, qd = lane >> 4, tt = w >> 1, dh = w & 1;
    const int CB = n * 128;
    const int dl = 16 * dh + c16;
    const int dcol = CB + 32 * q + dl;
    for (int i = tid; i < 640; i += NTHR) { const int j = i >> 7, c = i & 127; CW[i] = j < 4 ? p.conv_w[j * D + CB + c] : p.conv_b[CB + c]; }
    if (tid < 64) CAR[tid] = 0.f;
    bf16x8 waf[4], wxf[4];
#pragma unroll
    for (int ks = 0; ks < 4; ++ks) {
        waf[ks] = *(const bf16x8*)(p.Bt_wa + ((size_t)n * 128 + 32 * q + dl) * 128 + 32 * ks + 8 * qd);
        wxf[ks] = *(const bf16x8*)(p.Bt_wx + ((size_t)n * 128 + 32 * q + dl) * 128 + 32 * ks + 8 * qd);
    }
    const float bav = p.lru_ba[dcol], bxv = p.lru_bx[dcol];
    const float c2 = -8.0f * log1pf(expf(-p.lru_lam[dcol])) * 1.4426950408889634f;
    const int cg = tid & 15, tg = tid >> 4, crow = tid >> 3, c4 = (tid & 7) * 4;
    u32x4 lx[5]; u32x2 g2;
    LAS float* TR = (LAS float*)(lds + 32768);
    f32x4 xa[4], xb[4];
#pragma unroll
    for (int t = 0; t < 4; ++t) { xa[t] = (f32x4){0.f, 0.f, 0.f, 0.f}; xb[t] = xa[t]; }
    auto prefetch_lx = [&](int c) {
#pragma unroll
        for (int j = 0; j < 5; ++j) { int pos = c * 64 + 2 * tg - 3 + j; pos = pos < 0 ? 0 : pos; lx[j] = *(const u32x4*)(p.LX + ((size_t)b * LP + pos) * D + CB + cg * 8); }
    };
    auto prefetch_g2 = [&](int c) { g2 = *(const u32x2*)(p.G2 + ((size_t)b * LP + c * 64 + crow) * D + CB + 32 * q + c4); };
    prefetch_lx(0); prefetch_g2(0);
    __syncthreads();
    float cw[5][8];
#pragma unroll
    for (int j = 0; j < 5; ++j) { const f32x4 a = *(const LAS f32x4*)(CW + j * 128 + cg * 8), bq = *(const LAS f32x4*)(CW + j * 128 + cg * 8 + 4);
        cw[j][0] = a[0]; cw[j][1] = a[1]; cw[j][2] = a[2]; cw[j][3] = a[3]; cw[j][4] = bq[0]; cw[j][5] = bq[1]; cw[j][6] = bq[2]; cw[j][7] = bq[3]; }
    for (int c = 0; c < NCH; ++c) {
        const size_t R0 = (size_t)b * LP + c * 64; const int par = c & 1;
        {
            float x[5][8];
#pragma unroll
            for (int j = 0; j < 5; ++j) { unpack8(lx[j], x[j]);
                if (c == 0 && 2 * tg - 3 + j < PADR) {
#pragma unroll
                    for (int e = 0; e < 8; ++e) x[j][e] = 0.f; } }
#pragma unroll
            for (int rr = 0; rr < 2; ++rr) {
                float y[8];
#pragma unroll
                for (int e = 0; e < 8; ++e) y[e] = __builtin_fmaf(cw[3][e], x[rr + 3][e], __builtin_fmaf(cw[2][e], x[rr + 2][e], __builtin_fmaf(cw[1][e], x[rr + 1][e], __builtin_fmaf(cw[0][e], x[rr][e], cw[4][e]))));
                u32x4 o; o.x = cvt_pk_bf16(y[0], y[1]); o.y = cvt_pk_bf16(y[2], y[3]); o.z = cvt_pk_bf16(y[4], y[5]); o.w = cvt_pk_bf16(y[6], y[7]);
                *(LAS u32x4*)(XC + (2 * tg + rr) * XSTR + cg * 16) = o;
            }
        }
        __syncthreads();
        prefetch_lx(c + 1 < NCH ? c + 1 : c);
        if (do_strips && c < 60) {
            const int ph = c % 5; const int sid = (int)blockIdx.x + 256 * (c / 5);
            if (ph == 0) {
                const XStrip s = xstrip_decode(p, sid); const int kr = tid >> 3, c8 = (tid & 7) * 8;
#pragma unroll
                for (int t = 0; t < 4; ++t) { const float* sp = s.src + (size_t)(s.k0 + kr) * s.sld + s.n0 + t * 64 + c8; xa[t] = *(const f32x4*)sp; xb[t] = *(const f32x4*)(sp + 4); }
            } else if (ph == 1) {
                const int kr = tid >> 3, c8 = (tid & 7) * 8;
#pragma unroll
                for (int t = 0; t < 4; ++t) { LAS float* wp = TR + t * (64 * 65) + kr * 65 + c8;
                    wp[0] = xa[t][0]; wp[1] = xa[t][1]; wp[2] = xa[t][2]; wp[3] = xa[t][3]; wp[4] = xb[t][0]; wp[5] = xb[t][1]; wp[6] = xb[t][2]; wp[7] = xb[t][3]; }
            } else if (ph == 2) {
                const XStrip s = xstrip_decode(p, sid); const int nr = tid >> 3, k8 = (tid & 7) * 8;
#pragma unroll
                for (int t = 0; t < 4; ++t) {
                    float v[8];
#pragma unroll
                    for (int i = 0; i < 8; ++i) v[i] = TR[t * (64 * 65) + (k8 + i) * 65 + nr];
                    *(u32x2*)(s.dst + (size_t)xstrip_drow(s.mode, s.n0 + t * 64 + nr) * s.dld + s.k0 + k8) =
                        (u32x2){pk_fp8x4(v[0] * WSCALE8, v[1] * WSCALE8, v[2] * WSCALE8, v[3] * WSCALE8), pk_fp8x4(v[4] * WSCALE8, v[5] * WSCALE8, v[6] * WSCALE8, v[7] * WSCALE8)};
                }
            }
        }
        f32x4 Rg = (f32x4){0.f, 0.f, 0.f, 0.f}, Ig = Rg;
#pragma unroll
        for (int ks = 0; ks < 4; ++ks) {
            const bf16x8 a = *(const LAS bf16x8*)(XC + (16 * tt + c16) * XSTR + (32 * ks + 8 * qd) * 2);
            Rg = mfma16(a, waf[ks], Rg); Ig = mfma16(a, wxf[ks], Ig);
        }
        float av[4], uv[4];
        float gA = 1.0f, gU = 0.f;
        const v4i16 xc4 = __builtin_amdgcn_ds_read_tr16_b64_v4i16((LAS v4i16*)(XC + (16 * tt + 4 * qd + (c16 >> 2)) * XSTR + (32 * q + 16 * dh + 4 * (c16 & 3)) * 2));
#pragma unroll
        for (int i = 0; i < 4; ++i) {
            const int tl = 16 * tt + 4 * qd + i;
            const float xcv = bf2f((bf16_t)xc4[i]);
            const float rr = fast_sigmoid(Rg[i] + bav), ii = fast_sigmoid(Ig[i] + bxv);
            float a = __builtin_amdgcn_exp2f(rr * c2);
            float u = __builtin_amdgcn_sqrtf(fmaxf(1.0f - a * a, 0.f)) * ii * xcv;
            if (c == 0 && tl < PADR) { a = 1.0f; u = 0.f; }
            gU = a * gU + u; gA *= a; av[i] = gA; uv[i] = gU;
        }
        float rA = 1.0f, rU = 0.f, stA = 1.0f, stU = 0.f;
        float Aq[4], Uq[4]; bcast_rows(gA, Aq); bcast_rows(gU, Uq);
#pragma unroll
        for (int j = 0; j < 4; ++j) {
            if (j == qd) { stA = rA; stU = rU; }
            rU = Aq[j] * rU + Uq[j]; rA = Aq[j] * rA;
        }
#pragma unroll
        for (int i = 0; i < 4; ++i) { const float ca = av[i]; uv[i] = ca * stU + uv[i]; av[i] = ca * stA; }
        if (qd == 0) { LSA[(par * 4 + tt) * 32 + dl] = rA; LSU[(par * 4 + tt) * 32 + dl] = rU; }
        __syncthreads();
        {
            float hin = CAR[par * 32 + dl];
#pragma unroll
            for (int t2 = 0; t2 < 3; ++t2) if (t2 < tt) hin = LSA[(par * 4 + t2) * 32 + dl] * hin + LSU[(par * 4 + t2) * 32 + dl];
            if (tt == 3 && qd == 0) CAR[(par ^ 1) * 32 + dl] = rA * hin + rU;
#pragma unroll
            for (int i = 0; i < 4; ++i) *(LAS bf16_t*)(O2 + (16 * tt + 4 * qd + i) * 64 + dl * 2) = f2bf_fast(av[i] * hin + uv[i]);
        }
        __syncthreads();
        {
            const u32x2 hh2 = *(const LAS u32x2*)(O2 + crow * 64 + c4 * 2);
            float hh[4], gg[4]; unpack4(hh2, hh); unpack4(g2, gg);
            if (!dry) *(u32x2*)(p.G2 + (R0 + crow) * D + CB + 32 * q + c4) = (u32x2){cvt_pk_bf16(hh[0] * gg[0], hh[1] * gg[1]), cvt_pk_bf16(hh[2] * gg[2], hh[3] * gg[3])};
            prefetch_g2(c + 1 < NCH ? c + 1 : 0);
        }
    }
    __syncthreads();
}
__device__ __forceinline__ bf16x8 tr_frag(const LAS unsigned char* img, const int stride, const int s0, const int col0, const int c16) {
    const LAS unsigned char* p0 = img + (s0 + (c16 >> 2)) * stride + (col0 + 4 * (c16 & 3)) * 2;
    const v4i16 lo = __builtin_amdgcn_ds_read_tr16_b64_v4i16((LAS v4i16*)p0);
    const v4i16 hi = __builtin_amdgcn_ds_read_tr16_b64_v4i16((LAS v4i16*)(p0 + 4 * stride));
    return __builtin_shufflevector(lo, hi, 0, 1, 2, 3, 4, 5, 6, 7);
}
__device__ __forceinline__ void hgrn_chain_q(const Params& p, LAS unsigned char* lds, const int b, const int hd, const int q, const bool dry = false, const unsigned tagbase = 0u, const int xflags = 0) {
    constexpr int QSTR = 272, TSTR = 144;
    LAS unsigned char* Qi = lds;
    LAS unsigned char* Ki = Qi + 64 * QSTR;
    constexpr int VSTR = 80;
    LAS unsigned char* Vi = Ki + 64 * QSTR;
    LAS unsigned char* St = Vi + 64 * VSTR;
    LAS unsigned char* Pi = St + 32 * QSTR;
    LAS unsigned char* O1 = Pi + 64 * TSTR;
    LAS float* Df = (LAS float*)(O1 + 2 * 64 * 64);
    LAS float* ssL = Df + 128;
    LAS float* ssO = ssL + 64;
    LAS float* rT = ssO + 128;
    const int tid = tid_opaque(), w = __builtin_amdgcn_readfirstlane(tid >> 6), lane = tid & 63, c16 = lane & 15, qd = lane >> 4, tt = w >> 1, vh = w & 1;
    const int CB = hd * 128, VB = CB + 32 * q;
    unsigned long long* xg = (unsigned long long*)p.xg + (size_t)(b * 8 + hd) * (4 * 4 * 64);
    for (int i = tid; i < 32 * QSTR / 16; i += NTHR) *(LAS u32x4*)(St + i * 16) = (u32x4){0u, 0u, 0u, 0u};
    for (int i = tid; i < 64 * TSTR / 16; i += NTHR) *(LAS u32x4*)(Pi + i * 16) = (u32x4){0u, 0u, 0u, 0u};
    if (tid < 64) ssL[tid] = 0.f;
    f32x4 Sacc[2];
    Sacc[0] = (f32x4){0.f, 0.f, 0.f, 0.f}; Sacc[1] = Sacc[0];
    const float ngv = p.hg_ng[32 * q + 16 * vh + c16];
    const int crow = tid >> 3, cseg = (tid & 7) * 16, c4 = (tid & 7) * 4;
    u32x4 pq[2], pk[2]; u32x2 pv, pg, pz; float pd = 0.f;
    auto prefetch = [&](int c) {
        const size_t R0 = (size_t)b * LP + c * 64;
        pq[0] = *(const u32x4*)(p.Qh + (R0 + crow) * D + CB + cseg); pq[1] = *(const u32x4*)(p.Qh + (R0 + crow) * D + CB + cseg + 8);
        pk[0] = *(const u32x4*)(p.Kh + (R0 + crow) * D + CB + cseg); pk[1] = *(const u32x4*)(p.Kh + (R0 + crow) * D + CB + cseg + 8);
        pv = *(const u32x2*)(p.Vv + (R0 + crow) * D + VB + c4);
        pd = p.Dk[((size_t)b * NCH + c) * D + CB + (tid & 127)];
    };
    auto fin_store = [&](int cf) {
        const size_t R = (size_t)b * LP + cf * 64 + crow;
        const u32x2 o2 = *(const LAS u32x2*)(O1 + ((cf & 1) * 64 + crow) * 64 + c4 * 2);
        float oo[4], gg[4], zz[4]; unpack4(o2, oo); unpack4(pg, gg); unpack4(pz, zz);
        const float rt = rT[crow];
        if (!dry) *(u32x2*)(p.G1 + R * D + VB + c4) = (u32x2){cvt_pk_bf16(oo[0] * rt * gg[0] + zz[0], oo[1] * rt * gg[1] + zz[1]), cvt_pk_bf16(oo[2] * rt * gg[2] + zz[2], oo[3] * rt * gg[3] + zz[3])};
    };
    auto fin_factors = [&](int cf, unsigned long long g0, unsigned long long g1, unsigned long long g2) {
        const unsigned tag = (unsigned)(cf + 1) + tagbase;
        unsigned spins = 0;
        while (!__all((unsigned)(g0 >> 32) == tag && (unsigned)(g1 >> 32) == tag && (unsigned)(g2 >> 32) == tag)) {
            if (++spins > (1u << 20)) break;
            __builtin_amdgcn_s_sleep(2);
            g0 = __hip_atomic_load(xg + (((q + 1) & 3) * 4 + (cf & 3)) * 64 + lane, __ATOMIC_RELAXED, __HIP_MEMORY_SCOPE_AGENT);
            g1 = __hip_atomic_load(xg + (((q + 2) & 3) * 4 + (cf & 3)) * 64 + lane, __ATOMIC_RELAXED, __HIP_MEMORY_SCOPE_AGENT);
            g2 = __hip_atomic_load(xg + (((q + 3) & 3) * 4 + (cf & 3)) * 64 + lane, __ATOMIC_RELAXED, __HIP_MEMORY_SCOPE_AGENT);
        }
        const float tot = ssO[(cf & 1) * 64 + lane] + __uint_as_float((unsigned)g0) + __uint_as_float((unsigned)g1) + __uint_as_float((unsigned)g2);
        rT[lane] = rsqrtf(tot * (1.0f / 128.0f) + 1e-6f);
    };
    prefetch(0);
    __syncthreads();
    for (int c = 0; c < NCH; ++c) {
        *(LAS u32x4*)(Qi + crow * QSTR + cseg * 2) = pq[0]; *(LAS u32x4*)(Qi + crow * QSTR + cseg * 2 + 16) = pq[1];
        *(LAS u32x4*)(Ki + crow * QSTR + cseg * 2) = pk[0]; *(LAS u32x4*)(Ki + crow * QSTR + cseg * 2 + 16) = pk[1];
        *(LAS u32x2*)(Vi + crow * VSTR + c4 * 2) = pv;
        if (tid < 128) Df[tid] = pd;
        __syncthreads();
        prefetch(c + 1 < NCH ? c + 1 : c);
        const int cf = c > 0 ? c - 1 : 0;
        {
            const size_t R = (size_t)b * LP + cf * 64 + crow;
            pg = *(const u32x2*)(p.G1 + R * D + VB + c4); pz = *(const u32x2*)(p.G2 + R * D + VB + c4);
        }
        unsigned long long g0 = 0ull, g1 = 0ull, g2 = 0ull;
        if (w == 7) {
            g0 = __hip_atomic_load(xg + (((q + 1) & 3) * 4 + (cf & 3)) * 64 + lane, __ATOMIC_RELAXED, __HIP_MEMORY_SCOPE_AGENT);
            g1 = __hip_atomic_load(xg + (((q + 2) & 3) * 4 + (cf & 3)) * 64 + lane, __ATOMIC_RELAXED, __HIP_MEMORY_SCOPE_AGENT);
            g2 = __hip_atomic_load(xg + (((q + 3) & 3) * 4 + (cf & 3)) * 64 + lane, __ATOMIC_RELAXED, __HIP_MEMORY_SCOPE_AGENT);
        }
        for (int ti = w; ti < 10; ti += 8) {
            const int pt = ti < 1 ? 0 : ti < 3 ? 1 : ti < 6 ? 2 : 3, ps = ti - (pt * (pt + 1)) / 2;
            f32x4 X = (f32x4){0.f, 0.f, 0.f, 0.f};
#pragma unroll
            for (int ks = 0; ks < 4; ++ks) {
                const bf16x8 a = *(const LAS bf16x8*)(Qi + (16 * pt + c16) * QSTR + (32 * ks + 8 * qd) * 2);
                const bf16x8 bb = *(const LAS bf16x8*)(Ki + (16 * ps + c16) * QSTR + (32 * ks + 8 * qd) * 2);
                X = mfma16(a, bb, X);
            }
            float xv[4];
#pragma unroll
            for (int i = 0; i < 4; ++i) xv[i] = (pt == ps && c16 > 4 * qd + i) ? 0.f : X[i];
            *(LAS u32x2*)(Pi + (16 * ps + c16) * TSTR + (16 * pt + 4 * qd) * 2) = (u32x2){cvt_pk_bf16(xv[0], xv[1]), cvt_pk_bf16(xv[2], xv[3])};
        }
        __syncthreads();
        {
            f32x4 O = (f32x4){0.f, 0.f, 0.f, 0.f};
            for (int ks = 0; ks < (tt + 2) / 2; ++ks) {
                const bf16x8 a = tr_frag(Pi, TSTR, 32 * ks + 8 * qd, 16 * tt, c16);
                const bf16x8 bb = tr_frag(Vi, VSTR, 32 * ks + 8 * qd, 16 * vh, c16);
                O = mfma16(a, bb, O);
            }
#pragma unroll
            for (int ks = 0; ks < 4; ++ks) {
                const bf16x8 a = *(const LAS bf16x8*)(Qi + (16 * tt + c16) * QSTR + (32 * ks + 8 * qd) * 2);
                const bf16x8 bb = *(const LAS bf16x8*)(St + (16 * vh + c16) * QSTR + (32 * ks + 8 * qd) * 2);
                O = mfma16(a, bb, O);
            }
#pragma unroll
            for (int i = 0; i < 4; ++i) {
                const float s = row16_incl_scan(O[i] * O[i]);
                if (c16 == 15) __hip_atomic_fetch_add(ssL + 16 * tt + 4 * qd + i, s, __ATOMIC_RELAXED, __HIP_MEMORY_SCOPE_WORKGROUP);
                *(LAS bf16_t*)(O1 + ((c & 1) * 64 + 16 * tt + 4 * qd + i) * 64 + (16 * vh + c16) * 2) = f2bf_fast(O[i] * ngv);
            }
            if (w == 7 && c > 0) fin_factors(cf, g0, g1, g2);
        }
        __syncthreads();
        if (w == 0) {
            const float s = ssL[lane];
            ssO[(c & 1) * 64 + lane] = s;
            __hip_atomic_store(xg + ((q * 4) + (c & 3)) * 64 + lane, ((unsigned long long)((unsigned)(c + 1) + tagbase) << 32) | (unsigned long long)__float_as_uint(s), __ATOMIC_RELAXED, __HIP_MEMORY_SCOPE_AGENT);
        }
#pragma unroll
        for (int i2 = 0; i2 < 2; ++i2) {
            const int kk = 2 * tt + i2;
#pragma unroll
            for (int ks = 0; ks < 2; ++ks) {
                const bf16x8 a = tr_frag(Ki, QSTR, 32 * ks + 8 * qd, 16 * kk, c16);
                const bf16x8 bb = tr_frag(Vi, VSTR, 32 * ks + 8 * qd, 16 * vh, c16);
                Sacc[i2] = mfma16(a, bb, Sacc[i2]);
            }
            const f32x4 d4 = *(const LAS f32x4*)(Df + 16 * kk + 4 * qd);
            Sacc[i2] = Sacc[i2] * d4;
            *(LAS u32x2*)(St + (16 * vh + c16) * QSTR + (16 * kk + 4 * qd) * 2) = (u32x2){cvt_pk_bf16(Sacc[i2][0], Sacc[i2][1]), cvt_pk_bf16(Sacc[i2][2], Sacc[i2][3])};
        }
        __syncthreads();
        if (tid < 64) ssL[tid] = 0.f;
        if (c > 0) fin_store(cf);
    }
    {
        const int cf = NCH - 1;
        const size_t R = (size_t)b * LP + cf * 64 + crow;
        pg = *(const u32x2*)(p.G1 + R * D + VB + c4); pz = *(const u32x2*)(p.G2 + R * D + VB + c4);
        __syncthreads();
        if (w == 7) {
            const unsigned long long g0 = __hip_atomic_load(xg + (((q + 1) & 3) * 4 + (cf & 3)) * 64 + lane, __ATOMIC_RELAXED, __HIP_MEMORY_SCOPE_AGENT);
            const unsigned long long g1 = __hip_atomic_load(xg + (((q + 2) & 3) * 4 + (cf & 3)) * 64 + lane, __ATOMIC_RELAXED, __HIP_MEMORY_SCOPE_AGENT);
            const unsigned long long g2 = __hip_atomic_load(xg + (((q + 3) & 3) * 4 + (cf & 3)) * 64 + lane, __ATOMIC_RELAXED, __HIP_MEMORY_SCOPE_AGENT);
            fin_factors(cf, g0, g1, g2);
        }
        __syncthreads();
        fin_store(cf);
    }
    __syncthreads();
}
__device__ __forceinline__ void phase2q(const Params& p, LAS unsigned char* lds) {
    const int bh = blockIdx.x & 63, q = blockIdx.x >> 6, b = bh >> 3, hd = bh & 7;
    const int nl = 1 + (p.flags & 15), nh = 1 + ((p.flags >> 4) & 15);
    for (int rep = 0; rep < nl; ++rep) lru_chain_q(p, lds, b, hd, q, rep > 0, rep == 0);
    asm volatile("s_waitcnt vmcnt(0)" ::: "memory");
    __syncthreads();
    if (threadIdx.x == 0) { __builtin_amdgcn_fence(__ATOMIC_ACQUIRE, "agent"); asm volatile("s_waitcnt vmcnt(0)" ::: "memory"); }
    __syncthreads();
    for (int rep = 0; rep < nh; ++rep) hgrn_chain_q(p, lds, b, hd, q, rep > 0, 1000u * rep, rep > 0 ? (p.flags >> 8) : 0);
}

__device__ __forceinline__ void phase2(const Params& p, LAS unsigned char* lds, const bool dry = false) {
    if (blockIdx.x >= NB * 8) return;
    const int b = blockIdx.x >> 3, hd = blockIdx.x & 7;
    lru_chain(p, lds, b, hd, dry);
    asm volatile("s_waitcnt vmcnt(0)" ::: "memory");
    __syncthreads();
    if (threadIdx.x == 0) { __builtin_amdgcn_fence(__ATOMIC_ACQUIRE, "agent"); asm volatile("s_waitcnt vmcnt(0)" ::: "memory"); }
    __syncthreads();
    hgrn_chain(p, lds, b, hd, dry);
}

__global__ __launch_bounds__(NTHR, 2) void k_mega(Params p) {
    extern __shared__ __attribute__((aligned(16))) unsigned char shm[];
    LAS unsigned char* lds = (LAS unsigned char*)shm;
    volatile LAS unsigned* xst = (volatile LAS unsigned*)(lds + LDS_BYTES - 16);
    if (threadIdx.x == 0) { xst[0] = 0u; xst[1] = 0u; }
    __syncthreads();
    (void)xcd_barrier_post(p.bar, xst);
#define XB_NOW() do { XcdBarrier xb_; xb_.bar = p.bar; xb_.x = xb_xcc_id(); xb_.st = (volatile LAS unsigned*)(lds + LDS_BYTES - 16); xcd_barrier(xb_); } while (0)
    phase_prep(p, lds);
    XB_NOW();
#if REPEAT_PHASE == 0
    phase_prep(p, lds); XB_NOW();
#endif
#if REPEAT_PHASE == 99
    XB_NOW(); XB_NOW(); XB_NOW(); XB_NOW();
#endif
    phase1(p, lds);
    XB_NOW();
#if REPEAT_PHASE == 1
    phase1(p, lds); XB_NOW();
#endif
    if (gridDim.x == 256) phase2q(p, lds); else phase2(p, lds);
    XB_NOW();
#if REPEAT_PHASE == 2
    phase2(p, lds, true); XB_NOW();
#endif
    phase3(p, lds);
    XB_NOW();
#if REPEAT_PHASE == 3
    phase3(p, lds); XB_NOW();
#endif
    phase4(p, lds);
    XB_NOW();
#if REPEAT_PHASE == 4
    if (blockIdx.x == 0 && threadIdx.x < 64) p.cnt[threadIdx.x * 64] = 0;
    XB_NOW(); phase4(p, lds); XB_NOW();
#endif
    phase5(p, lds);
    XB_NOW();
#if REPEAT_PHASE == 5
    phase5(p, lds); XB_NOW();
#endif
    phase6(p, lds);
    XB_NOW();
#if REPEAT_PHASE == 6
    phase6(p, lds); XB_NOW();
#endif
    phase7(p);
#if REPEAT_PHASE == 7
    XB_NOW(); phase7(p);
#endif
}

template <int PH> __global__ __launch_bounds__(NTHR, 2) void k_phase(Params p) {
    extern __shared__ __attribute__((aligned(16))) unsigned char shm[];
    LAS unsigned char* lds = (LAS unsigned char*)shm;
    if (PH == 0) phase_prep(p, lds);
    if (PH == 1) phase1(p, lds);
    if (PH == 3) phase3(p, lds);
    if (PH == 4) phase4(p, lds);
    if (PH == 5) phase5(p, lds);
    if (PH == 6) phase6(p, lds);
    if (PH == 7) phase7(p);
}

extern "C" void kernel_launch(void* const* d_in, const int* in_sizes, int n_in, void* d_out, int out_size, void* d_ws, size_t ws_size, hipStream_t stream) {
    Params p{};
#ifdef EXP_FLAGS
    p.flags = EXP_FLAGS;
#endif
    p.x = (const float*)d_in[0]; p.meta = (const float*)d_in[1]; p.ln_in_g = (const float*)d_in[2]; p.ln_in_b = (const float*)d_in[3];
    p.w_in = (const float*)d_in[4]; p.b_in = (const float*)d_in[5]; p.lbl = (const float*)d_in[6]; p.hg_ng = (const float*)d_in[7];
    p.conv_w = (const float*)d_in[8]; p.conv_b = (const float*)d_in[9]; p.lru_wa = (const float*)d_in[10]; p.lru_ba = (const float*)d_in[11];
    p.lru_wx = (const float*)d_in[12]; p.lru_bx = (const float*)d_in[13]; p.lru_lam = (const float*)d_in[14]; p.w_out = (const float*)d_in[15];
    p.ln1_g = (const float*)d_in[16]; p.ln1_b = (const float*)d_in[17]; p.router_w = (const float*)d_in[18]; p.router_b = (const float*)d_in[19];
    p.we_gate = (const float*)d_in[20]; p.we_up = (const float*)d_in[21]; p.we_down = (const float*)d_in[22];
    p.ws_gate = (const float*)d_in[23]; p.ws_up = (const float*)d_in[24]; p.ws_down = (const float*)d_in[25];
    p.ln2_g = (const float*)d_in[26]; p.ln2_b = (const float*)d_in[27];
    p.out = (float*)d_out;
    char* ws = (char*)d_ws;
    p.h0 = (bf16_t*)(ws + 0 * U); p.Qh = (bf16_t*)(ws + 1 * U); p.Kh = (bf16_t*)(ws + 2 * U); p.Vv = (bf16_t*)(ws + 3 * U);
    p.G1 = (bf16_t*)(ws + 4 * U); p.LX = (bf16_t*)(ws + 5 * U); p.G2 = (bf16_t*)(ws + 6 * U);
    char* misc = ws + 7 * U;
    const size_t MB = 1024 * 1024;
    p.Dk = (float*)misc;
    p.ridx = (int*)(misc + 9 * MB / 4);
    p.rwts = (float*)(misc + 13 * MB / 4);
    p.Bt_in = (bf16_t*)(misc + 17 * MB / 4);
    p.Bt_out = (bf16_t*)(misc + 81 * MB / 4);
    p.Bt_sgu = (unsigned char*)(misc + 89 * MB / 4);
    p.Bt_sd = (unsigned char*)(misc + 93 * MB / 4);
    p.Bt_wa = (bf16_t*)(misc + 95 * MB / 4);
    p.Bt_wx = (bf16_t*)(misc + 96 * MB / 4);
    p.Bt_r = (bf16_t*)(misc + 97 * MB / 4);
    p.bperm = (float*)(misc + 97 * MB / 4 + MB / 8);
    p.lb = (float*)(misc + 97 * MB / 4 + MB / 8 + 32768);
    p.act = (unsigned char*)ws; p.base = (bf16_t*)(ws + 2 * U); p.yrows = (unsigned char*)(ws + 4 * U);
    p.bar = (unsigned*)(misc + 43 * MB); p.xg = (unsigned long long*)(misc + 44 * MB);
    p.cnt = (int*)(misc + 25 * MB); p.list_tok = (int*)(misc + 26 * MB); p.list_w = (float*)(misc + 34 * MB);
    p.pre1 = (bf16_t*)(ws + 1 * U);
    p.h1 = (bf16_t*)(ws + 3 * U);
    p.Bt_gu = (unsigned char*)d_out;
    p.Bt_d = (unsigned char*)d_out + (size_t)NE * 512 * D;
    p.h1q = (unsigned char*)d_out + (size_t)NE * 512 * D + (size_t)NE * D * DE;

    static int grid_blocks = 0;
    if (!grid_blocks) {
        (void)hipFuncSetAttribute((const void*)k_mega, hipFuncAttributeMaxDynamicSharedMemorySize, LDS_BYTES);
        int dev = 0, cus = 0, per_cu = 0;
        (void)hipGetDevice(&dev);
        (void)hipDeviceGetAttribute(&cus, hipDeviceAttributeMultiprocessorCount, dev);
        (void)hipOccupancyMaxActiveBlocksPerMultiprocessor(&per_cu, (const void*)k_mega, NTHR, LDS_BYTES);
        if (per_cu > 1) per_cu = 1;
        grid_blocks = cus * per_cu;
    }
    (void)hipMemsetAsync(p.bar, 0, XCD_BAR_WORDS * 4, stream);
    void* args[] = {&p};
    hipError_t e = hipLaunchCooperativeKernel((const void*)k_mega, dim3(grid_blocks), dim3(NTHR), args, LDS_BYTES, stream);
    if (e != hipSuccess) fprintf(stderr, "cooperative launch failed: %s (grid %d)\n", hipGetErrorString(e), grid_blocks);
}
```
